# Optimizing an MI355X kernel written in HIP

```python
import jax, jax.numpy as jnp
from jax import lax
import numpy as np

D_MODEL = 1024
BATCH = 2
SEQ = 8192
DEPTH = 2

GRID_W = 64
CTX_LEN = 256
Q_BLOCK = 128
ROPE_THETA = 10000.0
NORM_EPS = 1e-6
N_MOD = 9
D_FF = 2816

SC_WIDTH = 512
SC_KERNEL = 3
MLA_HEADS = 8
MLA_NOPE = 64
MLA_ROPE = 32
MLA_V = 64
MLA_Q_RANK = 256
MLA_KV_RANK = 128
E_IN = 3 * SC_WIDTH + MLA_Q_RANK + MLA_KV_RANK + MLA_ROPE
E_MIX = SC_WIDTH + MLA_HEADS * MLA_V
GQA_HEADS = 8
GQA_KV_HEADS = 2
GQA_HEAD_DIM = 64
CONF_WIDTH = 512
CONF_KERNEL = 31
O_IN = (GQA_HEADS + 2 * GQA_KV_HEADS) * GQA_HEAD_DIM + 2 * CONF_WIDTH
O_MIX = GQA_HEADS * GQA_HEAD_DIM + CONF_WIDTH
N_EVEN = (DEPTH + 1) // 2
N_ODD = DEPTH // 2

kernel_name = 'hybrid_dit_shortconv_mla_gqa_conformer_macaron'


def rms_norm(x, g):
    xf = x.astype(jnp.float32)
    y = xf * lax.rsqrt(jnp.mean(xf * xf, axis=-1, keepdims=True) + NORM_EPS)
    return (y * g.astype(jnp.float32)).astype(x.dtype)


def layer_norm(x, g, b):
    xf = x.astype(jnp.float32)
    mu = jnp.mean(xf, axis=-1, keepdims=True)
    var = jnp.mean(jnp.square(xf - mu), axis=-1, keepdims=True)
    y = (xf - mu) * lax.rsqrt(var + NORM_EPS) * g.astype(jnp.float32) + b.astype(jnp.float32)
    return y.astype(x.dtype)


def modulation(cond, w, b):
    m = jax.nn.silu(cond) @ w + b
    return m.reshape(-1, N_MOD, 1, D_MODEL)


def adaln(t, g, mm, j):
    return rms_norm(t, g) * (1 + mm[:, 3 * j + 1]) + mm[:, 3 * j]


def swiglu(t, w_in, w_out):
    gt, up = jnp.split(t @ w_in, 2, axis=-1)
    return (jax.nn.silu(gt) * up) @ w_out


def depthwise_conv(x, w, b=None):
    k, ch = w.shape
    y = lax.conv_general_dilated(x, w[:, None, :].astype(x.dtype), window_strides=(1,),
                                 padding=[(k // 2, k // 2)],
                                 dimension_numbers=('NWC', 'WIO', 'NWC'),
                                 feature_group_count=ch)
    if b is not None:
        y = y + b
    return y


def axial_rope(n_rows, rot_dim):
    row = jnp.repeat(jnp.arange(n_rows, dtype=jnp.float32), GRID_W)
    col = jnp.tile(jnp.arange(GRID_W, dtype=jnp.float32), n_rows)
    nf = rot_dim // 4
    inv = ROPE_THETA ** (-jnp.arange(nf, dtype=jnp.float32) / nf)
    ang = jnp.concatenate([row[:, None] * inv, col[:, None] * inv], axis=-1)
    return jnp.cos(ang), jnp.sin(ang)


def apply_rope(x, cos, sin):
    xp = x.reshape(x.shape[:-1] + (-1, 2))
    x0, x1 = xp[..., 0], xp[..., 1]
    c = cos[:, None, :].astype(x.dtype)
    s = sin[:, None, :].astype(x.dtype)
    return jnp.stack([x0 * c - x1 * s, x0 * s + x1 * c], axis=-1).reshape(x.shape)


def blocked_attention(q, k, v, scale):
    b, n, hq, dh = q.shape
    hkv, dv = k.shape[2], v.shape[3]
    g = hq // hkv
    nb = n // Q_BLOCK
    qb = q.reshape(b, nb, Q_BLOCK, hkv, g, dh).transpose(1, 0, 2, 3, 4, 5)

    def one_block(qq):
        s = jnp.einsum('btkgd,bskd->bkgts', qq, k).astype(jnp.float32) * scale
        p = jax.nn.softmax(s, axis=-1).astype(v.dtype)
        return jnp.einsum('bkgts,bskd->btkgd', p, v)

    o = lax.map(one_block, qb)
    return o.transpose(1, 0, 2, 3, 4, 5).reshape(b, n, hq, dv)


def _mla_qkv(qa, kva, kr, q_norm, w_q_b, kv_norm, w_kv_b, rope):
    b, n, _ = qa.shape
    q = (rms_norm(qa, q_norm) @ w_q_b).reshape(b, n, MLA_HEADS, MLA_NOPE + MLA_ROPE)
    kv = (rms_norm(kva, kv_norm) @ w_kv_b).reshape(b, n, MLA_HEADS, MLA_NOPE + MLA_V)
    q_nope, q_rope = q[..., :MLA_NOPE], q[..., MLA_NOPE:]
    k_nope, v = kv[..., :MLA_NOPE], kv[..., MLA_NOPE:]
    kr = kr[:, :, None, :]
    if rope is not None:
        q_rope = apply_rope(q_rope, *rope)
        kr = apply_rope(kr, *rope)
    k = jnp.concatenate([k_nope, jnp.broadcast_to(kr, (b, n, MLA_HEADS, MLA_ROPE))], axis=-1)
    q = jnp.concatenate([q_nope, q_rope], axis=-1)
    return q, k, v


def even_mixer(h, hc, rope, w_in, conv_w, q_norm, w_q_b, kv_norm, w_kv_b, w_out, ctx_out):
    cuts = [SC_WIDTH, 2 * SC_WIDTH, 3 * SC_WIDTH, 3 * SC_WIDTH + MLA_Q_RANK,
            3 * SC_WIDTH + MLA_Q_RANK + MLA_KV_RANK]
    sb, sc, sx, qa, kva, kr = jnp.split(h @ w_in, cuts, axis=-1)
    sbc, scc, sxc, qac, kvac, krc = jnp.split(hc @ w_in, cuts, axis=-1)
    q, k, v = _mla_qkv(qa, kva, kr, q_norm, w_q_b, kv_norm, w_kv_b, rope)
    qc, kc, vc = _mla_qkv(qac, kvac, krc, q_norm, w_q_b, kv_norm, w_kv_b, None)
    scale = (MLA_NOPE + MLA_ROPE) ** -0.5
    b, n, _ = h.shape
    o = blocked_attention(q, jnp.concatenate([k, kc], axis=1), jnp.concatenate([v, vc], axis=1), scale)
    y_a = sb * depthwise_conv(sc * sx, conv_w)
    y = jnp.concatenate([y_a, o.reshape(b, n, MLA_HEADS * MLA_V)], axis=-1) @ w_out
    yc = None
    if ctx_out:
        oc = blocked_attention(qc, kc, vc, scale)
        y_ac = sbc * depthwise_conv(scc * sxc, conv_w)
        yc = jnp.concatenate([y_ac, oc.reshape(b, hc.shape[1], MLA_HEADS * MLA_V)], axis=-1) @ w_out
    return y, yc


def odd_mixer(h, hc, rope, w_in, q_norm, k_norm, conv_w, conv_b, ln_g, ln_b, w_out, ctx_out):
    qw = GQA_HEADS * GQA_HEAD_DIM
    kw = GQA_KV_HEADS * GQA_HEAD_DIM
    cuts = [qw, qw + kw, qw + 2 * kw]

    def split(t):
        b, n, _ = t.shape
        q, k, v, u = jnp.split(t @ w_in, cuts, axis=-1)
        q = rms_norm(q.reshape(b, n, GQA_HEADS, GQA_HEAD_DIM), q_norm)
        k = rms_norm(k.reshape(b, n, GQA_KV_HEADS, GQA_HEAD_DIM), k_norm)
        v = v.reshape(b, n, GQA_KV_HEADS, GQA_HEAD_DIM)
        return q, k, v, u

    def conformer_conv(u):
        a, gt = jnp.split(u, 2, axis=-1)
        z = depthwise_conv(a * jax.nn.sigmoid(gt), conv_w, conv_b)
        return jax.nn.silu(layer_norm(z, ln_g, ln_b))

    q, k, v, u = split(h)
    qc, kc, vc, uc = split(hc)
    q = apply_rope(q, *rope)
    k = apply_rope(k, *rope)
    scale = GQA_HEAD_DIM ** -0.5
    b, n, _ = h.shape
    o = blocked_attention(q, jnp.concatenate([k, kc], axis=1), jnp.concatenate([v, vc], axis=1), scale)
    y = jnp.concatenate([o.reshape(b, n, qw), conformer_conv(u)], axis=-1) @ w_out
    yc = None
    if ctx_out:
        oc = blocked_attention(qc, kc, vc, scale)
        yc = jnp.concatenate([oc.reshape(b, hc.shape[1], qw), conformer_conv(uc)], axis=-1) @ w_out
    return y, yc


def setup_inputs(seed: int = 0) -> dict:
    key = jax.random.key(seed)
    ks = iter(jax.random.split(key, 32))
    f32 = jnp.float32

    def nrm(shape, fan_in, gain=1.0):
        return gain * fan_in ** -0.5 * jax.random.normal(next(ks), shape, f32)

    def gains(shape):
        return 1.0 + 0.05 * jax.random.normal(next(ks), shape, f32)

    def bias(shape):
        return 0.02 * jax.random.normal(next(ks), shape, f32)

    return {
        'x': jax.random.normal(next(ks), (BATCH, SEQ, D_MODEL), f32),
        'c': jax.random.normal(next(ks), (BATCH, D_MODEL), f32),
        'ctx': jax.random.normal(next(ks), (BATCH, CTX_LEN, D_MODEL), f32),
        'c_ctx': jax.random.normal(next(ks), (D_MODEL,), f32),
        'w_mod': nrm((DEPTH, D_MODEL, N_MOD * D_MODEL), D_MODEL, 0.5),
        'b_mod': bias((DEPTH, N_MOD * D_MODEL)),
        'norm_g': gains((DEPTH, 3, D_MODEL)),
        'w_ffn_in': nrm((DEPTH, 2, D_MODEL, 2 * D_FF), D_MODEL),
        'w_ffn_out': nrm((DEPTH, 2, D_FF, D_MODEL), D_FF),
        'e_w_in': nrm((N_EVEN, D_MODEL, E_IN), D_MODEL),
        'e_conv_w': nrm((N_EVEN, SC_KERNEL, SC_WIDTH), SC_KERNEL),
        'e_q_norm': gains((N_EVEN, MLA_Q_RANK)),
        'e_w_q_b': nrm((N_EVEN, MLA_Q_RANK, MLA_HEADS * (MLA_NOPE + MLA_ROPE)), MLA_Q_RANK),
        'e_kv_norm': gains((N_EVEN, MLA_KV_RANK)),
        'e_w_kv_b': nrm((N_EVEN, MLA_KV_RANK, MLA_HEADS * (MLA_NOPE + MLA_V)), MLA_KV_RANK),
        'e_w_out': nrm((N_EVEN, E_MIX, D_MODEL), E_MIX),
        'o_w_in': nrm((N_ODD, D_MODEL, O_IN), D_MODEL),
        'o_q_norm': gains((N_ODD, GQA_HEAD_DIM)),
        'o_k_norm': gains((N_ODD, GQA_HEAD_DIM)),
        'o_conv_w': nrm((N_ODD, CONF_KERNEL, CONF_WIDTH), CONF_KERNEL),
        'o_conv_b': bias((N_ODD, CONF_WIDTH)),
        'o_ln_g': gains((N_ODD, CONF_WIDTH)),
        'o_ln_b': bias((N_ODD, CONF_WIDTH)),
        'o_w_out': nrm((N_ODD, O_MIX, D_MODEL), O_MIX),
        'final_g': gains((D_MODEL,)),
    }


def reference(x, c, ctx, c_ctx, w_mod, b_mod, norm_g, w_ffn_in, w_ffn_out,
              e_w_in, e_conv_w, e_q_norm, e_w_q_b, e_kv_norm, e_w_kv_b, e_w_out,
              o_w_in, o_q_norm, o_k_norm, o_conv_w, o_conv_b, o_ln_g, o_ln_b, o_w_out,
              final_g):
    ROWS = x.shape[1] // GRID_W
    rope_mla = axial_rope(ROWS, MLA_ROPE)
    rope_gqa = axial_rope(ROWS, GQA_HEAD_DIM)
    h, hc = x, ctx
    for l in range(DEPTH):
        last = l == DEPTH - 1
        m = modulation(c, w_mod[l], b_mod[l])
        mc = modulation(c_ctx, w_mod[l], b_mod[l])
        h = h + 0.5 * m[:, 2] * swiglu(adaln(h, norm_g[l, 0], m, 0), w_ffn_in[l, 0], w_ffn_out[l, 0])
        hc = hc + 0.5 * mc[:, 2] * swiglu(adaln(hc, norm_g[l, 0], mc, 0), w_ffn_in[l, 0], w_ffn_out[l, 0])
        a = adaln(h, norm_g[l, 1], m, 1)
        ac = adaln(hc, norm_g[l, 1], mc, 1)
        if l % 2 == 0:
            i = l // 2
            y, yc = even_mixer(a, ac, rope_mla, e_w_in[i], e_conv_w[i], e_q_norm[i], e_w_q_b[i],
                               e_kv_norm[i], e_w_kv_b[i], e_w_out[i], not last)
        else:
            i = l // 2
            y, yc = odd_mixer(a, ac, rope_gqa, o_w_in[i], o_q_norm[i], o_k_norm[i], o_conv_w[i],
                              o_conv_b[i], o_ln_g[i], o_ln_b[i], o_w_out[i], not last)
        h = h + m[:, 5] * y
        h = h + 0.5 * m[:, 8] * swiglu(adaln(h, norm_g[l, 2], m, 2), w_ffn_in[l, 1], w_ffn_out[l, 1])
        if not last:
            hc = hc + mc[:, 5] * yc
            hc = hc + 0.5 * mc[:, 8] * swiglu(adaln(hc, norm_g[l, 2], mc, 2), w_ffn_in[l, 1], w_ffn_out[l, 1])
    return rms_norm(h, final_g)
```

```cpp
#include <hip/hip_runtime.h>
#include <hip/hip_cooperative_groups.h>
#include <cstdio>
#include <cstdint>
#include <cmath>
namespace cg = cooperative_groups;
__device__ __forceinline__ int fresh_lane() { int l; asm volatile("v_mbcnt_lo_u32_b32 %0, -1, 0\n\tv_mbcnt_hi_u32_b32 %0, -1, %0" : "=v"(l)); return l; }
__device__ __forceinline__ int fresh_wave() { return (int)__builtin_amdgcn_readfirstlane(threadIdx.x >> 6); }
namespace pg8 {
#define PG8_LAS __attribute__((address_space(3)))
typedef unsigned short bf16_t;
typedef short bf16x8 __attribute__((ext_vector_type(8)));
typedef float f32x4 __attribute__((ext_vector_type(4)));
typedef unsigned u32x4 __attribute__((ext_vector_type(4)));
constexpr int BM = 256, BK = 64, HALF = 128, HTB = HALF * BK * 2  , STAGE_BYTES = 8 * HTB, NXCD = 8, WGM = 8;

__host__ __device__ __forceinline__ int lds_byte(int r, int c) { const int st = (r >> 4) * 2 + (c >> 5), rr = r & 15, cc = c & 31, ob = rr * 64 + cc * 2; return st * 1024 + (ob ^ (((ob >> 9) & 1) << 5)); }
__host__ __device__ __forceinline__ void stage_rc(int b, int& R, int& C) { const int st = b / 1024, sb = b % 1024, swz = sb ^ (((sb >> 9) & 1) << 5); R = (st >> 1) * 16 + swz / 64; C = (st & 1) * 32 + (swz % 64) / 2; }
__host__ __device__ __forceinline__ int perm32(int rho) { const int n = rho >> 4, i = rho & 15; return 8 * (i >> 2) + 4 * n + (i & 3); }

struct Unit { int pm, pn, kx; };
struct Gemm { const bf16_t* A; const bf16_t* Bt; int M, N, K; };

struct Order {
    int nM, nN, nwg, G, c, skip, ntk, nsub, S;
    __device__ __forceinline__ void init(int nM_, int nN_, int G_, int c_, int skip_, int ntk_, int S_) { nM = nM_; nN = nN_; nwg = nM_ * nN_; G = G_; c = c_; skip = skip_; ntk = ntk_; S = S_; nsub = S_ ? 2 * nN_ * S_ : 0; }
    __device__ __forceinline__ bool next(int i, Unit& u) const {
        const long L = (long)i * G + c; if (L >= nwg + nsub) return false;
        if (L < nsub) { const int r = (int)L, s = r % S, tile = r / S; const int nts = ntk / S; u.pn = tile % nN; u.pm = 32 + 33 * (tile / nN); u.kx = (s * nts) | (nts << 8) | (1 << 16) | (s << 17); return true; }
        int wgid = (int)L - nsub; { const int q = nwg / NXCD, r = nwg % NXCD, xcd = wgid % NXCD, off = wgid / NXCD; wgid = (xcd < r ? xcd * (q + 1) : r * (q + 1) + (xcd - r) * q) + off; }
        const int nig = WGM * nN, gid = wgid / nig, fm = gid * WGM, gsz = (nM - fm) < WGM ? (nM - fm) : WGM;
        int pm = fm + ((wgid % nig) % gsz); if (skip) pm += pm >> 5;
        u.pm = pm; u.pn = (wgid % nig) / gsz; u.kx = ntk << 8; return true;
    }
    __device__ __forceinline__ void a_ready(const Unit&) const {}
    __device__ __forceinline__ void done(const Unit&) const {}
};
__device__ __forceinline__ unsigned cvt_pk_bf16(float lo, float hi) { unsigned r; asm volatile("v_cvt_pk_bf16_f32 %0, %1, %2" : "=v"(r) : "v"(lo), "v"(hi)); return r; }
template <class Epi, class Sched, bool ALIGN_EPI = false, bool SP2 = false>
__device__ __forceinline__ void gemm_phase(PG8_LAS unsigned char* lds, const Gemm g, const Sched& S, const Epi& E, const int wave_id) {
    const int wid = wave_id, lane = fresh_lane(), tid = wid * 64 + lane, wr = wid >> 2, wc = wid & 3, fr = lane & 15, fq = lane >> 4;
    const int K = g.K;
    unsigned voffA[2], voffB[2];
#pragma unroll
    for (int i = 0; i < 2; ++i) { int R, C; stage_rc(tid * 16 + i * 8192, R, C); const int Rb = Epi::PERM ? ((R & ~31) + perm32(R & 31)) : R;
        voffA[i] = (unsigned)(R * K + C) * 2u; voffB[i] = (unsigned)(Rb * K + C) * 2u; }
    const size_t kstep = (size_t)(BK * 2);
    const size_t hstep = (size_t)HALF * K * 2;
    const size_t tstep = 2 * hstep;
    const unsigned ldsw = (unsigned)wid * 1024u;
    const int aoff = lds_byte(wr * 64 + fr, fq * 8), boff = lds_byte(wc * 32 + fr, fq * 8);
#define PG8_SA(b, h) (((b) * 2 + (h)) * HTB)
#define PG8_SB(b, h) ((4 + (b) * 2 + (h)) * HTB)
#define PG8_STAGE(bufoff, gbase, voff) do { _Pragma("unroll") for (int _i = 0; _i < 2; ++_i) \
        __builtin_amdgcn_global_load_lds((const unsigned*)((const char*)(gbase) + (voff)[_i]), (PG8_LAS unsigned*)(lds + (bufoff) + ldsw + _i * 8192), 16, 0, 0); } while (0)
#define PG8_LDA(dst, b, h) do { _Pragma("unroll") for (int m = 0; m < 4; ++m) _Pragma("unroll") for (int k = 0; k < 2; ++k) dst[m][k] = *(const PG8_LAS bf16x8*)(lds + PG8_SA(b, h) + aoff + m * 2048 + k * 1024); } while (0)
#define PG8_LDB(dst, b, h) do { _Pragma("unroll") for (int n = 0; n < 2; ++n) _Pragma("unroll") for (int k = 0; k < 2; ++k) dst[n][k] = *(const PG8_LAS bf16x8*)(lds + PG8_SB(b, h) + boff + n * 2048 + k * 1024); } while (0)
#define PG8_MMA(ai, bj, At, Bt) do { __builtin_amdgcn_s_setprio(1); _Pragma("unroll") for (int m = 0; m < 4; ++m) _Pragma("unroll") for (int n = 0; n < 2; ++n) _Pragma("unroll") for (int k = 0; k < 2; ++k) \
        acc[ai][bj][m][n] = __builtin_amdgcn_mfma_f32_16x16x32_bf16(Bt[n][k], At[m][k], acc[ai][bj][m][n], 0, 0, 0); __builtin_amdgcn_s_setprio(0); } while (0)
#define PG8_WAIT_V(n) asm volatile("s_waitcnt vmcnt(" #n ")" ::: "memory")
#define PG8_WAIT_L(n) asm volatile("s_waitcnt lgkmcnt(" #n ")" ::: "memory")
#define PG8_BAR __builtin_amdgcn_s_barrier()
#define PG8_SCHED __builtin_amdgcn_sched_barrier(0)
    Unit cur, nxt; int ui = 0;
    if (!S.next(0, cur)) return;
    f32x4 acc[2][2][4][2];
#pragma unroll
    for (int a = 0; a < 2; ++a)
#pragma unroll
        for (int b = 0; b < 2; ++b)
#pragma unroll
            for (int m = 0; m < 4; ++m)
#pragma unroll
                for (int n = 0; n < 2; ++n) acc[a][b][m][n] = (f32x4){0.f, 0.f, 0.f, 0.f};
    bf16x8 At[4][2], B0[2][2], B1[2][2];
    const char* cA = (const char*)g.A + (size_t)cur.pm * tstep + (size_t)(cur.kx & 255) * kstep; const char* cB = (const char*)g.Bt + (size_t)cur.pn * tstep + (size_t)(cur.kx & 255) * kstep;
    S.a_ready(cur);
    if constexpr (SP2) {
        PG8_STAGE(PG8_SB(0, 0), cB, voffB); PG8_STAGE(PG8_SB(0, 1), cB + hstep, voffB); PG8_STAGE(PG8_SA(0, 0), cA, voffA); PG8_STAGE(PG8_SA(0, 1), cA + hstep, voffA);
        if (wr == 1) PG8_BAR;
        PG8_WAIT_V(2); PG8_BAR;
        PG8_STAGE(PG8_SB(1, 0), cB + kstep, voffB); PG8_STAGE(PG8_SA(1, 0), cA + kstep, voffA); PG8_STAGE(PG8_SB(1, 1), cB + hstep + kstep, voffB);
        PG8_WAIT_V(6); PG8_BAR;
    } else {
        PG8_STAGE(PG8_SB(0, 0), cB, voffB); PG8_STAGE(PG8_SA(0, 0), cA, voffA); PG8_STAGE(PG8_SB(0, 1), cB + hstep, voffB); PG8_STAGE(PG8_SA(0, 1), cA + hstep, voffA);
        if (wr == 1) PG8_BAR;
        PG8_WAIT_V(4); PG8_BAR;
        PG8_STAGE(PG8_SB(1, 0), cB + kstep, voffB); PG8_STAGE(PG8_SA(1, 0), cA + kstep, voffA); PG8_STAGE(PG8_SB(1, 1), cB + hstep + kstep, voffB);
        PG8_WAIT_V(6); PG8_BAR;
    }
    for (;;) {
        const bool has_next = S.next(ui + 1, nxt);
        const char* nA = has_next ? (const char*)g.A + (size_t)nxt.pm * tstep + (size_t)(nxt.kx & 255) * kstep : cA; const char* nB = has_next ? (const char*)g.Bt + (size_t)nxt.pn * tstep + (size_t)(nxt.kx & 255) * kstep : cB;
        const int nt = (cur.kx >> 8) & 255;
        for (int t = 0; t < nt; t += 2) {
            const bool last = (t == nt - 2);
            const char* a1 = cA + (size_t)(t + 1) * kstep;
            const char* a2 = last ? nA : cA + (size_t)(t + 2) * kstep; const char* b2 = last ? nB : cB + (size_t)(t + 2) * kstep;
            const char* a3 = a2 + kstep; const char* b3 = b2 + kstep;
            if (last && has_next) S.a_ready(nxt);
            if constexpr (SP2) {
            PG8_LDB(B0, 0, 0); PG8_LDB(B1, 0, 1); PG8_SCHED; PG8_LDA(At, 0, 0); PG8_STAGE(PG8_SA(1, 1), a1 + hstep, voffA);
            PG8_WAIT_V(8); PG8_WAIT_L(0); PG8_BAR; PG8_MMA(0, 0, At, B0); PG8_MMA(0, 1, At, B1); PG8_BAR; PG8_SCHED;
            PG8_LDA(At, 0, 1); PG8_STAGE(PG8_SB(0, 0), b2, voffB); PG8_STAGE(PG8_SB(0, 1), b2 + hstep, voffB); PG8_STAGE(PG8_SA(0, 0), a2, voffA);
            PG8_WAIT_V(8); PG8_WAIT_L(0); PG8_BAR; PG8_MMA(1, 0, At, B0); PG8_MMA(1, 1, At, B1); PG8_BAR; PG8_SCHED;
            PG8_LDB(B0, 1, 0); PG8_LDB(B1, 1, 1); PG8_SCHED; PG8_LDA(At, 1, 0); PG8_STAGE(PG8_SA(0, 1), a2 + hstep, voffA);
            PG8_WAIT_V(8); PG8_WAIT_L(0); PG8_BAR; PG8_MMA(0, 0, At, B0); PG8_MMA(0, 1, At, B1); PG8_BAR; PG8_SCHED;
            PG8_LDA(At, 1, 1); PG8_STAGE(PG8_SB(1, 0), b3, voffB); PG8_STAGE(PG8_SB(1, 1), b3 + hstep, voffB); PG8_STAGE(PG8_SA(1, 0), a3, voffA);
            PG8_WAIT_V(8); PG8_WAIT_L(0); PG8_BAR; PG8_MMA(1, 0, At, B0); PG8_MMA(1, 1, At, B1); PG8_BAR; PG8_SCHED;
            } else {
            PG8_LDB(B0, 0, 0); PG8_SCHED; PG8_LDA(At, 0, 0); PG8_STAGE(PG8_SA(1, 1), a1 + hstep, voffA);
            PG8_WAIT_L(8); PG8_BAR; PG8_WAIT_L(0); PG8_MMA(0, 0, At, B0); PG8_BAR; PG8_SCHED;
            PG8_LDB(B1, 0, 1); PG8_STAGE(PG8_SB(0, 0), b2, voffB);
            PG8_BAR; PG8_WAIT_L(0); PG8_MMA(0, 1, At, B1); PG8_BAR;
            PG8_LDA(At, 0, 1); PG8_STAGE(PG8_SA(0, 0), a2, voffA);
            PG8_BAR; PG8_WAIT_L(0); PG8_MMA(1, 0, At, B0); PG8_BAR; PG8_SCHED;
            PG8_STAGE(PG8_SB(0, 1), b2 + hstep, voffB);
            PG8_WAIT_V(6); PG8_BAR; PG8_MMA(1, 1, At, B1); PG8_BAR;
            PG8_LDB(B0, 1, 0); PG8_SCHED; PG8_LDA(At, 1, 0); PG8_STAGE(PG8_SA(0, 1), a2 + hstep, voffA);
            PG8_WAIT_L(8); PG8_BAR; PG8_WAIT_L(0); PG8_MMA(0, 0, At, B0); PG8_BAR; PG8_SCHED;
            PG8_LDB(B1, 1, 1); PG8_STAGE(PG8_SB(1, 0), b3, voffB);
            PG8_BAR; PG8_WAIT_L(0); PG8_MMA(0, 1, At, B1); PG8_BAR;
            PG8_LDA(At, 1, 1); PG8_STAGE(PG8_SA(1, 0), a3, voffA);
            PG8_BAR; PG8_WAIT_L(0); PG8_MMA(1, 0, At, B0); PG8_BAR; PG8_SCHED;
            PG8_STAGE(PG8_SB(1, 1), b3 + hstep, voffB);
            PG8_WAIT_V(6); PG8_BAR; PG8_MMA(1, 1, At, B1); PG8_BAR;
            }
        }
        if constexpr (ALIGN_EPI) { if (wr == 0) PG8_BAR; }
        if constexpr (!Epi::AFTER_DRAIN) { E(acc, cur, wr, wc, fr, fq); S.done(cur); }
        if (!has_next) break;
#pragma unroll
        for (int a = 0; a < 2; ++a)
#pragma unroll
            for (int b = 0; b < 2; ++b)
#pragma unroll
                for (int m = 0; m < 4; ++m)
#pragma unroll
                    for (int n = 0; n < 2; ++n) acc[a][b][m][n] = (f32x4){0.f, 0.f, 0.f, 0.f};
        cur = nxt; cA = nA; cB = nB; ++ui;
        if constexpr (ALIGN_EPI) { if (wr == 1) PG8_BAR; }
    }
    PG8_WAIT_V(0);
    if constexpr (!ALIGN_EPI) { if (wr == 0) PG8_BAR; }
    PG8_BAR;
    if constexpr (Epi::AFTER_DRAIN) { E.fused(acc, cur, wr, wc, fr, fq, lds, wid, lane); S.done(cur); }
#undef PG8_SA
#undef PG8_SB
#undef PG8_STAGE
#undef PG8_LDA
#undef PG8_LDB
#undef PG8_MMA
#undef PG8_WAIT_V
#undef PG8_WAIT_L
#undef PG8_BAR
#undef PG8_SCHED
}
}

#define LAS __attribute__((address_space(3)))
typedef unsigned short bf16_t;
typedef float f32x4 __attribute__((ext_vector_type(4)));
typedef float f32x2 __attribute__((ext_vector_type(2)));
typedef float f32x16 __attribute__((ext_vector_type(16)));
typedef short bf16x8 __attribute__((ext_vector_type(8)));
typedef short s16x4 __attribute__((ext_vector_type(4)));
typedef unsigned u32x4 __attribute__((ext_vector_type(4)));
typedef unsigned u32x2 __attribute__((ext_vector_type(2)));
typedef __bf16 bf16x2_t __attribute__((ext_vector_type(2)));

constexpr int DM = 1024, NB = 2, SEQ = 8192, CTXL = 256, SEQT = SEQ + CTXL, T = NB * SEQT;
constexpr int DFF = 2816, NFI = 2 * DFF;
constexpr int E_IN = 1952, E_INP = 2048, O_IN = 1792;
constexpr float EPS = 1e-6f;
constexpr float LOG2E = 1.4426950408889634f;
constexpr float C2_MLA = 0.10206207261596575f * LOG2E;
constexpr float C2_GQA = 0.125f * LOG2E;
constexpr int NWAVES = 8;

constexpr size_t MiB = 1u << 20;
constexpr size_t WS_XBUF = 256 * 1024  ;
constexpr size_t WS_CTL = 0, WS_MOD = 1 * MiB, WS_ROPE = 1 * MiB + 512 * 1024, ZERO_BYTES = 2 * MiB;
constexpr size_t WS_WFI = 2 * MiB, WS_WFO = 46 * MiB, WS_EWIN = 68 * MiB, WS_EWQB = 72 * MiB, WS_EWKVB = 73 * MiB, WS_EWOUT = 74 * MiB, WS_OWIN = 76 * MiB, WS_OWOUT = 80 * MiB;
constexpr size_t WS_H = 82 * MiB, WS_A = 148 * MiB, WS_SCR = 181 * MiB;
constexpr size_t WS_ACT = WS_SCR, WS_P = WS_SCR, WS_EQ = 181 * MiB, WS_EK = 206 * MiB, WS_EV = 231 * MiB, WS_Y = 248 * MiB;
constexpr size_t WS_QAN = 281 * MiB, WS_KVAN = 290 * MiB, WS_KR = 295 * MiB, WS_G = 281 * MiB, WS_OQ = 298 * MiB, WS_OK = 315 * MiB, WS_OV = 320 * MiB, WS_SB = 300 * MiB  , WS_CX = 317 * MiB, WS_PART = 300 * MiB  , WS_END = 344 * MiB;
static_assert(WS_WFI + 4 * (size_t)NFI * DM * 2 <= WS_WFO && WS_WFO + 4 * (size_t)DM * DFF * 2 <= WS_EWIN, "ws map");
static_assert(WS_H + (size_t)T * DM * 4 <= WS_A && WS_A + (size_t)T * DM * 2 <= WS_SCR && WS_ACT + (size_t)T * DFF * 2 <= WS_QAN, "ws map");
static_assert(WS_EQ + (size_t)T * 768 * 2 <= WS_EK && WS_EK + (size_t)T * 768 * 2 <= WS_EV && WS_EV + (size_t)T * 512 * 2 <= WS_Y && WS_Y + (size_t)T * DM * 2 <= WS_QAN, "ws map");
static_assert(WS_QAN + (size_t)T * 256 * 2 <= WS_KVAN && WS_KVAN + (size_t)T * 128 * 2 <= WS_KR && WS_KR + (size_t)T * 32 * 2 <= WS_OQ && WS_G + (size_t)T * 512 * 2 <= WS_OQ, "ws map");
static_assert(WS_OQ + (size_t)T * 512 * 2 <= WS_OK && WS_OK + (size_t)T * 128 * 2 <= WS_OV && WS_OV + (size_t)T * 128 * 2 <= WS_END && WS_P + (size_t)T * 2048 * 2 <= WS_Y, "ws map");

constexpr int RING_BYTES = 131072, LDS_BYTES = 147456;

struct Params {
    const float *x, *c, *ctx, *c_ctx, *w_mod, *b_mod, *norm_g, *w_ffn_in, *w_ffn_out;
    const float *e_w_in, *e_conv_w, *e_q_norm, *e_w_q_b, *e_kv_norm, *e_w_kv_b, *e_w_out;
    const float *o_w_in, *o_q_norm, *o_k_norm, *o_conv_w, *o_conv_b, *o_ln_g, *o_ln_b, *o_w_out, *final_g;
    float* out; unsigned char* ws;
};

__device__ __forceinline__ unsigned f2bf(float f) { unsigned u = __builtin_bit_cast(unsigned, f); return (u + 0x7fffu + ((u >> 16) & 1u)) >> 16; }
__device__ __forceinline__ unsigned pk2(float lo, float hi) { f32x2 v = {lo, hi}; bf16x2_t b = __builtin_convertvector(v, bf16x2_t); return __builtin_bit_cast(unsigned, b); }
__device__ __forceinline__ float bf_lo(unsigned w) { return __builtin_bit_cast(float, w << 16); }
__device__ __forceinline__ float bf_hi(unsigned w) { return __builtin_bit_cast(float, w & 0xffff0000u); }
__device__ __forceinline__ void unpack8(const u32x4 w, float (&f)[8]) { f[0] = bf_lo(w.x); f[1] = bf_hi(w.x); f[2] = bf_lo(w.y); f[3] = bf_hi(w.y); f[4] = bf_lo(w.z); f[5] = bf_hi(w.z); f[6] = bf_lo(w.w); f[7] = bf_hi(w.w); }
__device__ __forceinline__ u32x4 pack8(const float (&f)[8]) { u32x4 w; w.x = pk2(f[0], f[1]); w.y = pk2(f[2], f[3]); w.z = pk2(f[4], f[5]); w.w = pk2(f[6], f[7]); return w; }
template <int PAT> __device__ __forceinline__ float swz(float v) { return __builtin_bit_cast(float, __builtin_amdgcn_ds_swizzle(__builtin_bit_cast(int, v), PAT)); }
__device__ __forceinline__ float wave_sum(float v) {
    v += swz<0x041F>(v); v += swz<0x081F>(v); v += swz<0x101F>(v); v += swz<0x201F>(v); v += swz<0x401F>(v);
    auto rr = __builtin_amdgcn_permlane32_swap(__float_as_uint(v), __float_as_uint(v), false, false); return __uint_as_float(rr[0]) + __uint_as_float(rr[1]);
}
__device__ __forceinline__ float rdlane(float v, int k) { return __builtin_bit_cast(float, __builtin_amdgcn_readlane(__builtin_bit_cast(int, v), k)); }
__device__ __forceinline__ float silu_f(float v) { return v * __builtin_amdgcn_rcpf(1.f + __builtin_amdgcn_exp2f(-1.4426950408889634f * v)); }
__device__ __forceinline__ float sigmoid_f(float v) { return __builtin_amdgcn_rcpf(1.f + __builtin_amdgcn_exp2f(-1.4426950408889634f * v)); }
__device__ __forceinline__ int row_mi(int pm) { const int b = pm / 33; return (pm - b * 33 == 32) ? 2 : b; }

using pg8::Unit; using pg8::BM; using pg8::HALF;
#define EPI_FENCE() asm volatile("" ::: "memory")
template <int LDC> struct EpiStoreT {
    static constexpr bool PERM = true, AFTER_DRAIN = false;
    bf16_t* O;
    __device__ __forceinline__ void operator()(const f32x4 (&acc)[2][2][4][2], const Unit& u, int wr, int wc, int fr_, int fq_) const {
        int fr = fr_, fq = fq_; asm volatile("" : "+v"(fr), "+v"(fq));
        const unsigned off0 = (unsigned)(u.pm * BM + wr * 64 + fr) * LDC + (unsigned)(u.pn * BM + wc * 32 + 8 * fq);
#pragma unroll
        for (int ai = 0; ai < 2; ++ai)
#pragma unroll
            for (int m = 0; m < 4; ++m) { const unsigned off = off0 + (unsigned)(ai * HALF + m * 16) * LDC;
#pragma unroll
                for (int bj = 0; bj < 2; ++bj) { const f32x4 v0 = acc[ai][bj][m][0], v1 = acc[ai][bj][m][1]; u32x4 w; w.x = pk2(v0[0], v0[1]); w.y = pk2(v0[2], v0[3]); w.z = pk2(v1[0], v1[1]); w.w = pk2(v1[2], v1[3]);
                    *(u32x4*)(O + off + bj * HALF) = w; }
                EPI_FENCE(); }
    }
};
struct EpiSwiglu {
    static constexpr bool PERM = true, AFTER_DRAIN = false;
    bf16_t* O;
    __device__ __forceinline__ void operator()(const f32x4 (&acc)[2][2][4][2], const Unit& u, int wr, int wc, int fr_, int fq_) const {
        int fr = fr_, fq = fq_; asm volatile("" : "+v"(fr), "+v"(fq));
        const unsigned off0 = (unsigned)(u.pm * BM + wr * 64 + fr) * DFF + (unsigned)(u.pn * HALF + wc * 32 + 8 * fq);
#pragma unroll
        for (int ai = 0; ai < 2; ++ai)
#pragma unroll
            for (int m = 0; m < 4; ++m) { const unsigned off = off0 + (unsigned)(ai * HALF + m * 16) * DFF;
                float r[8];
#pragma unroll
                for (int n = 0; n < 2; ++n)
#pragma unroll
                    for (int e = 0; e < 4; ++e) { const float g = acc[ai][0][m][n][e], up = acc[ai][1][m][n][e]; r[n * 4 + e] = (g * up) * __builtin_amdgcn_rcpf(1.f + __builtin_amdgcn_exp2f(g)); }
                *(u32x4*)(O + off) = pack8(r); EPI_FENCE(); }
    }
};
__device__ __forceinline__ void ld8(const bf16_t* p, float (&f)[8]);
__device__ __forceinline__ void ldf8(const float* p, float (&f)[8]);
template <bool FIRST> struct EpiResidT {
    static constexpr bool PERM = true, AFTER_DRAIN = false;
    bf16_t* H; const float* gate  ; float* part; const float* xin; float coef;
    __device__ __forceinline__ void operator()(const f32x4 (&acc)[2][2][4][2], const Unit& u, int wr, int wc, int fr_, int fq_) const {
        int fr = fr_, fq = fq_; asm volatile("" : "+v"(fr), "+v"(fq));
        const unsigned colp = (unsigned)(u.pn * BM + wc * 32 + 8 * fq), rloc = (unsigned)(wr * 64 + fr);
        const float* gp = gate + (unsigned)row_mi(u.pm) * 9 * DM + colp;
        const unsigned xrow0 = (unsigned)((u.pm / 33) * SEQ + (u.pm % 33) * BM);
#pragma unroll
        for (int bj = 0; bj < 2; ++bj) { const f32x4 gv0 = *(const f32x4*)(gp + bj * HALF) * coef, gv1 = *(const f32x4*)(gp + bj * HALF + 4) * coef;
            if (u.kx >> 16) {
                float* pb = part + ((size_t)(u.kx >> 17) * 512 + (u.pm == 65 ? 256 : 0) + rloc) * DM + colp + bj * HALF;
#pragma unroll
                for (int ai = 0; ai < 2; ++ai)
#pragma unroll
                    for (int m = 0; m < 4; ++m) { float* p = pb + (unsigned)(ai * HALF + m * 16) * DM; *(f32x4*)p = gv0 * acc[ai][bj][m][0]; *(f32x4*)(p + 4) = gv1 * acc[ai][bj][m][1]; }
            } else {
                f32x4 hx[FIRST ? 8 : 1][2]; u32x4 hb[FIRST ? 1 : 8];
#pragma unroll
                for (int ai = 0; ai < 2; ++ai)
#pragma unroll
                    for (int m = 0; m < 4; ++m) { const unsigned rr = rloc + (unsigned)(ai * HALF + m * 16);
                        if (FIRST) { const float* xp = xin + (size_t)(xrow0 + rr) * DM + colp + bj * HALF; hx[FIRST ? ai * 4 + m : 0][0] = *(const f32x4*)xp; hx[FIRST ? ai * 4 + m : 0][1] = *(const f32x4*)(xp + 4); }
                        else hb[FIRST ? 0 : ai * 4 + m] = *(const u32x4*)(H + (size_t)((unsigned)u.pm * BM + rr) * DM + colp + bj * HALF); }
#pragma unroll
                for (int ai = 0; ai < 2; ++ai)
#pragma unroll
                    for (int m = 0; m < 4; ++m) { const unsigned rr = rloc + (unsigned)(ai * HALF + m * 16); float h[8];
                        if (FIRST) { const f32x4 x0 = hx[FIRST ? ai * 4 + m : 0][0], x1 = hx[FIRST ? ai * 4 + m : 0][1]; h[0] = x0[0]; h[1] = x0[1]; h[2] = x0[2]; h[3] = x0[3]; h[4] = x1[0]; h[5] = x1[1]; h[6] = x1[2]; h[7] = x1[3]; }
                        else unpack8(hb[FIRST ? 0 : ai * 4 + m], h);
                        const f32x4 d0 = gv0 * acc[ai][bj][m][0], d1 = gv1 * acc[ai][bj][m][1];
                        h[0] += d0[0]; h[1] += d0[1]; h[2] += d0[2]; h[3] += d0[3]; h[4] += d1[0]; h[5] += d1[1]; h[6] += d1[2]; h[7] += d1[3];
                        *(u32x4*)(H + (size_t)((unsigned)u.pm * BM + rr) * DM + colp + bj * HALF) = pack8(h); }
            }
            EPI_FENCE(); }
    }
};
struct EpiOddIn {
    static constexpr bool PERM = true, AFTER_DRAIN = false;
    bf16_t* O; bf16_t* G;
    __device__ __forceinline__ void operator()(const f32x4 (&acc)[2][2][4][2], const Unit& u, int wr, int wc, int fr_, int fq_) const {
        int fr = fr_, fq = fq_; asm volatile("" : "+v"(fr), "+v"(fq));
        const unsigned row0 = (unsigned)(u.pm * BM + wr * 64 + fr);
        if (u.pn < 3) {
            const unsigned off0 = row0 * 768u + (unsigned)(u.pn * BM + wc * 32 + 8 * fq);
#pragma unroll
            for (int ai = 0; ai < 2; ++ai)
#pragma unroll
                for (int m = 0; m < 4; ++m) { const unsigned off = off0 + (unsigned)(ai * HALF + m * 16) * 768u;
#pragma unroll
                    for (int bj = 0; bj < 2; ++bj) { const f32x4 v0 = acc[ai][bj][m][0], v1 = acc[ai][bj][m][1]; u32x4 w; w.x = pk2(v0[0], v0[1]); w.y = pk2(v0[2], v0[3]); w.z = pk2(v1[0], v1[1]); w.w = pk2(v1[2], v1[3]);
                        *(u32x4*)(O + off + bj * HALF) = w; }
                    EPI_FENCE(); }
        } else {
            const unsigned off0 = row0 * 512u + (unsigned)((u.pn - 3) * HALF + wc * 32 + 8 * fq);
#pragma unroll
            for (int ai = 0; ai < 2; ++ai)
#pragma unroll
                for (int m = 0; m < 4; ++m) { const unsigned off = off0 + (unsigned)(ai * HALF + m * 16) * 512u; float r[8];
#pragma unroll
                    for (int n = 0; n < 2; ++n)
#pragma unroll
                        for (int e = 0; e < 4; ++e) r[n * 4 + e] = acc[ai][0][m][n][e] * sigmoid_f(acc[ai][1][m][n][e]);
                    *(u32x4*)(G + off) = pack8(r); EPI_FENCE(); }
        }
    }
};
struct EpiOddQKV {
    static constexpr bool PERM = true, AFTER_DRAIN = false;
    bf16_t *Q, *K, *V, *G; const float *gq, *gk; const f32x2* rope  ; LAS float* xch;
    __device__ __forceinline__ void operator()(const f32x4 (&acc)[2][2][4][2], const Unit& u, int wr, int wc, int fr_, int fq_) const {
        int fr = fr_, fq = fq_; asm volatile("" : "+v"(fr), "+v"(fq));
        const unsigned row0 = (unsigned)(u.pm * BM + wr * 64 + fr);
        if (u.pn >= 3) {
            const unsigned off0 = row0 * 512u + (unsigned)((u.pn - 3) * HALF + wc * 32 + 8 * fq);
#pragma unroll
            for (int ai = 0; ai < 2; ++ai)
#pragma unroll
                for (int m = 0; m < 4; ++m) { const unsigned off = off0 + (unsigned)(ai * HALF + m * 16) * 512u; float r[8];
#pragma unroll
                    for (int n = 0; n < 2; ++n)
#pragma unroll
                        for (int e = 0; e < 4; ++e) r[n * 4 + e] = acc[ai][0][m][n][e] * sigmoid_f(acc[ai][1][m][n][e]);
                    *(u32x4*)(G + off) = pack8(r); EPI_FENCE(); }
            return;
        }
        const int wid = wr * 4 + wc;
        float ps[2][4][2];
#pragma unroll
        for (int ai = 0; ai < 2; ++ai)
#pragma unroll
            for (int m = 0; m < 4; ++m)
#pragma unroll
                for (int bj = 0; bj < 2; ++bj) { const f32x4 a = acc[ai][bj][m][0], b = acc[ai][bj][m][1];
                    float s_ = (a[0] * a[0] + a[1] * a[1]) + (a[2] * a[2] + a[3] * a[3]) + (b[0] * b[0] + b[1] * b[1]) + (b[2] * b[2] + b[3] * b[3]);
                    s_ += swz<0x401F>(s_);
                    { auto rr = __builtin_amdgcn_permlane32_swap(__float_as_uint(s_), __float_as_uint(s_), false, false); s_ = __uint_as_float(rr[0]) + __uint_as_float(rr[1]); }
                    ps[ai][m][bj] = s_;
                    if (fq == 0) xch[(((wid * 2 + ai) * 4 + m) * 2 + bj) * 16 + fr] = s_; }
        asm volatile("s_waitcnt lgkmcnt(0)\n\ts_barrier" ::: "memory");
        const int pw_ = wr * 4 + (wc ^ 1);
        const bool lat = (u.pm % 33) != 32; const int t0 = (int)row0 - (u.pm / 33) * SEQT;
        const int d0 = 32 * (wc & 1) + 8 * fq;
        float gqv[8], gkv[8];
        { const f32x4 x0 = *(const f32x4*)(gq + d0), x1 = *(const f32x4*)(gq + d0 + 4), y0 = *(const f32x4*)(gk + d0), y1 = *(const f32x4*)(gk + d0 + 4);
#pragma unroll
          for (int e = 0; e < 4; ++e) { gqv[e] = x0[e]; gqv[4 + e] = x1[e]; gkv[e] = y0[e]; gkv[4 + e] = y1[e]; } }
#pragma unroll
        for (int ai = 0; ai < 2; ++ai)
#pragma unroll
            for (int m = 0; m < 4; ++m) { const unsigned rr_ = (unsigned)(ai * HALF + m * 16); const int t = t0 + (int)rr_;
                f32x4 c01 = {1.f, 0.f, 1.f, 0.f}, c23 = {1.f, 0.f, 1.f, 0.f};
                if (lat) { const int pos = (wc & 1) ? (t & 63) : (t >> 6); const f32x4* rp = (const f32x4*)(rope + pos * 16 + 4 * fq); c01 = rp[0]; c23 = rp[1]; }
#pragma unroll
                for (int bj = 0; bj < 2; ++bj) { const f32x4 a = acc[ai][bj][m][0], b = acc[ai][bj][m][1];
                    float v[8] = {a[0], a[1], a[2], a[3], b[0], b[1], b[2], b[3]};
                    if (u.pn == 2 && bj == 1) {
                        *(u32x4*)(V + (size_t)(row0 + rr_) * 128 + wc * 32 + 8 * fq) = pack8(v); continue; }
                    const float tot = ps[ai][m][bj] + xch[(((pw_ * 2 + ai) * 4 + m) * 2 + bj) * 16 + fr];
                    const float rstd = 1.f / sqrtf(tot * (1.f / 64.f) + EPS);
                    const bool isq = (u.pn < 2); const float sc_ = isq ? C2_GQA : 1.f;
                    float o[8];
#pragma unroll
                    for (int p = 0; p < 4; ++p) { const float x0 = v[2 * p] * rstd * (isq ? gqv[2 * p] : gkv[2 * p]), x1 = v[2 * p + 1] * rstd * (isq ? gqv[2 * p + 1] : gkv[2 * p + 1]);
                        const float cs = (p < 2) ? c01[2 * p] : c23[2 * p - 4], sn = (p < 2) ? c01[2 * p + 1] : c23[2 * p - 3];
                        o[2 * p] = (x0 * cs - x1 * sn) * sc_; o[2 * p + 1] = (x0 * sn + x1 * cs) * sc_; }
                    if (isq) *(u32x4*)(Q + (size_t)(row0 + rr_) * 512 + u.pn * BM + bj * HALF + wc * 32 + 8 * fq) = pack8(o);
                    else *(u32x4*)(K + (size_t)(row0 + rr_) * 128 + wc * 32 + 8 * fq) = pack8(o); }
                EPI_FENCE(); }
    }
};
struct EpiEvenIn {
    static constexpr bool PERM = true, AFTER_DRAIN = false;
    bf16_t *SB, *CX, *QAN, *KVAN, *KR; const float *gq, *gkv; const f32x2* rope  ; LAS float* xch;
    __device__ __forceinline__ void operator()(const f32x4 (&acc)[2][2][4][2], const Unit& u, int wr, int wc, int fr_, int fq_) const {
        int fr = fr_, fq = fq_; asm volatile("" : "+v"(fr), "+v"(fq));
        const unsigned row0 = (unsigned)(u.pm * BM + wr * 64 + fr);
        if (u.pn < 2) {
            const unsigned off0 = row0 * 512u + (unsigned)(u.pn * BM + wc * 32 + 8 * fq);
#pragma unroll
            for (int ai = 0; ai < 2; ++ai)
#pragma unroll
                for (int m = 0; m < 4; ++m) { const unsigned off = off0 + (unsigned)(ai * HALF + m * 16) * 512u;
#pragma unroll
                    for (int bj = 0; bj < 2; ++bj) { const f32x4 v0 = acc[ai][bj][m][0], v1 = acc[ai][bj][m][1]; u32x4 w; w.x = pk2(v0[0], v0[1]); w.y = pk2(v0[2], v0[3]); w.z = pk2(v1[0], v1[1]); w.w = pk2(v1[2], v1[3]);
                        *(u32x4*)(SB + off + bj * HALF) = w; }
                    EPI_FENCE(); }
            return;
        }
        if (u.pn < 6) {
            const unsigned off0 = row0 * 512u + (unsigned)((u.pn - 2) * HALF + wc * 32 + 8 * fq);
#pragma unroll
            for (int ai = 0; ai < 2; ++ai)
#pragma unroll
                for (int m = 0; m < 4; ++m) { const unsigned off = off0 + (unsigned)(ai * HALF + m * 16) * 512u; float r[8];
#pragma unroll
                    for (int n = 0; n < 2; ++n)
#pragma unroll
                        for (int e = 0; e < 4; ++e) r[n * 4 + e] = acc[ai][0][m][n][e] * acc[ai][1][m][n][e];
                    *(u32x4*)(CX + off) = pack8(r); EPI_FENCE(); }
            return;
        }
        const bool isq = (u.pn == 6);
        const int wid = wr * 4 + wc;
        float ps[2][4];
#pragma unroll
        for (int ai = 0; ai < 2; ++ai)
#pragma unroll
            for (int m = 0; m < 4; ++m) { float s_ = 0.f;
#pragma unroll
                for (int bj = 0; bj < 2; ++bj) { if (bj == 1 && !isq) continue; const f32x4 a = acc[ai][bj][m][0], b = acc[ai][bj][m][1];
                    s_ += (a[0] * a[0] + a[1] * a[1]) + (a[2] * a[2] + a[3] * a[3]) + (b[0] * b[0] + b[1] * b[1]) + (b[2] * b[2] + b[3] * b[3]); }
                s_ += swz<0x401F>(s_);
                { auto rr = __builtin_amdgcn_permlane32_swap(__float_as_uint(s_), __float_as_uint(s_), false, false); s_ = __uint_as_float(rr[0]) + __uint_as_float(rr[1]); }
                ps[ai][m] = s_;
                if (fq == 0) xch[((wid * 2 + ai) * 4 + m) * 16 + fr] = s_; }
        asm volatile("s_waitcnt lgkmcnt(0)\n\ts_barrier" ::: "memory");
        const bool lat = (u.pm % 33) != 32; const int t0 = (int)row0 - (u.pm / 33) * SEQT;
        const float invn = isq ? (1.f / 256.f) : (1.f / 128.f);
        const float* gp = (isq ? gq : gkv) + wc * 32 + 8 * fq;
#pragma unroll
        for (int ai = 0; ai < 2; ++ai)
#pragma unroll
            for (int m = 0; m < 4; ++m) { const unsigned rr_ = (unsigned)(ai * HALF + m * 16);
                float tot = 0.f;
#pragma unroll
                for (int w4 = 0; w4 < 4; ++w4) tot += xch[(((wr * 4 + w4) * 2 + ai) * 4 + m) * 16 + fr];
                const float rstd = 1.f / sqrtf(tot * invn + EPS);
#pragma unroll
                for (int bj = 0; bj < 2; ++bj) { const f32x4 a = acc[ai][bj][m][0], b = acc[ai][bj][m][1];
                    if (isq || bj == 0) {
                        const f32x4 g0 = *(const f32x4*)(gp + bj * HALF), g1 = *(const f32x4*)(gp + bj * HALF + 4);
                        float o[8] = {a[0] * rstd * g0[0], a[1] * rstd * g0[1], a[2] * rstd * g0[2], a[3] * rstd * g0[3], b[0] * rstd * g1[0], b[1] * rstd * g1[1], b[2] * rstd * g1[2], b[3] * rstd * g1[3]};
                        if (isq) *(u32x4*)(QAN + (size_t)(row0 + rr_) * 256 + bj * HALF + wc * 32 + 8 * fq) = pack8(o);
                        else *(u32x4*)(KVAN + (size_t)(row0 + rr_) * 128 + wc * 32 + 8 * fq) = pack8(o);
                    } else if (wc == 0) {
                        const int t = t0 + (int)rr_;
                        f32x4 c01 = {1.f, 0.f, 1.f, 0.f}, c23 = {1.f, 0.f, 1.f, 0.f};
                        if (lat) { const int pos = (fq < 2) ? (t >> 6) : (t & 63); const f32x4* rp = (const f32x4*)(rope + pos * 16 + 4 * (fq & 1)); c01 = rp[0]; c23 = rp[1]; }
                        float o[8] = {a[0] * c01[0] - a[1] * c01[1], a[0] * c01[1] + a[1] * c01[0], a[2] * c01[2] - a[3] * c01[3], a[2] * c01[3] + a[3] * c01[2],
                                      b[0] * c23[0] - b[1] * c23[1], b[0] * c23[1] + b[1] * c23[0], b[2] * c23[2] - b[3] * c23[3], b[2] * c23[3] + b[3] * c23[2]};
                        const u32x4 kw = pack8(o); bf16_t* kp = KR + (size_t)(row0 + rr_) * 768 + 64 + 8 * fq;
#pragma unroll
                        for (int h = 0; h < 8; ++h) *(u32x4*)(kp + h * 96) = kw; } }
                EPI_FENCE(); }
    }
};
template <int MODE> struct EpiResidNorm {
    static constexpr bool PERM = true, AFTER_DRAIN = false;
    bf16_t* H; const float* gate; float* xbuf; unsigned* cnt; LAS float* xch; bf16_t* A; const float* ng; const float* modsh; float* out; float coef;
    __device__ __forceinline__ void operator()(f32x4 (&acc)[2][2][4][2], const Unit& u, int wr, int wc, int fr_, int fq_) const {
        int fr = fr_, fq = fq_; asm volatile("" : "+v"(fr), "+v"(fq));
        const unsigned colp = (unsigned)(u.pn * BM + wc * 32 + 8 * fq), rloc = (unsigned)(wr * 64 + fr);
        const int mi = row_mi(u.pm), wid = wr * 4 + wc;
        const float* gp = gate + (unsigned)mi * 9 * DM + colp;
        float ps[2][4];
#pragma unroll
        for (int ai = 0; ai < 2; ++ai)
#pragma unroll
            for (int m = 0; m < 4; ++m) ps[ai][m] = 0.f;
#pragma unroll
        for (int bj = 0; bj < 2; ++bj) { const f32x4 gv0 = *(const f32x4*)(gp + bj * HALF) * coef, gv1 = *(const f32x4*)(gp + bj * HALF + 4) * coef;
#pragma unroll
            for (int ai = 0; ai < 2; ++ai) { u32x4 hb[4];
#pragma unroll
                for (int m = 0; m < 4; ++m) hb[m] = *(const u32x4*)(H + (((unsigned)u.pm * BM + rloc + (unsigned)(ai * HALF + m * 16)) * DM + colp + bj * HALF));
#pragma unroll
                for (int m = 0; m < 4; ++m) { float h[8]; unpack8(hb[m], h);
                    const f32x4 d0 = gv0 * acc[ai][bj][m][0], d1 = gv1 * acc[ai][bj][m][1];
                    const f32x4 h0 = {h[0] + d0[0], h[1] + d0[1], h[2] + d0[2], h[3] + d0[3]}, h1 = {h[4] + d1[0], h[5] + d1[1], h[6] + d1[2], h[7] + d1[3]};
                    acc[ai][bj][m][0] = h0; acc[ai][bj][m][1] = h1;
                    ps[ai][m] += (h0[0] * h0[0] + h0[1] * h0[1]) + (h0[2] * h0[2] + h0[3] * h0[3]) + (h1[0] * h1[0] + h1[1] * h1[1]) + (h1[2] * h1[2] + h1[3] * h1[3]); }
                EPI_FENCE(); }
            EPI_FENCE(); }
#pragma unroll
        for (int ai = 0; ai < 2; ++ai)
#pragma unroll
            for (int m = 0; m < 4; ++m) { float s_ = ps[ai][m]; s_ += swz<0x401F>(s_);
                { auto rr = __builtin_amdgcn_permlane32_swap(__float_as_uint(s_), __float_as_uint(s_), false, false); s_ = __uint_as_float(rr[0]) + __uint_as_float(rr[1]); }
                if (fq == 0) xch[((wid * 2 + ai) * 4 + m) * 16 + fr] = s_; }
        asm volatile("s_waitcnt lgkmcnt(0)\n\ts_barrier" ::: "memory");
        if (wc == 0 && fq == 0) {
#pragma unroll
            for (int ai = 0; ai < 2; ++ai)
#pragma unroll
                for (int m = 0; m < 4; ++m) { float tot = 0.f;
#pragma unroll
                    for (int w4 = 0; w4 < 4; ++w4) tot += xch[(((wr * 4 + w4) * 2 + ai) * 4 + m) * 16 + fr];
                    __hip_atomic_store(xbuf + (((unsigned)u.pm * BM + rloc + (unsigned)(ai * HALF + m * 16)) * 4u + (unsigned)u.pn), tot, __ATOMIC_RELAXED, __HIP_MEMORY_SCOPE_AGENT); } }
        asm volatile("s_waitcnt vmcnt(0) lgkmcnt(0)\n\ts_barrier" ::: "memory");
        if (wid == 0) {
            if (fr == 0 && fq == 0) __hip_atomic_fetch_add(cnt + 64 * u.pm, 1u, __ATOMIC_RELAXED, __HIP_MEMORY_SCOPE_AGENT);
            unsigned it_ = 0;
            while ((unsigned)__builtin_amdgcn_readfirstlane(__hip_atomic_load(cnt + 64 * u.pm, __ATOMIC_RELAXED, __HIP_MEMORY_SCOPE_AGENT)) < 4u) { if (++it_ > (1u << 20)) break; __builtin_amdgcn_s_sleep(2); }
            __builtin_amdgcn_fence(__ATOMIC_ACQUIRE, "agent");
        }
        asm volatile("s_waitcnt vmcnt(0) lgkmcnt(0)\n\ts_barrier" ::: "memory");
        float rstd[2][4];
#pragma unroll
        for (int ai = 0; ai < 2; ++ai)
#pragma unroll
            for (int m = 0; m < 4; ++m) { const float* sl = xbuf + (((unsigned)u.pm * BM + rloc + (unsigned)(ai * HALF + m * 16)) * 4u); float tot = 0.f;
#pragma unroll
                for (int k4 = 0; k4 < 4; ++k4) tot += __hip_atomic_load(sl + k4, __ATOMIC_RELAXED, __HIP_MEMORY_SCOPE_AGENT);
                rstd[ai][m] = 1.f / sqrtf(tot * (1.f / DM) + EPS); EPI_FENCE(); }
        const unsigned orow0 = (unsigned)((u.pm / 33) * SEQ + (u.pm % 33) * BM);
#pragma unroll
        for (int bj = 0; bj < 2; ++bj) {
            float g8[8], sh8[8], sc8[8];
            ldf8(ng + colp + bj * HALF, g8);
            if (MODE == 1) { const float* mp = modsh + (unsigned)mi * 9 * DM + colp + bj * HALF; ldf8(mp, sh8); ldf8(mp + DM, sc8); }
#pragma unroll
            for (int ai = 0; ai < 2; ++ai)
#pragma unroll
                for (int m = 0; m < 4; ++m) { const unsigned rr = rloc + (unsigned)(ai * HALF + m * 16); const f32x4 h0 = acc[ai][bj][m][0], h1 = acc[ai][bj][m][1]; const float r_ = rstd[ai][m];
                    float h[8] = {h0[0], h0[1], h0[2], h0[3], h1[0], h1[1], h1[2], h1[3]};
                    if (MODE == 1) { float o[8];
#pragma unroll
                        for (int i = 0; i < 8; ++i) o[i] = h[i] * r_ * g8[i] * (sc8[i] + 1.f) + sh8[i];
                        *(u32x4*)(H + (((unsigned)u.pm * BM + rr) * DM + colp + bj * HALF)) = pack8(h);
                        *(u32x4*)(A + (((unsigned)u.pm * BM + rr) * DM + colp + bj * HALF)) = pack8(o); }
                    else { float* op = out + ((orow0 + rr) * DM + colp + bj * HALF);
                        *(f32x4*)op = (f32x4){h[0] * r_ * g8[0], h[1] * r_ * g8[1], h[2] * r_ * g8[2], h[3] * r_ * g8[3]};
                        *(f32x4*)(op + 4) = (f32x4){h[4] * r_ * g8[4], h[5] * r_ * g8[5], h[6] * r_ * g8[6], h[7] * r_ * g8[7]}; }
                    EPI_FENCE(); }
            EPI_FENCE(); }
    }
};
struct EpiQb {
    static constexpr bool PERM = false, AFTER_DRAIN = false;
    bf16_t* Q; const f32x2* rope  ;
    __device__ __forceinline__ void operator()(const f32x4 (&acc)[2][2][4][2], const Unit& u, int wr, int wc, int fr_, int fq_) const {
        int fr = fr_, fq = fq_; asm volatile("" : "+v"(fr), "+v"(fq));
        const int row0 = u.pm * BM + wr * 64 + fr, col0 = u.pn * BM + wc * 32 + 4 * fq;
        const bool lat = (u.pm % 33) != 32;
        const int t0 = row0 - (u.pm / 33) * SEQT;
#pragma unroll
        for (int bj = 0; bj < 2; ++bj)
#pragma unroll
            for (int n = 0; n < 2; ++n) { const int col = col0 + bj * HALF + n * 16; const int d = col % 96; const bool rot = (d >= 64) && lat;
                const int i0 = (d - 64) >> 1, f0 = i0 & 7;
#pragma unroll
                for (int ai = 0; ai < 2; ++ai) {
#pragma unroll
                    for (int m = 0; m < 4; ++m) { const int rr = ai * HALF + m * 16; const int t = t0 + rr; f32x4 v = acc[ai][bj][m][n];
                        if (rot) { const int pos = (i0 < 8) ? (t >> 6) : (t & 63);
                            const f32x2 cs0 = rope[pos * 16 + f0], cs1 = rope[pos * 16 + f0 + 1];
                            v = (f32x4){v[0] * cs0.x - v[1] * cs0.y, v[0] * cs0.y + v[1] * cs0.x, v[2] * cs1.x - v[3] * cs1.y, v[2] * cs1.y + v[3] * cs1.x}; }
                        v = v * C2_MLA; u32x2 w; w.x = pk2(v[0], v[1]); w.y = pk2(v[2], v[3]);
                        *(u32x2*)(Q + (unsigned)(row0 + rr) * 768 + col) = w; }
                    EPI_FENCE(); } }
    }
};
struct EpiKVb {
    static constexpr bool PERM = false, AFTER_DRAIN = false;
    bf16_t* K; bf16_t* V;
    __device__ __forceinline__ void operator()(const f32x4 (&acc)[2][2][4][2], const Unit& u, int wr, int wc, int fr_, int fq_) const {
        int fr = fr_, fq = fq_; asm volatile("" : "+v"(fr), "+v"(fq));
        const int row0 = u.pm * BM + wr * 64 + fr, col0 = u.pn * BM + wc * 32 + 4 * fq;
#pragma unroll
        for (int bj = 0; bj < 2; ++bj)
#pragma unroll
            for (int n = 0; n < 2; ++n) { const int col = col0 + bj * HALF + n * 16; const int h = col >> 7, d = col & 127;
                bf16_t* base = (d < 64) ? (K + h * 96 + d) : (V + h * 64 + (d - 64)); const unsigned pitch = (d < 64) ? 768u : 512u;
#pragma unroll
                for (int ai = 0; ai < 2; ++ai) {
#pragma unroll
                    for (int m = 0; m < 4; ++m) { const f32x4 v = acc[ai][bj][m][n]; u32x2 w; w.x = pk2(v[0], v[1]); w.y = pk2(v[2], v[3]);
                        *(u32x2*)(base + (unsigned)(row0 + ai * HALF + m * 16) * pitch) = w; }
                    EPI_FENCE(); } }
    }
};

constexpr int A_NSLOT = 3, A_KSLOT = 12288, A_VSLOT = 8192;
constexpr int A_K = 0, A_V = A_NSLOT * A_KSLOT, A_WS = A_V + A_NSLOT * A_VSLOT, A_OST = A_WS + 2048, A_BYTES = A_OST + 8 * 4096;
static_assert(A_BYTES <= RING_BYTES, "attention LDS");
__device__ __forceinline__ int crow(int r, int hi) { return (r & 3) + 8 * (r >> 2) + 4 * hi; }
__device__ __forceinline__ void glds16(const void* gsrc, unsigned lds_dst) { unsigned keep;
    asm volatile("s_mov_b32 %0, m0\n\ts_mov_b32 m0, %2\n\ts_nop 0\n\tglobal_load_lds_dwordx4 %1, off\n\ts_mov_b32 m0, %0" : "=&s"(keep) : "v"(gsrc), "s"(lds_dst) : "memory"); }
__device__ __forceinline__ void pv(f32x16* o, int vb, bf16x8 pa0, bf16x8 pa1, bf16x8 pa2, bf16x8 pa3) {
#pragma unroll
    for (int d0 = 0; d0 < 2; ++d0) { s16x4 lo[4], hi[4];
#pragma unroll
        for (int ks = 0; ks < 4; ++ks) {
            asm volatile("ds_read_b64_tr_b16 %0,%1 offset:%c2" : "=&v"(lo[ks]) : "v"(vb), "i"(d0 * 4096 + ks * 1024) : "memory");
            asm volatile("ds_read_b64_tr_b16 %0,%1 offset:%c2" : "=&v"(hi[ks]) : "v"(vb), "i"(d0 * 4096 + ks * 1024 + 512) : "memory"); }
        asm volatile("s_waitcnt lgkmcnt(0)" ::: "memory"); __builtin_amdgcn_sched_barrier(0);
#define PK(k) (bf16x8){lo[k][0], lo[k][1], lo[k][2], lo[k][3], hi[k][0], hi[k][1], hi[k][2], hi[k][3]}
        o[d0] = __builtin_amdgcn_mfma_f32_32x32x16_bf16(pa0, PK(0), o[d0], 0, 0, 0);
        o[d0] = __builtin_amdgcn_mfma_f32_32x32x16_bf16(pa1, PK(1), o[d0], 0, 0, 0);
        o[d0] = __builtin_amdgcn_mfma_f32_32x32x16_bf16(pa2, PK(2), o[d0], 0, 0, 0);
        o[d0] = __builtin_amdgcn_mfma_f32_32x32x16_bf16(pa3, PK(3), o[d0], 0, 0, 0);
#undef PK
    }
}
template <int NKD>
__device__ __forceinline__ void attn_unit(const bf16_t* Qu, int qp, const bf16_t* Ku, int kp, const bf16_t* Vu, int vp, bf16_t* Ou, int op, int NT, LAS unsigned char* shm, const int wave_id) {
    const int wid = wave_id, lane = fresh_lane(), r32 = lane & 31, hi = lane >> 5;
    const unsigned lds0 = (unsigned)(uintptr_t)shm;
    LAS float* wsf = (LAS float*)(shm + A_WS) + wid * 64;
    const bf16_t* Qw = Qu + (size_t)(wid * 32) * qp;
    const bf16_t* ksrc = Ku + (size_t)lane * kp + wid * 8;
    const bf16_t* ksrc2 = Ku + (size_t)lane * kp + (8 + (wid & 3)) * 8;
    const bf16_t* vsrc = Vu + (size_t)(16 * (wid & 3) + (lane >> 2)) * vp + (wid >> 2) * 32 + (lane & 3) * 8;
    const unsigned kdst = lds0 + A_K + wid * 1024, kdst2 = lds0 + A_K + (8 + (wid & 3)) * 1024, vdst = lds0 + A_V + wid * 1024;
#define DMA_TILE(t, s) do { glds16(ksrc + (size_t)(t) * 64 * kp, (unsigned)__builtin_amdgcn_readfirstlane(kdst + (s) * A_KSLOT)); \
        if (NKD == 6) glds16(ksrc2 + (size_t)(t) * 64 * kp, (unsigned)__builtin_amdgcn_readfirstlane(kdst2 + (s) * A_KSLOT)); \
        glds16(vsrc + (size_t)(t) * 64 * vp, (unsigned)__builtin_amdgcn_readfirstlane(vdst + (s) * A_VSLOT)); } while (0)
    bf16x8 qr[NKD];
#pragma unroll
    for (int d0 = 0; d0 < NKD; ++d0) qr[d0] = *(const bf16x8*)(Qw + (size_t)r32 * qp + d0 * 16 + hi * 8);
    DMA_TILE(0, 0); if (NT > 1) DMA_TILE(1, 1);
    const int vb0 = (int)(lds0 + A_V) + ((lane >> 4) & 1) * 32 + (lane & 3) * 8 + (4 * hi + ((lane & 15) >> 2)) * 64;
    const LAS unsigned char* kp0 = shm + A_K + hi * 1024 + r32 * 16;
    float mhat = -INFINITY, l_reg = 0.f; f32x16 o[2]; o[0] = f32x16{}; o[1] = f32x16{};
    int sl = 0, sl2 = 2;
    for (int t = 0; t < NT; ++t) {
        if (t + 1 < NT) { if (NKD == 6) asm volatile("s_waitcnt vmcnt(3) lgkmcnt(0)\n\ts_barrier" ::: "memory"); else asm volatile("s_waitcnt vmcnt(2) lgkmcnt(0)\n\ts_barrier" ::: "memory"); }
        else asm volatile("s_waitcnt vmcnt(0) lgkmcnt(0)\n\ts_barrier" ::: "memory");
        if (t + 2 < NT) DMA_TILE(t + 2, sl2);
        f32x16 p0, p1;
        { const LAS unsigned char* kb = kp0 + sl * A_KSLOT;
#pragma unroll
          for (int d0 = 0; d0 < NKD; ++d0) {
              const bf16x8 b0 = *(const LAS bf16x8*)(kb + d0 * 2048), b1 = *(const LAS bf16x8*)(kb + d0 * 2048 + 512);
              if (d0 == 0) { p0 = __builtin_amdgcn_mfma_f32_32x32x16_bf16(b0, qr[0], f32x16{}, 0, 0, 0); p1 = __builtin_amdgcn_mfma_f32_32x32x16_bf16(b1, qr[0], f32x16{}, 0, 0, 0); }
              else { p0 = __builtin_amdgcn_mfma_f32_32x32x16_bf16(b0, qr[d0], p0, 0, 0, 0); p1 = __builtin_amdgcn_mfma_f32_32x32x16_bf16(b1, qr[d0], p1, 0, 0, 0); } } }
        float rm = __builtin_fmaxf(p0[0], p1[0]);
#pragma unroll
        for (int r = 1; r < 16; ++r) rm = __builtin_fmaxf(rm, __builtin_fmaxf(p0[r], p1[r]));
        { auto rr = __builtin_amdgcn_permlane32_swap(__float_as_uint(rm), __float_as_uint(rm), false, false); rm = __builtin_fmaxf(__uint_as_float(rr[0]), __uint_as_float(rr[1])); }
        if (__any(rm > mhat + 8.f)) {
            const float mn = __builtin_fmaxf(mhat, rm); const float f = __builtin_amdgcn_exp2f(mhat - mn); mhat = mn; l_reg *= f;
            if (hi == 0) wsf[r32] = f;
            asm volatile("s_waitcnt lgkmcnt(0)" ::: "memory");
#pragma unroll
            for (int r = 0; r < 16; ++r) { const float fr_ = wsf[crow(r, hi)]; o[0][r] *= fr_; o[1][r] *= fr_; }
        }
        float sacc = 0.f;
#pragma unroll
        for (int r = 0; r < 16; ++r) { p0[r] = __builtin_amdgcn_exp2f(p0[r] - mhat); p1[r] = __builtin_amdgcn_exp2f(p1[r] - mhat); sacc += p0[r] + p1[r]; }
        l_reg += sacc;
        u32x4 pw0, pw1, pw2, pw3;
        pw0 = (u32x4){pk2(p0[0], p0[1]), pk2(p0[2], p0[3]), pk2(p0[4], p0[5]), pk2(p0[6], p0[7])};
        pw1 = (u32x4){pk2(p0[8], p0[9]), pk2(p0[10], p0[11]), pk2(p0[12], p0[13]), pk2(p0[14], p0[15])};
        pw2 = (u32x4){pk2(p1[0], p1[1]), pk2(p1[2], p1[3]), pk2(p1[4], p1[5]), pk2(p1[6], p1[7])};
        pw3 = (u32x4){pk2(p1[8], p1[9]), pk2(p1[10], p1[11]), pk2(p1[12], p1[13]), pk2(p1[14], p1[15])};
        pv(o, vb0 + sl * A_VSLOT, __builtin_bit_cast(bf16x8, pw0), __builtin_bit_cast(bf16x8, pw1), __builtin_bit_cast(bf16x8, pw2), __builtin_bit_cast(bf16x8, pw3));
        sl = (sl == 2) ? 0 : sl + 1; sl2 = (sl2 == 2) ? 0 : sl2 + 1;
    }
    { auto rr = __builtin_amdgcn_permlane32_swap(__float_as_uint(l_reg), __float_as_uint(l_reg), false, false); l_reg = __uint_as_float(rr[0]) + __uint_as_float(rr[1]); }
    if (hi == 0) wsf[32 + r32] = l_reg;
    asm volatile("s_waitcnt lgkmcnt(0)" ::: "memory");
    LAS bf16_t* stg = (LAS bf16_t*)(shm + A_OST) + wid * 2048;
#pragma unroll
    for (int r = 0; r < 16; ++r) { const int orow = crow(r, hi); const float rl = __builtin_amdgcn_rcpf(wsf[32 + orow]);
        stg[orow * 64 + r32] = (bf16_t)f2bf(o[0][r] * rl); stg[orow * 64 + 32 + r32] = (bf16_t)f2bf(o[1][r] * rl); }
    asm volatile("s_waitcnt lgkmcnt(0)" ::: "memory");
    bf16_t* Ow = Ou + (size_t)(wid * 32) * op;
#pragma unroll
    for (int i = 0; i < 4; ++i) { const int row = i * 8 + (lane >> 3), ch = lane & 7; const u32x4 v = *(const LAS u32x4*)(stg + row * 64 + ch * 8); *(u32x4*)(Ow + (size_t)row * op + ch * 8) = v; }
    asm volatile("s_waitcnt vmcnt(0) lgkmcnt(0)\n\ts_barrier" ::: "memory");
#undef DMA_TILE
}


namespace tat {
using bf16 = unsigned short;
using bf16x8 = __attribute__((ext_vector_type(8))) short;
using s16x4 = __attribute__((ext_vector_type(4))) short;
using f32x16 = __attribute__((ext_vector_type(16))) float;
using u32x4 = __attribute__((ext_vector_type(4))) unsigned;
constexpr int D = 64, NW = 8, QBLK = 32, QB = QBLK * NW, KVBLK = 64;
__device__ __forceinline__ int crow(int r, int hi) { return (r & 3) + 8 * (r >> 2) + 4 * hi; }
#define SBAR() __builtin_amdgcn_sched_barrier(0)
constexpr int NSLOT=3, SLOTB=8192;
__device__ __forceinline__ unsigned f2bf_t(float f){unsigned u=__builtin_bit_cast(unsigned,f);return (u+0x7fffu+((u>>16)&1u))>>16;}
constexpr int KSLOTMAX=12288; constexpr int LDS_K=0, LDS_V=NSLOT*KSLOTMAX, LDS_WS=NSLOT*KSLOTMAX+NSLOT*SLOTB, LDS_OST=LDS_WS+NW*64*4, LDS_BYTES=LDS_OST+NW*4096;
constexpr float C2=0.125f*1.4426950408889634f;
__device__ __forceinline__ void glds16(const void*gsrc,unsigned lds_dst){unsigned keep;
  asm volatile("s_mov_b32 %0, m0\n\ts_mov_b32 m0, %2\n\ts_nop 0\n\tglobal_load_lds_dwordx4 %1, off\n\ts_mov_b32 m0, %0":"=&s"(keep):"v"(gsrc),"s"(lds_dst):"memory");}
__device__ __forceinline__ float max3f(float a,float b,float c){float r;asm("v_max3_f32 %0, %1, %2, %3":"=v"(r):"v"(a),"v"(b),"v"(c));return r;}
__device__ __forceinline__ float max2f(float a,float b){float r;asm("v_max_f32_e32 %0, %1, %2":"=v"(r):"v"(a),"v"(b));return r;}
__device__ __forceinline__ float fadd_s(float a,float b){float r;asm("v_add_f32_e32 %0, %1, %2":"=v"(r):"v"(a),"v"(b));return r;}
__device__ __forceinline__ float fsub_s(float a,float b){float r;asm("v_sub_f32_e32 %0, %1, %2":"=v"(r):"v"(a),"v"(b));return r;}
typedef float f32x2_t __attribute__((ext_vector_type(2))); typedef __bf16 bf16x2_t __attribute__((ext_vector_type(2)));
__device__ __forceinline__ unsigned cvtpk_s(float lo,float hi){f32x2_t v={lo,hi};bf16x2_t b=__builtin_convertvector(v,bf16x2_t);return __builtin_bit_cast(unsigned,b);}
#define WAIT_BAR(N) asm volatile("s_waitcnt vmcnt(" #N ") lgkmcnt(0)\n\ts_barrier":::"memory")

template<int NKD> __device__ __forceinline__ void qkt(f32x16&p0,f32x16&p1,const char*Kslot,const bf16x8*qr,const f32x16&negm,int r32,int hi){
  const char*kb=Kslot+hi*1024+r32*16;
  #pragma unroll
  for(int d0=0;d0<NKD;++d0){
    const bf16x8 b0=*reinterpret_cast<const bf16x8*>(kb+d0*2048);
    const bf16x8 b1=*reinterpret_cast<const bf16x8*>(kb+d0*2048+512);
    if(d0==0){p0=__builtin_amdgcn_mfma_f32_32x32x16_bf16(b0,qr[0],negm,0,0,0);p1=__builtin_amdgcn_mfma_f32_32x32x16_bf16(b1,qr[0],negm,0,0,0);}
    else{p0=__builtin_amdgcn_mfma_f32_32x32x16_bf16(b0,qr[d0],p0,0,0,0);p1=__builtin_amdgcn_mfma_f32_32x32x16_bf16(b1,qr[d0],p1,0,0,0);}}
}
typedef __attribute__((address_space(3))) const char* lds_cptr;
typedef short v4i16_t __attribute__((ext_vector_type(4)));
template<int NKD> __device__ __forceinline__ void kload8(bf16x8*kf,lds_cptr kp){
  if(NKD==6){ kf[8]=*(const __attribute__((address_space(3))) bf16x8*)(kp+8192); kf[9]=*(const __attribute__((address_space(3))) bf16x8*)(kp+8704); kf[10]=*(const __attribute__((address_space(3))) bf16x8*)(kp+10240); kf[11]=*(const __attribute__((address_space(3))) bf16x8*)(kp+10752); }
  kf[0]=*(const __attribute__((address_space(3))) bf16x8*)(kp);      kf[1]=*(const __attribute__((address_space(3))) bf16x8*)(kp+512);
  kf[2]=*(const __attribute__((address_space(3))) bf16x8*)(kp+2048); kf[3]=*(const __attribute__((address_space(3))) bf16x8*)(kp+2560);
  kf[4]=*(const __attribute__((address_space(3))) bf16x8*)(kp+4096); kf[5]=*(const __attribute__((address_space(3))) bf16x8*)(kp+4608);
  kf[6]=*(const __attribute__((address_space(3))) bf16x8*)(kp+6144); kf[7]=*(const __attribute__((address_space(3))) bf16x8*)(kp+6656);
}
__device__ __forceinline__ void kload2(bf16x8*kf,lds_cptr kp,int j){ kf[2*j]=*(const __attribute__((address_space(3))) bf16x8*)(kp+j*2048); kf[2*j+1]=*(const __attribute__((address_space(3))) bf16x8*)(kp+j*2048+512); }
__device__ __forceinline__ s16x4 vtr(lds_cptr p){ return __builtin_bit_cast(s16x4,__builtin_amdgcn_ds_read_tr16_b64_v4i16((__attribute__((address_space(3))) v4i16_t*)p)); }
__device__ __forceinline__ float rowmax(const f32x16&p0,const f32x16&p1){
  float a=max3f(p0[0],p0[1],p1[0]),b=max3f(p0[2],p0[3],p1[1]);a=max3f(a,p1[2],p1[3]);
  #pragma unroll
  for(int r=4;r<16;r+=4){a=max3f(a,p0[r],p0[r+1]);b=max3f(b,p0[r+2],p0[r+3]);a=max3f(a,p1[r],p1[r+1]);b=max3f(b,p1[r+2],p1[r+3]);}
  const float m=max2f(a,b);
  auto rr=__builtin_amdgcn_permlane32_swap(__float_as_uint(m),__float_as_uint(m),false,false);
  return max2f(__uint_as_float(rr[0]),__uint_as_float(rr[1]));
}
__device__ __forceinline__ void pv(f32x16*o,int vb,bf16x8 pa0,bf16x8 pa1,bf16x8 pa2,bf16x8 pa3){
  #pragma unroll
  for(int d0=0;d0<2;++d0){s16x4 lo[4],hi[4];
    #pragma unroll
    for(int ks=0;ks<4;++ks){
      asm volatile("ds_read_b64_tr_b16 %0,%1 offset:%c2":"=&v"(lo[ks]):"v"(vb),"i"(d0*4096+ks*1024):"memory");
      asm volatile("ds_read_b64_tr_b16 %0,%1 offset:%c2":"=&v"(hi[ks]):"v"(vb),"i"(d0*4096+ks*1024+512):"memory");}
    asm volatile("s_waitcnt lgkmcnt(0)":::"memory");SBAR();
    #define PK(k) (bf16x8){lo[k][0],lo[k][1],lo[k][2],lo[k][3],hi[k][0],hi[k][1],hi[k][2],hi[k][3]}
    o[d0]=__builtin_amdgcn_mfma_f32_32x32x16_bf16(pa0,PK(0),o[d0],0,0,0);
    o[d0]=__builtin_amdgcn_mfma_f32_32x32x16_bf16(pa1,PK(1),o[d0],0,0,0);
    o[d0]=__builtin_amdgcn_mfma_f32_32x32x16_bf16(pa2,PK(2),o[d0],0,0,0);
    o[d0]=__builtin_amdgcn_mfma_f32_32x32x16_bf16(pa3,PK(3),o[d0],0,0,0);
    #undef PK
  }
}
#ifndef ATTN_STORE16
#define ATTN_STORE16(p,v) (*(u32x4*)(p)=(v))
#endif
template<int THRL,int NKD,int QP,int KP,int VP,int OP> __device__ __forceinline__ void attn_unit(const bf16*Qu,const bf16*__restrict__ Ku,const bf16*__restrict__ Vu,bf16*Ou,const int NT,char*shm,const int wave_id){
  const int lane=fresh_lane(),r32=lane&31,hi=lane>>5; const int wid=wave_id;
  const bf16*Qw=Qu+(long)(wid*QBLK)*QP;
  const bf16*Kh=Ku,*Vh=Vu;
  const unsigned lds0=(unsigned)(uintptr_t)shm;
  float*wsf=(float*)(shm+LDS_WS)+wid*64;
  const bf16*ksrc=Kh+(long)lane*KP+wid*8; const bf16*ksrc2=Kh+(long)lane*KP+(8+(wid&3))*8;
  const bf16*vsrc=Vh+(long)(16*(wid&3)+(lane>>2))*VP+(wid>>2)*32+(lane&3)*8;
  const unsigned kdst=lds0+LDS_K+wid*1024, kdst2=lds0+LDS_K+(8+(wid&3))*1024, vdst=lds0+LDS_V+wid*1024;
  #define KOFF(s_) ((NKD==6)?((s_)+((s_)>>1)):(s_))
  #define DMA_K(t,slot) do{ glds16(ksrc+(long)(t)*KVBLK*KP,(unsigned)__builtin_amdgcn_readfirstlane(kdst+KOFF(slot))); if(NKD==6) glds16(ksrc2+(long)(t)*KVBLK*KP,(unsigned)__builtin_amdgcn_readfirstlane(kdst2+KOFF(slot))); }while(0)
  #define WAIT_KV() do{ if(NKD==6){WAIT_BAR(3);} else {WAIT_BAR(2);} }while(0)
  #define DMA_V(t,slot) glds16(vsrc+(long)(t)*KVBLK*VP,(unsigned)__builtin_amdgcn_readfirstlane(vdst+(slot)))
  const int vb0=(int)(lds0+LDS_V)+((lane>>4)&1)*32+(lane&3)*8+(4*hi+((lane&15)>>2))*64;
  const char*Kbase=shm+LDS_K; bf16x8 kf[2*NKD];
  const lds_cptr shm3=(lds_cptr)shm; const lds_cptr kp0=shm3+LDS_K+hi*1024+r32*16; const lds_cptr vp0=shm3+LDS_V+((lane>>4)&1)*32+(lane&3)*8+(4*hi+((lane&15)>>2))*64;
  DMA_K(0,0);DMA_V(0,0);DMA_K(1,SLOTB);
  bf16x8 qr[NKD];
  #pragma unroll
  for(int d0=0;d0<NKD;++d0)qr[d0]=*reinterpret_cast<const bf16x8*>(&Qw[(long)r32*QP+d0*16+hi*8]);
  float mhat=0.f,l_reg=0.f;f32x16 o[2];o[0]=f32x16{};o[1]=f32x16{};f32x16 negm=f32x16{};asm volatile("":"+v"(negm));
  #define CMASK(P0,P1,t) do{}while(0)
  bool resc=false;
  #define START(P0,P1) do{ const float rm=rowmax(P0,P1); resc=false; \
    { const float dl=rm; mhat=fadd_s(mhat,dl); \
      _Pragma("unroll") for(int r=0;r<16;++r){P0[r]=fsub_s(P0[r],dl);P1[r]=fsub_s(P1[r],dl);} \
      _Pragma("unroll") for(int r=0;r<16;++r)negm[r]=-mhat; asm volatile("":"+v"(negm)); } \
    _Pragma("unroll") for(int r=0;r<16;++r)P0[r]=__builtin_amdgcn_exp2f(P0[r]); }while(0)
  #define RESC() do{ if(resc){ asm volatile("s_waitcnt lgkmcnt(0)":::"memory"); \
      _Pragma("unroll") for(int d_=0;d_<2;++d_) _Pragma("unroll") for(int r=0;r<16;++r)o[d_][r]*=wsf[crow(r,hi)]; } }while(0)
  f32x16 pA0,pA1,pB0,pB1;
  int sl_prev=0,sl_cur=0,sl_next=SLOTB;
  #define ROT() do{sl_prev=sl_cur;sl_cur=sl_next;sl_next=(sl_next==(NSLOT-1)*SLOTB)?0:sl_next+SLOTB;}while(0)
  DMA_K(2,2*SLOTB);
  WAIT_BAR(3);
  qkt<NKD>(pA0,pA1,Kbase,qr,negm,r32,hi);asm volatile("s_nop 15\n\ts_nop 7":"+v"(pA0),"+v"(pA1));CMASK(pA0,pA1,0);
  START(pA0,pA1);
  _Pragma("unroll") for(int r=0;r<16;++r)pA1[r]=__builtin_amdgcn_exp2f(pA1[r]);
  WAIT_BAR(0);
  DMA_K(3,0);DMA_V(1,SLOTB);
  ROT();
  kload8<NKD>(kf,kp0+KOFF(sl_cur));
  WAIT_KV();
  s16x4 vlo[8],vhi[8]; u32x4 pw0,pw1,pw2,pw3;
  #define PKW(P,B) cvtpk_s(P[B],P[B+1])
  #define PAF(k) __builtin_bit_cast(bf16x8,pw##k)
  #define VFR(i) (bf16x8){vlo[i][0],vlo[i][1],vlo[i][2],vlo[i][3],vhi[i][0],vhi[i][1],vhi[i][2],vhi[i][3]}
  #define PIN(x) asm volatile("":"+v"(x))
  #define MX3(a,b,c) __builtin_fmaxf(__builtin_fmaxf((a),(b)),(c))
  #define GAPA(MF,A0,A1,A2,A3,W0,W1,PW) do{ MF; sacc+=A0; sacc+=A1; sacc+=A2; sacc+=A3; PIN(sacc); W0; W1; PIN(PW); SBAR(); }while(0)
  #define EX(v) __builtin_amdgcn_exp2f(v)
  #define GAPB(MF,X,B) do{ MF; X[B]=EX(X[B]); X[B+1]=EX(X[B+1]); X[B+2]=EX(X[B+2]); X[B+3]=EX(X[B+3]); PIN(X); SBAR(); }while(0)
  #define VRD(i) do{ vlo[i]=vtr(vp_+(((i)>>2)*4096+((i)&3)*1024)); vhi[i]=vtr(vp_+(((i)>>2)*4096+((i)&3)*1024+512)); }while(0)
  #define KRD(G,j) do{ if(G){ kload2(kf,kp0+KOFF(sl_next),j); SBAR(); } }while(0)
  #define STEP(C0,C1,P0,P1,t,GK,GV,GL) do{ SBAR(); \
    const lds_cptr vp_=vp0+sl_prev; \
    VRD(0); SBAR(); float sacc=(P0[0]+P0[1]); \
    GAPA(C0=__builtin_amdgcn_mfma_f32_32x32x16_bf16(kf[0],qr[0],negm,0,0,0), P0[2],P0[3],P0[4],P0[5],     pw0[0]=PKW(P0,0), pw0[1]=PKW(P0,2), pw0); \
    VRD(4); SBAR(); GAPA(C1=__builtin_amdgcn_mfma_f32_32x32x16_bf16(kf[1],qr[0],negm,0,0,0), P0[6],P0[7],P0[8],P0[9],     pw0[2]=PKW(P0,4), pw0[3]=PKW(P0,6), pw0); \
    VRD(1); SBAR(); GAPA(C0=__builtin_amdgcn_mfma_f32_32x32x16_bf16(kf[2],qr[1],C0,0,0,0),   P0[10],P0[11],P0[12],P0[13], pw1[0]=PKW(P0,8), pw1[1]=PKW(P0,10), pw1); \
    VRD(5); SBAR(); GAPA(C1=__builtin_amdgcn_mfma_f32_32x32x16_bf16(kf[3],qr[1],C1,0,0,0),   P0[14],P0[15],P1[0],P1[1],   pw1[2]=PKW(P0,12),pw1[3]=PKW(P0,14), pw1); \
    VRD(2); SBAR(); GAPA(C0=__builtin_amdgcn_mfma_f32_32x32x16_bf16(kf[4],qr[2],C0,0,0,0),   P1[2],P1[3],P1[4],P1[5],     pw2[0]=PKW(P1,0), pw2[1]=PKW(P1,2), pw2); \
    VRD(6); SBAR(); GAPA(C1=__builtin_amdgcn_mfma_f32_32x32x16_bf16(kf[5],qr[2],C1,0,0,0),   P1[6],P1[7],P1[8],P1[9],     pw2[2]=PKW(P1,4), pw2[3]=PKW(P1,6), pw2); \
    VRD(3); SBAR(); GAPA(C0=__builtin_amdgcn_mfma_f32_32x32x16_bf16(kf[6],qr[3],C0,0,0,0),   P1[10],P1[11],P1[12],P1[13], pw3[0]=PKW(P1,8), pw3[1]=PKW(P1,10), pw3); \
    VRD(7); SBAR(); GAPA(C1=__builtin_amdgcn_mfma_f32_32x32x16_bf16(kf[7],qr[3],C1,0,0,0),   P1[14],P1[15],0.f,0.f,       pw3[2]=PKW(P1,12),pw3[3]=PKW(P1,14), pw3); \
    if(NKD==6){ C0=__builtin_amdgcn_mfma_f32_32x32x16_bf16(kf[(NKD==6)?8:0],qr[(NKD==6)?4:0],C0,0,0,0); C1=__builtin_amdgcn_mfma_f32_32x32x16_bf16(kf[(NKD==6)?9:0],qr[(NKD==6)?4:0],C1,0,0,0); \
      C0=__builtin_amdgcn_mfma_f32_32x32x16_bf16(kf[(NKD==6)?10:0],qr[(NKD==6)?5:0],C0,0,0,0); C1=__builtin_amdgcn_mfma_f32_32x32x16_bf16(kf[(NKD==6)?11:0],qr[(NKD==6)?5:0],C1,0,0,0); SBAR(); } \
    l_reg+=sacc; \
    if(GK){DMA_K((t)+3,sl_cur);} if(GV){DMA_V((t)+1,sl_next);} \
    CMASK(C0,C1,t); \
    { float a=MX3(C0[0],C0[1],C1[0]),b=MX3(C0[2],C0[3],C1[1]); a=MX3(a,C1[2],C1[3]); \
      _Pragma("unroll") for(int r=4;r<16;r+=4){a=MX3(a,C0[r],C0[r+1]);b=MX3(b,C0[r+2],C0[r+3]);a=MX3(a,C1[r],C1[r+1]);b=MX3(b,C1[r+2],C1[r+3]);} \
      float rm=__builtin_fmaxf(a,b); { auto rr=__builtin_amdgcn_permlane32_swap(__float_as_uint(rm),__float_as_uint(rm),false,false); rm=__builtin_fmaxf(__uint_as_float(rr[0]),__uint_as_float(rr[1])); } \
      resc=false; \
      if(__builtin_expect(__any(rm>(float)THRL),0)){ const float dl=__builtin_fmaxf(rm,0.f); mhat+=dl; \
        _Pragma("unroll") for(int r=0;r<16;++r){C0[r]-=dl;C1[r]-=dl;} \
        _Pragma("unroll") for(int r=0;r<16;++r)negm[r]=-mhat; asm volatile("":"+v"(negm)); \
        const float f=__builtin_amdgcn_exp2f(-dl); l_reg*=f; if(hi==0)wsf[r32]=f; resc=true; } } \
    SBAR(); \
    GAPB(o[0]=__builtin_amdgcn_mfma_f32_32x32x16_bf16(PAF(0),VFR(0),o[0],0,0,0), C0,0); \
    GAPB(o[1]=__builtin_amdgcn_mfma_f32_32x32x16_bf16(PAF(0),VFR(4),o[1],0,0,0), C0,4); \
    KRD(GL,0); GAPB(o[0]=__builtin_amdgcn_mfma_f32_32x32x16_bf16(PAF(1),VFR(1),o[0],0,0,0), C0,8); \
    KRD(GL,1); GAPB(o[1]=__builtin_amdgcn_mfma_f32_32x32x16_bf16(PAF(1),VFR(5),o[1],0,0,0), C0,12); \
    KRD(GL,2); GAPB(o[0]=__builtin_amdgcn_mfma_f32_32x32x16_bf16(PAF(2),VFR(2),o[0],0,0,0), C1,0); \
    KRD(GL,3); GAPB(o[1]=__builtin_amdgcn_mfma_f32_32x32x16_bf16(PAF(2),VFR(6),o[1],0,0,0), C1,4); \
    if(NKD==6){KRD(GL,(NKD==6)?4:0);} GAPB(o[0]=__builtin_amdgcn_mfma_f32_32x32x16_bf16(PAF(3),VFR(3),o[0],0,0,0), C1,8); \
    if(NKD==6){KRD(GL,(NKD==6)?5:0);} GAPB(o[1]=__builtin_amdgcn_mfma_f32_32x32x16_bf16(PAF(3),VFR(7),o[1],0,0,0), C1,12); \
    }while(0)
  int t=1;
  #undef CMASK
  #define CMASK(P0,P1,t) do{}while(0)
  for(;t+5<NT;t+=2){
    STEP(pB0,pB1,pA0,pA1,t,true,true,true);     WAIT_KV(); RESC(); ROT();
    STEP(pA0,pA1,pB0,pB1,t+1,true,true,true);   WAIT_KV(); RESC(); ROT();
  }
  #undef CMASK
  #define CMASK(P0,P1,t) do{}while(0)
  #define ENDW(tt) do{ if((tt)+3<NT){WAIT_KV();} else if((tt)+2<NT){WAIT_BAR(1);} else {WAIT_BAR(0);} }while(0)
  for(;t+1<NT;t+=2){
    STEP(pB0,pB1,pA0,pA1,t,(t+3<NT),(t+1<NT),(t+1<NT));       ENDW(t);   RESC(); ROT();
    STEP(pA0,pA1,pB0,pB1,t+1,(t+4<NT),(t+2<NT),(t+2<NT));     ENDW(t+1); RESC(); ROT();
  }
  STEP(pB0,pB1,pA0,pA1,NT-1,false,false,false); RESC();
  { float sacc=pB0[0]+pB0[1]; _Pragma("unroll") for(int r=2;r<16;++r)sacc+=pB0[r]; _Pragma("unroll") for(int r=0;r<16;++r)sacc+=pB1[r]; l_reg+=sacc;
    pw0=(u32x4){PKW(pB0,0),PKW(pB0,2),PKW(pB0,4),PKW(pB0,6)};pw1=(u32x4){PKW(pB0,8),PKW(pB0,10),PKW(pB0,12),PKW(pB0,14)};pw2=(u32x4){PKW(pB1,0),PKW(pB1,2),PKW(pB1,4),PKW(pB1,6)};pw3=(u32x4){PKW(pB1,8),PKW(pB1,10),PKW(pB1,12),PKW(pB1,14)};
    SBAR(); pv(o,vb0+sl_cur,PAF(0),PAF(1),PAF(2),PAF(3)); }
  #undef PKW
  #undef PAF
  #undef VFR
  #undef PIN
  #undef MX3
  #undef GAPA
  #undef GAPB
  #undef EX
  #undef VRD
  #undef KRD
  #undef STEP
  #undef ENDW
  {auto rr=__builtin_amdgcn_permlane32_swap(__float_as_uint(l_reg),__float_as_uint(l_reg),false,false);l_reg=__uint_as_float(rr[0])+__uint_as_float(rr[1]);}
  if(hi==0)wsf[32+r32]=l_reg;asm volatile("s_waitcnt lgkmcnt(0)":::"memory");
  float rli[16];
  #pragma unroll
  for(int r=0;r<16;++r)rli[r]=__builtin_amdgcn_rcpf(wsf[32+crow(r,hi)]);
  bf16*Ow=Ou+(long)(wid*QBLK)*OP;
  { bf16*stg=(bf16*)(shm+LDS_OST)+wid*2048;
    #pragma unroll
    for(int r=0;r<16;++r){const int orow=crow(r,hi);
      #pragma unroll
      for(int d0=0;d0<2;++d0)stg[orow*64+d0*32+r32]=(bf16)f2bf_t(o[d0][r]*rli[r]);}
    asm volatile("s_waitcnt lgkmcnt(0)":::"memory");
    #pragma unroll
    for(int i=0;i<4;++i){const int row=i*8+(lane>>3),ch=lane&7; const u32x4 v=*(const u32x4*)(stg+row*64+ch*8); ATTN_STORE16(Ow+(long)row*OP+ch*8,v);} }
  asm volatile("s_waitcnt lgkmcnt(0)\n\ts_barrier":::"memory");
  #undef DMA_K
  #undef KOFF
  #undef WAIT_KV
  #undef DMA_V
  #undef CMASK
  #undef START
  #undef RESC
  #undef ROT
}

#undef SBAR
#undef WAIT_BAR
}

struct Fr { int lane, wave, gw, NGW, vcu, G; LAS unsigned char* lds; };

__device__ __forceinline__ void tr_item(const float* W, int K, int N, bf16_t* WT, int drow0, int k0, int n0, LAS float* scr, int lane, const float wsc = 1.0f) {
    { f32x4 w[8];
#pragma unroll
      for (int i = 0; i < 8; ++i) w[i] = *(const f32x4*)(W + (size_t)(k0 + 8 * i + (lane >> 3)) * N + n0 + 4 * (lane & 7));
#pragma unroll
      for (int i = 0; i < 8; ++i) { LAS float* d = scr + (8 * i + (lane >> 3)) * 33 + 4 * (lane & 7); d[0] = w[i].x; d[1] = w[i].y; d[2] = w[i].z; d[3] = w[i].w; } }
    asm volatile("s_waitcnt lgkmcnt(0)" ::: "memory");
    const int c = lane & 7;
#pragma unroll
    for (int j = 0; j < 4; ++j) { const int n = (lane >> 3) + 8 * j; const LAS float* s = scr + (8 * c) * 33 + n;
        u32x4 o; o.x = pk2(s[0 * 33] * wsc, s[1 * 33] * wsc); o.y = pk2(s[2 * 33] * wsc, s[3 * 33] * wsc); o.z = pk2(s[4 * 33] * wsc, s[5 * 33] * wsc); o.w = pk2(s[6 * 33] * wsc, s[7 * 33] * wsc);
        *(u32x4*)(WT + (size_t)(drow0 + n) * K + k0 + 8 * c) = o; }
    asm volatile("s_waitcnt lgkmcnt(0)" ::: "memory");
}

constexpr int I_FI = 16 * 176, I_FO = 44 * 32, I_EIN = 16 * 61, I_EQB = 4 * 24, I_EKVB = 2 * 32, I_SQ = 16 * 32, I_OIN = 16 * 56;
constexpr int I_E4 = I_EIN + I_EQB + I_EKVB + I_SQ, I_O2 = I_OIN + I_SQ;
constexpr int N_TR0 = 2 * I_FI + 2 * I_FO + I_E4, N_TR1 = 2 * I_FI + 2 * I_FO + I_O2;
__device__ __forceinline__ void tr_decode(const Params& P, const Fr& F, int it, LAS float* scr) {
    unsigned char* ws = P.ws;
        int r = it;
        if (r < 4 * I_FI) { const int mat = r / I_FI; r -= mat * I_FI; const int kb = r / 176, nb = r % 176, n0 = nb * 32, g = n0 / DFF, j = n0 - g * DFF;
            tr_item(P.w_ffn_in + (size_t)mat * DM * NFI, DM, NFI, (bf16_t*)(ws + WS_WFI) + (size_t)mat * NFI * DM, (j / 128) * 256 + g * 128 + (j % 128), kb * 64, n0, scr, F.lane, g ? -0.6931471805599453f : -1.4426950408889634f); return; }
        r -= 4 * I_FI;
        if (r < 4 * I_FO) { const int mat = r / I_FO; r -= mat * I_FO; const int kb = r / 32, nb = r % 32;
            tr_item(P.w_ffn_out + (size_t)mat * DFF * DM, DFF, DM, (bf16_t*)(ws + WS_WFO) + (size_t)mat * DM * DFF, nb * 32, kb * 64, nb * 32, scr, F.lane); return; }
        r -= 4 * I_FO;
        if (r < I_EIN) { const int kb = r / 61, nb = r % 61, n0 = nb * 32; int dr = n0;
            if (n0 >= 512 && n0 < 1024) { const int j = n0 - 512; dr = 512 + (j / 128) * 256 + (j % 128); } else if (n0 >= 1024 && n0 < 1536) { const int j = n0 - 1024; dr = 512 + (j / 128) * 256 + 128 + (j % 128); }
            tr_item(P.e_w_in, DM, E_IN, (bf16_t*)(ws + WS_EWIN), dr, kb * 64, n0, scr, F.lane); return; }
        r -= I_EIN;
        if (r < I_EQB) { const int kb = r / 24, nb = r % 24; tr_item(P.e_w_q_b, 256, 768, (bf16_t*)(ws + WS_EWQB), nb * 32, kb * 64, nb * 32, scr, F.lane); return; }
        r -= I_EQB;
        if (r < I_EKVB) { const int kb = r / 32, nb = r % 32; tr_item(P.e_w_kv_b, 128, 1024, (bf16_t*)(ws + WS_EWKVB), nb * 32, kb * 64, nb * 32, scr, F.lane); return; }
        r -= I_EKVB;
        if (r < I_SQ) { const int kb = r / 32, nb = r % 32; tr_item(P.e_w_out, DM, DM, (bf16_t*)(ws + WS_EWOUT), nb * 32, kb * 64, nb * 32, scr, F.lane); return; }
        r -= I_SQ;
        if (r < I_OIN) { const int kb = r / 56, nb = r % 56, n0 = nb * 32; int dr = n0;
            if (n0 >= 1280) { const int j = n0 - 1280; dr = 768 + (j / 128) * 256 + 128 + (j % 128); } else if (n0 >= 768) { const int j = n0 - 768; dr = 768 + (j / 128) * 256 + (j % 128); }
            tr_item(P.o_w_in, DM, O_IN, (bf16_t*)(ws + WS_OWIN), dr, kb * 64, n0, scr, F.lane); return; }
        r -= I_OIN;
        { const int kb = r / 32, nb = r % 32; tr_item(P.o_w_out, DM, DM, (bf16_t*)(ws + WS_OWOUT), nb * 32, kb * 64, nb * 32, scr, F.lane); }
}
__device__ __forceinline__ void tr_items(const Params& P, const Fr& F, int which, int worker, int nworkers) {
    LAS float* scr = (LAS float*)(F.lds + F.wave * 16384);
    const int n = which ? N_TR1 : N_TR0;
    for (int v = worker; v < n; v += nworkers) { int it;
        if (v < 2 * I_FI) it = which * 2 * I_FI + v;
        else if (v < 2 * I_FI + 2 * I_FO) it = 4 * I_FI + which * 2 * I_FO + (v - 2 * I_FI);
        else it = 4 * I_FI + 4 * I_FO + which * I_E4 + (v - 2 * I_FI - 2 * I_FO);
        tr_decode(P, F, it, scr); }
}
__device__ __forceinline__ void p0_prologue(const Params& P, const Fr& F0, const bool do_mod) {
    Fr F = F0; F.lane = fresh_lane();
    unsigned char* ws = P.ws;
    tr_items(P, F, 0, F.gw, F.NGW);
    { u32x4* z = (u32x4*)((bf16_t*)(ws + WS_EWIN) + (size_t)E_IN * DM); const int n16 = 96 * DM * 2 / 16;
      for (int i = F.gw * 64 + F.lane; i < n16; i += F.NGW * 64) z[i] = (u32x4){0u, 0u, 0u, 0u}; }
    if (do_mod) { float* MOD = (float*)(ws + WS_MOD);
      for (int it = F.gw; it < 2 * 36 * 16; it += F.NGW) {
          const int l = it / (36 * 16), r = it % (36 * 16), jb = r / 16, kc = r % 16, k0 = kc * 64;
          const float s0 = silu_f(P.c[k0 + F.lane]), s1 = silu_f(P.c[DM + k0 + F.lane]), s2 = silu_f(P.c_ctx[k0 + F.lane]);
          const float* wp = P.w_mod + ((size_t)l * DM + k0) * 9216 + jb * 256 + F.lane * 4;
          f32x4 a0 = {0.f, 0.f, 0.f, 0.f}, a1 = a0, a2 = a0;
#pragma unroll 8
          for (int k = 0; k < 64; ++k) { const f32x4 w = *(const f32x4*)(wp + (size_t)k * 9216); a0 += w * rdlane(s0, k); a1 += w * rdlane(s1, k); a2 += w * rdlane(s2, k); }
          if (kc == 0) { const f32x4 bv = *(const f32x4*)(P.b_mod + (size_t)l * 9216 + jb * 256 + F.lane * 4); a0 += bv; a1 += bv; a2 += bv; }
          float* mp = MOD + (size_t)l * 3 * 9216 + jb * 256 + F.lane * 4;
#pragma unroll
          for (int e = 0; e < 4; ++e) { atomicAdd(mp + e, a0[e]); atomicAdd(mp + 9216 + e, a1[e]); atomicAdd(mp + 2 * 9216 + e, a2[e]); }
      } }
    { f32x2* rt = (f32x2*)(ws + WS_ROPE);
      for (int i = F.gw * 64 + F.lane; i < 2 * 128 * 16; i += F.NGW * 64) {
          const int kind = i >> 11, pos = (i >> 4) & 127, f = i & 15; const float nf = kind ? 16.f : 8.f;
          const float inv = exp2f(-((float)f / nf) * 13.287712379549449f);
          const float ang = (float)pos * inv;
          const double rev = (double)ang * 0.15915494309189535; const float fr_ = (float)(rev - __builtin_rint(rev));
          rt[i] = (f32x2){__builtin_amdgcn_cosf(fr_), __builtin_amdgcn_sinf(fr_)}; } }
}

__device__ __forceinline__ void ld8(const bf16_t* p, float (&f)[8]) { unpack8(*(const u32x4*)p, f); }
__device__ __forceinline__ void ldf8(const float* p, float (&f)[8]) { const f32x4 a = *(const f32x4*)p, b = *(const f32x4*)(p + 4); f[0] = a.x; f[1] = a.y; f[2] = a.z; f[3] = a.w; f[4] = b.x; f[5] = b.y; f[6] = b.z; f[7] = b.w; }
__device__ __forceinline__ void norm_finish(float (&v0)[8], float (&v1)[8], const float (&g0)[8], const float (&g1)[8], const float* shp, bf16_t* arow) {
    const f32x4 m0 = *(const f32x4*)shp, m1 = *(const f32x4*)(shp + 4), m2 = *(const f32x4*)(shp + 512), m3 = *(const f32x4*)(shp + 516);
    const f32x4 m4 = *(const f32x4*)(shp + DM), m5 = *(const f32x4*)(shp + DM + 4), m6 = *(const f32x4*)(shp + DM + 512), m7 = *(const f32x4*)(shp + DM + 516);
    float s = 0.f;
#pragma unroll
    for (int i = 0; i < 8; ++i) s += v0[i] * v0[i] + v1[i] * v1[i];
    const float rstd = 1.f / sqrtf(wave_sum(s) * (1.f / DM) + EPS);
    float sh0[8], sh1[8], sc0[8], sc1[8];
#pragma unroll
    for (int i = 0; i < 4; ++i) { sh0[i] = m0[i]; sh0[4 + i] = m1[i]; sh1[i] = m2[i]; sh1[4 + i] = m3[i]; sc0[i] = m4[i]; sc0[4 + i] = m5[i]; sc1[i] = m6[i]; sc1[4 + i] = m7[i]; }
    float o0[8], o1[8];
#pragma unroll
    for (int i = 0; i < 8; ++i) { o0[i] = v0[i] * rstd * g0[i] * (sc0[i] + 1.f) + sh0[i]; o1[i] = v1[i] * rstd * g1[i] * (sc1[i] + 1.f) + sh1[i]; }
    *(u32x4*)arow = pack8(o0); *(u32x4*)(arow + 512) = pack8(o1);
}
__device__ __forceinline__ void norm_phase(const Params& P, const Fr& F0, int l, int j, int nslab) {
    Fr F = F0; F.lane = fresh_lane();
    bf16_t* Hb = (bf16_t*)(P.ws + WS_H); bf16_t* A = (bf16_t*)(P.ws + WS_A); const float* MOD = (const float*)(P.ws + WS_MOD);
    const int c0 = F.lane * 8;
    float g0[8], g1[8]; ldf8(P.norm_g + (size_t)(l * 3 + j) * DM + c0, g0); ldf8(P.norm_g + (size_t)(l * 3 + j) * DM + 512 + c0, g1);
    const bool from_input = (l == 0 && j == 0), ctx_from_input = (l == 0 && j <= 1);
    const bool uneven = (nslab > 0) && (F.NGW == 2048);
    const int rbase = uneven ? (F.gw < 512 ? F.gw : 1024 + (F.gw - 512)) : F.gw, rstride = uneven ? (F.gw < 512 ? 512 : 1536) : F.NGW, rend = uneven ? (F.gw < 512 ? 1024 : NB * SEQ) : NB * SEQ;
    for (int r = rbase; r < rend; r += 2 * rstride) { const int ra = r, rb = (r + rstride < rend) ? r + rstride : r;
        const int ba = ra / SEQ, bb = rb / SEQ; const size_t rowa = (size_t)ba * SEQT + (ra - ba * SEQ), rowb = (size_t)bb * SEQT + (rb - bb * SEQ);
        float va0[8], va1[8], vb0[8], vb1[8];
        if (from_input) { const float* pa = P.x + (size_t)ra * DM + c0; const float* pb = P.x + (size_t)rb * DM + c0;
            const f32x4 a0 = *(const f32x4*)pa, a1 = *(const f32x4*)(pa + 4), a2 = *(const f32x4*)(pa + 512), a3 = *(const f32x4*)(pa + 516), b0 = *(const f32x4*)pb, b1 = *(const f32x4*)(pb + 4), b2 = *(const f32x4*)(pb + 512), b3 = *(const f32x4*)(pb + 516);
#pragma unroll
            for (int i = 0; i < 4; ++i) { va0[i] = a0[i]; va0[4 + i] = a1[i]; va1[i] = a2[i]; va1[4 + i] = a3[i]; vb0[i] = b0[i]; vb0[4 + i] = b1[i]; vb1[i] = b2[i]; vb1[4 + i] = b3[i]; } }
        else { const u32x4 a0 = *(const u32x4*)(Hb + rowa * DM + c0), a1 = *(const u32x4*)(Hb + rowa * DM + 512 + c0), b0 = *(const u32x4*)(Hb + rowb * DM + c0), b1 = *(const u32x4*)(Hb + rowb * DM + 512 + c0);
            unpack8(a0, va0); unpack8(a1, va1); unpack8(b0, vb0); unpack8(b1, vb1); }
        norm_finish(va0, va1, g0, g1, MOD + ((size_t)(l * 3 + ba) * 9 + 3 * j) * DM + c0, A + rowa * DM + c0);
        if (rb != ra) norm_finish(vb0, vb1, g0, g1, MOD + ((size_t)(l * 3 + bb) * 9 + 3 * j) * DM + c0, A + rowb * DM + c0); }
    for (int r = F.gw; r < NB * CTXL; r += F.NGW) { const int b = r / CTXL, tc = r - b * CTXL; const size_t row = (size_t)b * SEQT + SEQ + tc;
        float v0[8], v1[8];
        if (ctx_from_input) { const float* inrow = P.ctx + (size_t)r * DM; ldf8(inrow + c0, v0); ldf8(inrow + 512 + c0, v1); }
        else { ld8(Hb + row * DM + c0, v0); ld8(Hb + row * DM + 512 + c0, v1); }
        if (nslab > 0) {
            const float* pr = (const float*)(P.ws + WS_PART) + (size_t)r * DM + c0;
            for (int sl = 0; sl < nslab; sl += 4) { float a0[8], a1[8], b0[8], b1[8], c0_[8], c1_[8], d0[8], d1[8];
                const bool two = (sl + 2 < nslab);
                ldf8(pr + (size_t)sl * 512 * DM, a0); ldf8(pr + (size_t)sl * 512 * DM + 512, a1); ldf8(pr + (size_t)(sl + 1) * 512 * DM, b0); ldf8(pr + (size_t)(sl + 1) * 512 * DM + 512, b1);
                const size_t s2 = two ? (size_t)(sl + 2) : (size_t)sl, s3 = two ? (size_t)(sl + 3) : (size_t)sl;
                ldf8(pr + s2 * 512 * DM, c0_); ldf8(pr + s2 * 512 * DM + 512, c1_); ldf8(pr + s3 * 512 * DM, d0); ldf8(pr + s3 * 512 * DM + 512, d1);
                const float m2 = two ? 1.f : 0.f;
#pragma unroll
                for (int i = 0; i < 8; ++i) { v0[i] += (a0[i] + b0[i]) + m2 * (c0_[i] + d0[i]); v1[i] += (a1[i] + b1[i]) + m2 * (c1_[i] + d1[i]); } }
            *(u32x4*)(Hb + row * DM + c0) = pack8(v0); *(u32x4*)(Hb + row * DM + 512 + c0) = pack8(v1); }
        norm_finish(v0, v1, g0, g1, MOD + ((size_t)(l * 3 + 2) * 9 + 3 * j) * DM + c0, A + row * DM + c0); }
}
__device__ __forceinline__ void final_norm(const Params& P, const Fr& F0) {
    Fr F = F0; F.lane = fresh_lane();
    const bf16_t* Hb = (const bf16_t*)(P.ws + WS_H); const int c0 = F.lane * 8;
    float g0[8], g1[8]; ldf8(P.final_g + c0, g0); ldf8(P.final_g + 512 + c0, g1);
    for (int r0 = F.gw; r0 < NB * SEQ; r0 += 2 * F.NGW) { const int ra = r0, rb = (r0 + F.NGW < NB * SEQ) ? r0 + F.NGW : r0;
        const int ba = ra / SEQ, bb = rb / SEQ; const size_t rowa = (size_t)ba * SEQT + (ra - ba * SEQ), rowb = (size_t)bb * SEQT + (rb - bb * SEQ);
        const u32x4 ra0 = *(const u32x4*)(Hb + rowa * DM + c0), ra1 = *(const u32x4*)(Hb + rowa * DM + 512 + c0), rb0 = *(const u32x4*)(Hb + rowb * DM + c0), rb1 = *(const u32x4*)(Hb + rowb * DM + 512 + c0);
#pragma unroll
        for (int h = 0; h < 2; ++h) { float v0[8], v1[8]; unpack8(h ? rb0 : ra0, v0); unpack8(h ? rb1 : ra1, v1); const int r = h ? rb : ra; if (h && rb == ra) break;
        float s = 0.f;
#pragma unroll
        for (int i = 0; i < 8; ++i) s += v0[i] * v0[i] + v1[i] * v1[i];
        const float rstd = 1.f / sqrtf(wave_sum(s) * (1.f / DM) + EPS);
        float* op = P.out + (size_t)r * DM + c0;
        *(f32x4*)op = (f32x4){v0[0] * rstd * g0[0], v0[1] * rstd * g0[1], v0[2] * rstd * g0[2], v0[3] * rstd * g0[3]};
        *(f32x4*)(op + 4) = (f32x4){v0[4] * rstd * g0[4], v0[5] * rstd * g0[5], v0[6] * rstd * g0[6], v0[7] * rstd * g0[7]};
        *(f32x4*)(op + 512) = (f32x4){v1[0] * rstd * g1[0], v1[1] * rstd * g1[1], v1[2] * rstd * g1[2], v1[3] * rstd * g1[3]};
        *(f32x4*)(op + 516) = (f32x4){v1[4] * rstd * g1[4], v1[5] * rstd * g1[5], v1[6] * rstd * g1[6], v1[7] * rstd * g1[7]}; } }
}


__device__ __forceinline__ void elem_even(const Params& P, const Fr& F0) {
    Fr F = F0; F.lane = fresh_lane();
    const bf16_t* PP = (const bf16_t*)(P.ws + WS_P); bf16_t* Y = (bf16_t*)(P.ws + WS_Y); bf16_t* QAN = (bf16_t*)(P.ws + WS_QAN); bf16_t* KVAN = (bf16_t*)(P.ws + WS_KVAN); bf16_t* KR = (bf16_t*)(P.ws + WS_KR);
    const f32x2* rope = (const f32x2*)(P.ws + WS_ROPE);
    const int lane = F.lane, ch0 = lane * 8;
    float w0[8], w1[8], w2[8]; ldf8(P.e_conv_w + ch0, w0); ldf8(P.e_conv_w + 512 + ch0, w1); ldf8(P.e_conv_w + 1024 + ch0, w2);
    const int seg = lane < 32 ? 0 : lane < 48 ? 1 : lane < 52 ? 2 : 3;
    const int scol = lane < 32 ? 1536 + lane * 8 : lane < 48 ? 1792 + (lane - 32) * 8 : lane < 52 ? 1920 + (lane - 48) * 8 : 0;
    float gn[8];
    if (seg == 0) ldf8(P.e_q_norm + lane * 8, gn); else if (seg == 1) ldf8(P.e_kv_norm + (lane - 32) * 8, gn); else { for (int i = 0; i < 8; ++i) gn[i] = 1.f; }
    u32x4 rsb, rc0, rx0, rsv, rcm, rxm, rcp, rxp; float mmk, mpk;
#define EV_LOAD(rw) do { const int b_ = (rw) / SEQT, t_ = (rw) - b_ * SEQT; const bool lat_ = t_ < SEQ; const int s0_ = lat_ ? 0 : SEQ, s1_ = lat_ ? SEQ : SEQT; \
        const bool hm_ = (t_ - 1 >= s0_), hp_ = (t_ + 1 < s1_); const bf16_t* Pr_ = PP + (size_t)(rw) * E_INP; const bf16_t* Pm_ = hm_ ? Pr_ - E_INP : Pr_; const bf16_t* Pp_ = hp_ ? Pr_ + E_INP : Pr_; \
        rsb = *(const u32x4*)(Pr_ + ch0); rc0 = *(const u32x4*)(Pr_ + 512 + ch0); rx0 = *(const u32x4*)(Pr_ + 1024 + ch0); rsv = *(const u32x4*)(Pr_ + scol); \
        rcm = *(const u32x4*)(Pm_ + 512 + ch0); rxm = *(const u32x4*)(Pm_ + 1024 + ch0); rcp = *(const u32x4*)(Pp_ + 512 + ch0); rxp = *(const u32x4*)(Pp_ + 1024 + ch0); mmk = hm_ ? 1.f : 0.f; mpk = hp_ ? 1.f : 0.f; } while (0)
    if (F.gw < T) EV_LOAD(F.gw);
    for (int row = F.gw; row < T; row += F.NGW) { const int b = row / SEQT, t = row - b * SEQT; const bool lat = t < SEQ;
        float sb[8], c0[8], x0[8], cm[8], xm[8], cp[8], xp[8], sv[8];
        unpack8(rsb, sb); unpack8(rc0, c0); unpack8(rx0, x0); unpack8(rsv, sv); unpack8(rcm, cm); unpack8(rxm, xm); unpack8(rcp, cp); unpack8(rxp, xp);
        const float mm = mmk, mp = mpk;
        { const int nrow = (row + F.NGW < T) ? row + F.NGW : row; EV_LOAD(nrow); }
#pragma unroll
        for (int i = 0; i < 8; ++i) { cm[i] *= mm; cp[i] *= mp; }
        float ya[8];
#pragma unroll
        for (int i = 0; i < 8; ++i) ya[i] = sb[i] * (w0[i] * (cm[i] * xm[i]) + w1[i] * (c0[i] * x0[i]) + w2[i] * (cp[i] * xp[i]));
        *(u32x4*)(Y + (size_t)row * DM + ch0) = pack8(ya);
        float ss = 0.f;
#pragma unroll
        for (int i = 0; i < 8; ++i) ss += sv[i] * sv[i];
        const float sq = wave_sum(seg == 0 ? ss : 0.f), skv = wave_sum(seg == 1 ? ss : 0.f);
        if (seg == 0) { const float rstd = 1.f / sqrtf(sq * (1.f / 256.f) + EPS); float o[8];
#pragma unroll
            for (int i = 0; i < 8; ++i) o[i] = sv[i] * rstd * gn[i];
            *(u32x4*)(QAN + (size_t)row * 256 + lane * 8) = pack8(o); }
        else if (seg == 1) { const float rstd = 1.f / sqrtf(skv * (1.f / 128.f) + EPS); float o[8];
#pragma unroll
            for (int i = 0; i < 8; ++i) o[i] = sv[i] * rstd * gn[i];
            *(u32x4*)(KVAN + (size_t)row * 128 + (lane - 32) * 8) = pack8(o); }
        else if (seg == 2) { const int j = lane - 48; float o[8];
#pragma unroll
            for (int p = 0; p < 4; ++p) { const int i = 4 * j + p; float cs = 1.f, sn = 0.f;
                if (lat) { const int pos = (i < 8) ? (t >> 6) : (t & 63); const f32x2 r2 = rope[pos * 16 + (i & 7)]; cs = r2.x; sn = r2.y; }
                o[2 * p] = sv[2 * p] * cs - sv[2 * p + 1] * sn; o[2 * p + 1] = sv[2 * p] * sn + sv[2 * p + 1] * cs; }
            *(u32x4*)(KR + (size_t)row * 32 + j * 8) = pack8(o); } }
#undef EV_LOAD
}
__device__ __forceinline__ void conv_even(const Params& P, const Fr& F0, const int row0_, const int row1_, const int worker, const int nworkers) {
    Fr F = F0; F.lane = fresh_lane();
    const bf16_t* SB = (const bf16_t*)(P.ws + WS_SB); const bf16_t* CX = (const bf16_t*)(P.ws + WS_CX); bf16_t* Y = (bf16_t*)(P.ws + WS_Y);
    const int ch0 = F.lane * 8;
    float w0[8], w1[8], w2[8]; ldf8(P.e_conv_w + ch0, w0); ldf8(P.e_conv_w + 512 + ch0, w1); ldf8(P.e_conv_w + 1024 + ch0, w2);
    u32x4 rsb, rc0, rcm, rcp; float mmk, mpk;
#define CE_LOAD(rw) do { const int b_ = (rw) / SEQT, t_ = (rw) - b_ * SEQT; const bool lat_ = t_ < SEQ; const int s0_ = lat_ ? 0 : SEQ, s1_ = lat_ ? SEQ : SEQT; \
        const bool hm_ = (t_ - 1 >= s0_), hp_ = (t_ + 1 < s1_); const bf16_t* C_ = CX + (size_t)(rw) * 512 + ch0; \
        rsb = *(const u32x4*)(SB + (size_t)(rw) * 512 + ch0); rc0 = *(const u32x4*)C_; rcm = *(const u32x4*)(hm_ ? C_ - 512 : C_); rcp = *(const u32x4*)(hp_ ? C_ + 512 : C_); mmk = hm_ ? 1.f : 0.f; mpk = hp_ ? 1.f : 0.f; } while (0)
    if (row0_ + worker < row1_) CE_LOAD(row0_ + worker);
    for (int row = row0_ + worker; row < row1_; row += nworkers) {
        float sb[8], c0[8], cm[8], cp[8]; unpack8(rsb, sb); unpack8(rc0, c0); unpack8(rcm, cm); unpack8(rcp, cp);
        const float mm = mmk, mp = mpk;
        { const int nrow = (row + nworkers < row1_) ? row + nworkers : row; CE_LOAD(nrow); }
        float ya[8];
#pragma unroll
        for (int i = 0; i < 8; ++i) ya[i] = sb[i] * (w0[i] * (cm[i] * mm) + w1[i] * c0[i] + w2[i] * (cp[i] * mp));
        *(u32x4*)(Y + (size_t)row * DM + ch0) = pack8(ya); }
#undef CE_LOAD
}
__device__ __forceinline__ void kr_copy(const Params& P, const Fr& F0) {
    Fr F = F0; F.lane = fresh_lane();
    const bf16_t* KR = (const bf16_t*)(P.ws + WS_KR); bf16_t* K = (bf16_t*)(P.ws + WS_EK);
    for (int row = F.gw; row < T; row += F.NGW) { const int h = F.lane >> 3, q = F.lane & 7;
        const u32x2 v = *(const u32x2*)(KR + (size_t)row * 32 + q * 4); *(u32x2*)(K + (size_t)row * 768 + h * 96 + 64 + q * 4) = v; }
}
__device__ __forceinline__ void elem_odd(const Params& P, const Fr& F0) {
    Fr F = F0; F.lane = fresh_lane();
    const bf16_t* PP = (const bf16_t*)(P.ws + WS_P); bf16_t* Q = (bf16_t*)(P.ws + WS_OQ); bf16_t* K = (bf16_t*)(P.ws + WS_OK);
    const f32x2* rope = (const f32x2*)(P.ws + WS_ROPE) + 2048;
    const int lane = F.lane, l8 = lane & 7;
    float gq[8], gk[8]; ldf8(P.o_q_norm + l8 * 8, gq); ldf8(P.o_k_norm + l8 * 8, gk);
    u32x4 rq_, rk_; f32x2 rr_[4];
#define OD_LOAD(rw) do { const int b_ = (rw) / SEQT, t_ = (rw) - b_ * SEQT; const bool lat_ = t_ < SEQ; const bf16_t* Pr_ = PP + (size_t)(rw) * 768; \
        rq_ = *(const u32x4*)(Pr_ + lane * 8); rk_ = *(const u32x4*)(Pr_ + 512 + (lane & 15) * 8); \
        _Pragma("unroll") for (int p_ = 0; p_ < 4; ++p_) { const int i_ = 4 * l8 + p_; const int pos_ = lat_ ? ((i_ < 16) ? (t_ >> 6) : (t_ & 63)) : 0; const f32x2 r2_ = rope[pos_ * 16 + (i_ & 15)]; rr_[p_] = lat_ ? r2_ : (f32x2){1.f, 0.f}; } } while (0)
    if (F.gw < T) OD_LOAD(F.gw);
    for (int row = F.gw; row < T; row += F.NGW) {
        float q[8], k[8]; unpack8(rq_, q); unpack8(rk_, k);
        float cs[4], sn[4];
#pragma unroll
        for (int p = 0; p < 4; ++p) { cs[p] = rr_[p].x; sn[p] = rr_[p].y; }
        { const int nrow = (row + F.NGW < T) ? row + F.NGW : row; OD_LOAD(nrow); }
        float sq = 0.f, sk = 0.f;
#pragma unroll
        for (int i = 0; i < 8; ++i) { sq += q[i] * q[i]; sk += k[i] * k[i]; }
        sq += swz<0x041F>(sq); sq += swz<0x081F>(sq); sq += swz<0x101F>(sq);
        sk += swz<0x041F>(sk); sk += swz<0x081F>(sk); sk += swz<0x101F>(sk);
        const float rq = 1.f / sqrtf(sq * (1.f / 64.f) + EPS), rk = 1.f / sqrtf(sk * (1.f / 64.f) + EPS);
        float qo[8], ko[8];
#pragma unroll
        for (int p = 0; p < 4; ++p) { const float q0 = q[2 * p] * rq * gq[2 * p], q1 = q[2 * p + 1] * rq * gq[2 * p + 1]; qo[2 * p] = (q0 * cs[p] - q1 * sn[p]) * C2_GQA; qo[2 * p + 1] = (q0 * sn[p] + q1 * cs[p]) * C2_GQA;
            const float k0 = k[2 * p] * rk * gk[2 * p], k1 = k[2 * p + 1] * rk * gk[2 * p + 1]; ko[2 * p] = k0 * cs[p] - k1 * sn[p]; ko[2 * p + 1] = k0 * sn[p] + k1 * cs[p]; }
        *(u32x4*)(Q + (size_t)row * 512 + lane * 8) = pack8(qo);
        if (lane < 16) *(u32x4*)(K + (size_t)row * 128 + lane * 8) = pack8(ko); }
#undef OD_LOAD
}
__device__ __forceinline__ void conv_odd(const Params& P, const Fr& F0) {
    Fr F = F0; F.lane = fresh_lane();
    const bf16_t* G = (const bf16_t*)(P.ws + WS_G); bf16_t* Y = (bf16_t*)(P.ws + WS_Y);
    const int lane = F.lane, ch0 = lane * 8;
    constexpr int TK = 8;
    float bias[8], lg[8], lb[8]; ldf8(P.o_conv_b + ch0, bias); ldf8(P.o_ln_g + ch0, lg); ldf8(P.o_ln_b + ch0, lb);
    for (int it = F.gw; it < NB * SEQ / TK; it += F.NGW) { const int b = it / (SEQ / TK), t0 = (it - b * (SEQ / TK)) * TK;
        const bf16_t* Gb = G + (size_t)b * SEQT * 512 + ch0;
        float acc[TK][8];
#pragma unroll
        for (int q = 0; q < TK; ++q)
#pragma unroll
            for (int i = 0; i < 8; ++i) acc[q][i] = bias[i];
        u32x4 gcur[TK + 3];
#pragma unroll
        for (int r = 0; r < TK + 3; ++r) { const int tt = t0 - 15 + r; gcur[r] = (tt >= 0 && tt < SEQ) ? *(const u32x4*)(Gb + (size_t)tt * 512) : (u32x4){0u, 0u, 0u, 0u}; }
#pragma unroll 1
        for (int jc = 0; jc < 32; jc += 4) {
            u32x4 gnxt[TK + 3]; float w[4][8];
#pragma unroll
            for (int jj = 0; jj < 4; ++jj) { if (jc + jj < 31) ldf8(P.o_conv_w + (jc + jj) * 512 + ch0, w[jj]); else { for (int i = 0; i < 8; ++i) w[jj][i] = 0.f; } }
#pragma unroll
            for (int r = 0; r < TK + 3; ++r) { const int tt = t0 + jc + 4 - 15 + r; gnxt[r] = (jc + 4 < 32 && tt >= 0 && tt < SEQ) ? *(const u32x4*)(Gb + (size_t)tt * 512) : (u32x4){0u, 0u, 0u, 0u}; }
#pragma unroll
            for (int r = 0; r < TK + 3; ++r) { float gv[8]; unpack8(gcur[r], gv);
#pragma unroll
                for (int q = 0; q < TK; ++q) { const int jj = r - q; if (jj >= 0 && jj < 4) {
#pragma unroll
                    for (int i = 0; i < 8; ++i) acc[q][i] += w[jj][i] * gv[i]; } } }
#pragma unroll
            for (int r = 0; r < TK + 3; ++r) gcur[r] = gnxt[r]; }
#pragma unroll
        for (int q = 0; q < TK; ++q) { float s = 0.f;
#pragma unroll
            for (int i = 0; i < 8; ++i) s += acc[q][i];
            const float mu = wave_sum(s) * (1.f / 512.f); float s2 = 0.f;
#pragma unroll
            for (int i = 0; i < 8; ++i) { acc[q][i] -= mu; s2 += acc[q][i] * acc[q][i]; }
            const float rstd = 1.f / sqrtf(wave_sum(s2) * (1.f / 512.f) + EPS); float o[8];
#pragma unroll
            for (int i = 0; i < 8; ++i) o[i] = silu_f(acc[q][i] * rstd * lg[i] + lb[i]);
            *(u32x4*)(Y + ((size_t)b * SEQT + t0 + q) * DM + 512 + ch0) = pack8(o); } }
}

#define XB_TMO      128
#define XB_XCNT(j)  (256  + 64 * (j))
#define XB_XSUB(j)  (1280 + 64 * (j))
#define XB_XGEN(j)  (2304 + 64 * (j))
#define XB_TOP      3328
#define XB_TOPGEN   3392
#define XCD_BAR_WORDS 3456
#define XB_SPIN_CAP (1u << 18)

__device__ __forceinline__ unsigned xb_ld(unsigned* p)              { return __hip_atomic_load(p, __ATOMIC_RELAXED, __HIP_MEMORY_SCOPE_AGENT); }
__device__ __forceinline__ unsigned xb_add(unsigned* p, unsigned v) { return __hip_atomic_fetch_add(p, v, __ATOMIC_RELAXED, __HIP_MEMORY_SCOPE_AGENT); }
__device__ __forceinline__ unsigned xb_xcc_id() { return (unsigned)__builtin_amdgcn_s_getreg((3 << 11) | 20) & 0xFu; }
#define XB_SPIN(cond, bar) do { unsigned _sp = 0; while (cond) { __builtin_amdgcn_s_sleep(1); \
    if ((++_sp & 255u) == 0u) { if (xb_ld(&(bar)[XB_TMO])) break; if (_sp > XB_SPIN_CAP) { atomicAdd(&(bar)[XB_TMO], 1u); break; } } } } while (0)

struct XcdBarrier {
    unsigned* bar; unsigned x;
    volatile __attribute__((address_space(3))) unsigned* st;
};

__device__ __forceinline__ XcdBarrier xcd_barrier_post(unsigned* bar, volatile __attribute__((address_space(3))) unsigned* st) {
    XcdBarrier b; b.bar = bar; b.x = xb_xcc_id(); b.st = st;
    if (threadIdx.x == 0) (void)xb_add(&bar[XB_XCNT(b.x)], 1u);
    return b;
}
__device__ __forceinline__ void xcd_barrier_complete(unsigned* bar, unsigned x, unsigned& nloc, unsigned& nx) {
    const unsigned G = gridDim.x * gridDim.y * gridDim.z;
    unsigned sum, cnt, mine, sp = 0u;
    for (;;) {
        sum = 0u; cnt = 0u; mine = 0u;
#pragma unroll
        for (unsigned j = 0; j < 16; ++j) { const unsigned c = xb_ld(&bar[XB_XCNT(j)]); sum += c; cnt += (c > 0u) ? 1u : 0u; mine = (j == x) ? c : mine; }
        if (sum == G) break;
        __builtin_amdgcn_s_sleep(1);
        if ((++sp & 255u) == 0u) { if (xb_ld(&bar[XB_TMO])) break; if (sp > XB_SPIN_CAP) { atomicAdd(&bar[XB_TMO], 1u); break; } }
    }
    nloc = mine > 0u ? mine : 1u; nx = cnt > 0u ? cnt : 1u;
}

__device__ __forceinline__ void xcd_barrier(const XcdBarrier& b) {
    asm volatile("s_waitcnt vmcnt(0)" ::: "memory");
    __syncthreads();
    if (threadIdx.x == 0) {
        unsigned* bar = b.bar;
        __builtin_amdgcn_s_waitcnt(0);
        unsigned nloc = b.st[0], nx = b.st[1];
        if (nloc == 0u) { xcd_barrier_complete(bar, b.x, nloc, nx); b.st[0] = nloc; b.st[1] = nx; }
        const unsigned old = xb_add(&bar[XB_XSUB(b.x)], 1u);
        const unsigned gen = old / nloc;
        if (old + 1u == (gen + 1u) * nloc) {
            __builtin_amdgcn_fence(__ATOMIC_RELEASE, "agent");
            asm volatile("s_waitcnt vmcnt(0)" ::: "memory");
            const unsigned og = xb_add(&bar[XB_TOP], 1u);
            const unsigned tg = og / nx;
            if (og + 1u == (tg + 1u) * nx) xb_add(&bar[XB_TOPGEN], 1u);
            else XB_SPIN(xb_ld(&bar[XB_TOPGEN]) == tg, bar);
            __builtin_amdgcn_fence(__ATOMIC_ACQUIRE, "agent");
            xb_add(&bar[XB_XGEN(b.x)], 1u);
            asm volatile("s_waitcnt vmcnt(0)" ::: "memory");
        } else {
            XB_SPIN(xb_ld(&bar[XB_XGEN(b.x)]) == gen, bar);
            __builtin_amdgcn_fence(__ATOMIC_ACQUIRE, "agent");
            asm volatile("s_waitcnt vmcnt(0)" ::: "memory");
        }
    }
    __syncthreads();
}

#ifdef NO_ATTN
#define ATTN6(...) do{}while(0)
#define ATTN4(...) do{}while(0)
#else
#define ATTN6 attn_unit<6>
#define ATTN4 attn_unit<4>
#endif
#ifdef NO_GEMM
#define GEMM(...) do{}while(0)
#define GEMM_ROT(...) do{}while(0)
#else
template <class E> struct EpiOn { static constexpr bool v = true; };
#ifdef ONLY_EPI
template <class E> struct EpiSel { static constexpr bool v = false; }; template <> struct EpiSel<ONLY_EPI> { static constexpr bool v = true; };
#else
template <class E> struct EpiSel { static constexpr bool v = true; };
#endif
#define GEMM(EpiT, Aptr, Bptr, Kdim, nMl, nNt, skipc, SPL, ...) do { if constexpr (EpiSel<EpiT>::v) { pg8::Gemm g_{(const bf16_t*)(Aptr), (const bf16_t*)(Bptr), T, 0, (Kdim)}; pg8::Order S_; S_.init((nMl), (nNt), F.G, (int)blockIdx.x, (skipc), (Kdim) / 64, (SPL)); \
        EpiT E_{__VA_ARGS__}; pg8::gemm_phase<EpiT, pg8::Order, true, true>(F.lds, g_, S_, E_, F.wave); } } while (0)
#define GEMM_ROT(ROT, EpiT, Aptr, Bptr, Kdim, nMl, nNt, skipc, SPL, ...) do { if constexpr (EpiSel<EpiT>::v) { pg8::Gemm g_{(const bf16_t*)(Aptr), (const bf16_t*)(Bptr), T, 0, (Kdim)}; pg8::Order S_; S_.init((nMl), (nNt), F.G, (int)((blockIdx.x + (ROT)) % gridDim.x), (skipc), (Kdim) / 64, (SPL)); \
        EpiT E_{__VA_ARGS__}; pg8::gemm_phase<EpiT, pg8::Order, true, true>(F.lds, g_, S_, E_, F.wave); } } while (0)
#endif

__global__ void __launch_bounds__(NWAVES * 64, 2) hybrid_fwd(Params P) {
    extern __shared__ __attribute__((aligned(16))) unsigned char lds_raw[];
    cg::grid_group grid = cg::this_grid();
    Fr F; F.lds = (LAS unsigned char*)lds_raw; F.lane = 0; F.wave = __builtin_amdgcn_readfirstlane(threadIdx.x >> 6);
    F.G = gridDim.x; { const int bx = blockIdx.x; F.vcu = (F.G % 8 == 0) ? (bx % 8) * (F.G / 8) + bx / 8 : bx; }
    F.gw = F.vcu * NWAVES + F.wave; F.NGW = F.G * NWAVES;
    unsigned char* ws = P.ws;
    bf16_t* Hb = (bf16_t*)(ws + WS_H); const float* MOD = (const float*)(ws + WS_MOD);
    volatile LAS unsigned* MISC = (volatile LAS unsigned*)(F.lds + RING_BYTES + 320);
    if (threadIdx.x < 32) MISC[threadIdx.x] = 0u;
    __syncthreads();
    XcdBarrier xbar = xcd_barrier_post((unsigned*)(ws + WS_CTL) + 4096, MISC + 8);
#define SYNC() xcd_barrier(xbar)
#ifndef PROBE
#define PROBE 0
#endif
#ifndef NO_P0
    if (PROBE & 16) { p0_prologue(P, F, false); SYNC(); }
    p0_prologue(P, F, true);
#endif
    if (P.ws == nullptr) grid.sync();
    SYNC();
    { constexpr int l = 0;
        const float* modl = MOD + (size_t)l * 3 * 9 * DM;
        if (PROBE & 4) { norm_phase(P, F, l, 0, 0); SYNC(); }
        norm_phase(P, F, l, 0, (l == 1) ? 22 : 0); SYNC();
        if (PROBE & 2) { GEMM(EpiSwiglu, ws + WS_A, ws + WS_WFI + (size_t)(l * 2 + 0) * NFI * DM * 2, DM, 66, 22, 0, 0, (bf16_t*)(ws + WS_ACT)); SYNC(); }
        GEMM(EpiSwiglu, ws + WS_A, ws + WS_WFI + (size_t)(l * 2 + 0) * NFI * DM * 2, DM, 66, 22, 0, 0, (bf16_t*)(ws + WS_ACT)); SYNC();
        if (PROBE & 8) { GEMM(EpiResidT<(l == 0)>, ws + WS_ACT, ws + WS_WFO + (size_t)(l * 2 + 0) * DM * DFF * 2, DFF, 64, 4, 1, 22, Hb, modl + 2 * DM, (float*)(ws + WS_PART), P.x, 0.0f); SYNC(); }
        GEMM(EpiResidT<(l == 0)>, ws + WS_ACT, ws + WS_WFO + (size_t)(l * 2 + 0) * DM * DFF * 2, DFF, 64, 4, 1, 22, Hb, modl + 2 * DM, (float*)(ws + WS_PART), P.x, 0.5f); SYNC();
        if (PROBE & 4) { norm_phase(P, F, l, 1, 0); SYNC(); }
        norm_phase(P, F, l, 1, 22); SYNC();
        if (l == 0) {
            GEMM(EpiEvenIn, ws + WS_A, ws + WS_EWIN, DM, 66, 8, 0, 0, (bf16_t*)(ws + WS_SB), (bf16_t*)(ws + WS_CX), (bf16_t*)(ws + WS_QAN), (bf16_t*)(ws + WS_KVAN), (bf16_t*)(ws + WS_EK), P.e_q_norm, P.e_kv_norm, (const f32x2*)(ws + WS_ROPE), (LAS float*)(F.lds + RING_BYTES + 1024));
            if (blockIdx.x >= 16) { Fr F2 = F; F2.lane = fresh_lane(); tr_items(P, F2, 1, ((int)blockIdx.x - 16) * NWAVES + F.wave, (F.G - 16) * NWAVES); }
            SYNC();
            if (F.G == 256) { if (blockIdx.x < 206) conv_even(P, F, 0, 11536, (int)blockIdx.x * NWAVES + F.wave, 206 * NWAVES); else conv_even(P, F, 11536, T, ((int)blockIdx.x - 206) * NWAVES + F.wave, 50 * NWAVES); }
            else conv_even(P, F, 0, T, F.gw, F.NGW);
            GEMM(EpiQb, ws + WS_QAN, ws + WS_EWQB, 256, 66, 3, 0, 0, (bf16_t*)(ws + WS_EQ), (const f32x2*)(ws + WS_ROPE));
            GEMM_ROT(58, EpiKVb, ws + WS_KVAN, ws + WS_EWKVB, 128, 66, 4, 0, 0, (bf16_t*)(ws + WS_EK), (bf16_t*)(ws + WS_EV));
            SYNC();
            for (int rep_ = 0; rep_ < ((PROBE & 1) ? 2 : 1); ++rep_) {
            { const bf16_t* Q = (const bf16_t*)(ws + WS_EQ); const bf16_t* K = (const bf16_t*)(ws + WS_EK); const bf16_t* V = (const bf16_t*)(ws + WS_EV); bf16_t* Y = (bf16_t*)(ws + WS_Y);
              for (int i = 0; i < 2; ++i) { const int u = 2 * F.vcu + i; if (u >= 512) break; const int bh = u >> 5, qb = u & 31, b = bh >> 3, h = bh & 7; const size_t r0 = (size_t)b * SEQT;
                  tat::attn_unit<8, 6, 768, 768, 512, DM>(Q + (r0 + qb * 256) * 768 + h * 96, K + r0 * 768 + h * 96, V + r0 * 512 + h * 64, Y + (r0 + qb * 256) * DM + 512 + h * 64, SEQT / 64, (char*)lds_raw, F.wave); }
              if ((F.vcu & 15) == 0 && F.vcu < 256) { const int bh = F.vcu >> 4, b = bh >> 3, h = bh & 7; const size_t r0 = (size_t)b * SEQT + SEQ;
                  tat::attn_unit<8, 6, 768, 768, 512, DM>(Q + r0 * 768 + h * 96, K + r0 * 768 + h * 96, V + r0 * 512 + h * 64, Y + r0 * DM + 512 + h * 64, CTXL / 64, (char*)lds_raw, F.wave); } }
            SYNC(); }
        if (PROBE & 8) { GEMM(EpiResidT<false>, ws + WS_Y, ws + WS_EWOUT, DM, 64, 4, 1, 8, Hb, modl + 5 * DM, (float*)(ws + WS_PART), P.x, 0.0f); SYNC(); }
            GEMM(EpiResidT<false>, ws + WS_Y, ws + WS_EWOUT, DM, 64, 4, 1, 8, Hb, modl + 5 * DM, (float*)(ws + WS_PART), P.x, 1.0f); SYNC();
        } else {
            GEMM(EpiOddQKV, ws + WS_A, ws + WS_OWIN, DM, 66, 7, 0, 0, (bf16_t*)(ws + WS_OQ), (bf16_t*)(ws + WS_OK), (bf16_t*)(ws + WS_OV), (bf16_t*)(ws + WS_G), P.o_q_norm, P.o_k_norm, (const f32x2*)(ws + WS_ROPE) + 2048, (LAS float*)(F.lds + RING_BYTES + 1024)); SYNC();
#ifndef NO_CONV
            conv_odd(P, F);
#endif
            for (int rep_ = 0; rep_ < ((PROBE & 1) ? 2 : 1); ++rep_) {
            { const bf16_t* Q = (const bf16_t*)(ws + WS_OQ); const bf16_t* K = (const bf16_t*)(ws + WS_OK); const bf16_t* V = (const bf16_t*)(ws + WS_OV); bf16_t* Y = (bf16_t*)(ws + WS_Y);
              for (int i = 0; i < 2; ++i) { const int u = 2 * F.vcu + i; if (u >= 512) break; const int bh = u >> 5, qb = u & 31, b = bh >> 3, h = bh & 7; const size_t r0 = (size_t)b * SEQT;
                  tat::attn_unit<8, 4, 512, 128, 128, DM>(Q + (r0 + qb * 256) * 512 + h * 64, K + r0 * 128 + (h >> 2) * 64, V + r0 * 128 + (h >> 2) * 64, Y + (r0 + qb * 256) * DM + h * 64, SEQT / 64, (char*)lds_raw, F.wave); } }
            SYNC(); }
        if (PROBE & 8) { GEMM(EpiResidT<false>, ws + WS_Y, ws + WS_OWOUT, DM, 64, 4, 1, 0, Hb, modl + 5 * DM, (float*)(ws + WS_PART), P.x, 0.0f); SYNC(); }
            GEMM(EpiResidT<false>, ws + WS_Y, ws + WS_OWOUT, DM, 64, 4, 1, 0, Hb, modl + 5 * DM, (float*)(ws + WS_PART), P.x, 1.0f); SYNC();
        }
        const int nml = (l == 1) ? 64 : 66, skipc = (l == 1) ? 1 : 0;
        if (PROBE & 4) { norm_phase(P, F, l, 2, 0); SYNC(); }
        norm_phase(P, F, l, 2, (l == 0) ? 8 : 0); SYNC();
        if (PROBE & 2) { GEMM(EpiSwiglu, ws + WS_A, ws + WS_WFI + (size_t)(l * 2 + 1) * NFI * DM * 2, DM, nml, 22, skipc, 0, (bf16_t*)(ws + WS_ACT)); SYNC(); }
        GEMM(EpiSwiglu, ws + WS_A, ws + WS_WFI + (size_t)(l * 2 + 1) * NFI * DM * 2, DM, nml, 22, skipc, 0, (bf16_t*)(ws + WS_ACT)); SYNC();
        if (PROBE & 8) { GEMM(EpiResidT<false>, ws + WS_ACT, ws + WS_WFO + (size_t)(l * 2 + 1) * DM * DFF * 2, DFF, 64, 4, 1, (l == 0 ? 22 : 0), Hb, modl + 8 * DM, (float*)(ws + WS_PART), P.x, 0.0f); SYNC(); }
        if (l == 0) { GEMM(EpiResidT<false>, ws + WS_ACT, ws + WS_WFO + (size_t)(l * 2 + 1) * DM * DFF * 2, DFF, 64, 4, 1, 22, Hb, modl + 8 * DM, (float*)(ws + WS_PART), P.x, 0.5f); SYNC(); }
        else { GEMM(EpiResidNorm<2>, ws + WS_ACT, ws + WS_WFO + (size_t)(l * 2 + 1) * DM * DFF * 2, DFF, 64, 4, 1, 0, Hb, modl + 8 * DM, (float*)(ws + WS_XBUF) + (size_t)T * 4, (unsigned*)(ws + WS_CTL) + 16384 + 8192, (LAS float*)(F.lds + RING_BYTES + 1024), (bf16_t*)(ws + WS_A), P.final_g, modl, P.out, 0.5f); }
        }
    { constexpr int l = 1;
        const float* modl = MOD + (size_t)l * 3 * 9 * DM;
        if (PROBE & 4) { norm_phase(P, F, l, 0, 0); SYNC(); }
        norm_phase(P, F, l, 0, (l == 1) ? 22 : 0); SYNC();
        if (PROBE & 2) { GEMM(EpiSwiglu, ws + WS_A, ws + WS_WFI + (size_t)(l * 2 + 0) * NFI * DM * 2, DM, 66, 22, 0, 0, (bf16_t*)(ws + WS_ACT)); SYNC(); }
        GEMM(EpiSwiglu, ws + WS_A, ws + WS_WFI + (size_t)(l * 2 + 0) * NFI * DM * 2, DM, 66, 22, 0, 0, (bf16_t*)(ws + WS_ACT)); SYNC();
        if (PROBE & 8) { GEMM(EpiResidT<(l == 0)>, ws + WS_ACT, ws + WS_WFO + (size_t)(l * 2 + 0) * DM * DFF * 2, DFF, 64, 4, 1, 22, Hb, modl + 2 * DM, (float*)(ws + WS_PART), P.x, 0.0f); SYNC(); }
        GEMM(EpiResidT<(l == 0)>, ws + WS_ACT, ws + WS_WFO + (size_t)(l * 2 + 0) * DM * DFF * 2, DFF, 64, 4, 1, 22, Hb, modl + 2 * DM, (float*)(ws + WS_PART), P.x, 0.5f); SYNC();
        if (PROBE & 4) { norm_phase(P, F, l, 1, 0); SYNC(); }
        norm_phase(P, F, l, 1, 22); SYNC();
        if (l == 0) {
            GEMM(EpiEvenIn, ws + WS_A, ws + WS_EWIN, DM, 66, 8, 0, 0, (bf16_t*)(ws + WS_SB), (bf16_t*)(ws + WS_CX), (bf16_t*)(ws + WS_QAN), (bf16_t*)(ws + WS_KVAN), (bf16_t*)(ws + WS_EK), P.e_q_norm, P.e_kv_norm, (const f32x2*)(ws + WS_ROPE), (LAS float*)(F.lds + RING_BYTES + 1024));
            if (blockIdx.x >= 16) { Fr F2 = F; F2.lane = fresh_lane(); tr_items(P, F2, 1, ((int)blockIdx.x - 16) * NWAVES + F.wave, (F.G - 16) * NWAVES); }
            SYNC();
            if (F.G == 256) { if (blockIdx.x < 206) conv_even(P, F, 0, 11536, (int)blockIdx.x * NWAVES + F.wave, 206 * NWAVES); else conv_even(P, F, 11536, T, ((int)blockIdx.x - 206) * NWAVES + F.wave, 50 * NWAVES); }
            else conv_even(P, F, 0, T, F.gw, F.NGW);
            GEMM(EpiQb, ws + WS_QAN, ws + WS_EWQB, 256, 66, 3, 0, 0, (bf16_t*)(ws + WS_EQ), (const f32x2*)(ws + WS_ROPE));
            GEMM_ROT(58, EpiKVb, ws + WS_KVAN, ws + WS_EWKVB, 128, 66, 4, 0, 0, (bf16_t*)(ws + WS_EK), (bf16_t*)(ws + WS_EV));
            SYNC();
            for (int rep_ = 0; rep_ < ((PROBE & 1) ? 2 : 1); ++rep_) {
            { const bf16_t* Q = (const bf16_t*)(ws + WS_EQ); const bf16_t* K = (const bf16_t*)(ws + WS_EK); const bf16_t* V = (const bf16_t*)(ws + WS_EV); bf16_t* Y = (bf16_t*)(ws + WS_Y);
              for (int i = 0; i < 2; ++i) { const int u = 2 * F.vcu + i; if (u >= 512) break; const int bh = u >> 5, qb = u & 31, b = bh >> 3, h = bh & 7; const size_t r0 = (size_t)b * SEQT;
                  tat::attn_unit<8, 6, 768, 768, 512, DM>(Q + (r0 + qb * 256) * 768 + h * 96, K + r0 * 768 + h * 96, V + r0 * 512 + h * 64, Y + (r0 + qb * 256) * DM + 512 + h * 64, SEQT / 64, (char*)lds_raw, F.wave); }
              if ((F.vcu & 15) == 0 && F.vcu < 256) { const int bh = F.vcu >> 4, b = bh >> 3, h = bh & 7; const size_t r0 = (size_t)b * SEQT + SEQ;
                  tat::attn_unit<8, 6, 768, 768, 512, DM>(Q + r0 * 768 + h * 96, K + r0 * 768 + h * 96, V + r0 * 512 + h * 64, Y + r0 * DM + 512 + h * 64, CTXL / 64, (char*)lds_raw, F.wave); } }
            SYNC(); }
        if (PROBE & 8) { GEMM(EpiResidT<false>, ws + WS_Y, ws + WS_EWOUT, DM, 64, 4, 1, 8, Hb, modl + 5 * DM, (float*)(ws + WS_PART), P.x, 0.0f); SYNC(); }
            GEMM(EpiResidT<false>, ws + WS_Y, ws + WS_EWOUT, DM, 64, 4, 1, 8, Hb, modl + 5 * DM, (float*)(ws + WS_PART), P.x, 1.0f); SYNC();
        } else {
            GEMM(EpiOddQKV, ws + WS_A, ws + WS_OWIN, DM, 66, 7, 0, 0, (bf16_t*)(ws + WS_OQ), (bf16_t*)(ws + WS_OK), (bf16_t*)(ws + WS_OV), (bf16_t*)(ws + WS_G), P.o_q_norm, P.o_k_norm, (const f32x2*)(ws + WS_ROPE) + 2048, (LAS float*)(F.lds + RING_BYTES + 1024)); SYNC();
#ifndef NO_CONV
            conv_odd(P, F);
#endif
            for (int rep_ = 0; rep_ < ((PROBE & 1) ? 2 : 1); ++rep_) {
            { const bf16_t* Q = (const bf16_t*)(ws + WS_OQ); const bf16_t* K = (const bf16_t*)(ws + WS_OK); const bf16_t* V = (const bf16_t*)(ws + WS_OV); bf16_t* Y = (bf16_t*)(ws + WS_Y);
              for (int i = 0; i < 2; ++i) { const int u = 2 * F.vcu + i; if (u >= 512) break; const int bh = u >> 5, qb = u & 31, b = bh >> 3, h = bh & 7; const size_t r0 = (size_t)b * SEQT;
                  tat::attn_unit<8, 4, 512, 128, 128, DM>(Q + (r0 + qb * 256) * 512 + h * 64, K + r0 * 128 + (h >> 2) * 64, V + r0 * 128 + (h >> 2) * 64, Y + (r0 + qb * 256) * DM + h * 64, SEQT / 64, (char*)lds_raw, F.wave); } }
            SYNC(); }
        if (PROBE & 8) { GEMM(EpiResidT<false>, ws + WS_Y, ws + WS_OWOUT, DM, 64, 4, 1, 0, Hb, modl + 5 * DM, (float*)(ws + WS_PART), P.x, 0.0f); SYNC(); }
            GEMM(EpiResidT<false>, ws + WS_Y, ws + WS_OWOUT, DM, 64, 4, 1, 0, Hb, modl + 5 * DM, (float*)(ws + WS_PART), P.x, 1.0f); SYNC();
        }
        const int nml = (l == 1) ? 64 : 66, skipc = (l == 1) ? 1 : 0;
        if (PROBE & 4) { norm_phase(P, F, l, 2, 0); SYNC(); }
        norm_phase(P, F, l, 2, (l == 0) ? 8 : 0); SYNC();
        if (PROBE & 2) { GEMM(EpiSwiglu, ws + WS_A, ws + WS_WFI + (size_t)(l * 2 + 1) * NFI * DM * 2, DM, nml, 22, skipc, 0, (bf16_t*)(ws + WS_ACT)); SYNC(); }
        GEMM(EpiSwiglu, ws + WS_A, ws + WS_WFI + (size_t)(l * 2 + 1) * NFI * DM * 2, DM, nml, 22, skipc, 0, (bf16_t*)(ws + WS_ACT)); SYNC();
        if (PROBE & 8) { GEMM(EpiResidT<false>, ws + WS_ACT, ws + WS_WFO + (size_t)(l * 2 + 1) * DM * DFF * 2, DFF, 64, 4, 1, (l == 0 ? 22 : 0), Hb, modl + 8 * DM, (float*)(ws + WS_PART), P.x, 0.0f); SYNC(); }
        if (l == 0) { GEMM(EpiResidT<false>, ws + WS_ACT, ws + WS_WFO + (size_t)(l * 2 + 1) * DM * DFF * 2, DFF, 64, 4, 1, 22, Hb, modl + 8 * DM, (float*)(ws + WS_PART), P.x, 0.5f); SYNC(); }
        else { GEMM(EpiResidNorm<2>, ws + WS_ACT, ws + WS_WFO + (size_t)(l * 2 + 1) * DM * DFF * 2, DFF, 64, 4, 1, 0, Hb, modl + 8 * DM, (float*)(ws + WS_XBUF) + (size_t)T * 4, (unsigned*)(ws + WS_CTL) + 16384 + 8192, (LAS float*)(F.lds + RING_BYTES + 1024), (bf16_t*)(ws + WS_A), P.final_g, modl, P.out, 0.5f); }
        }
}

extern "C" void kernel_launch(void* const* d_in, const int* in_sizes, int n_in, void* d_out, int out_size, void* d_ws, size_t ws_size, hipStream_t stream) {
    static int grid = 0;
    if (grid == 0) {
        if (n_in != 25 || out_size != NB * SEQ * DM || ws_size < WS_END) { fprintf(stderr, "kernel_launch: unexpected shapes (n_in %d out %d ws %zu)\n", n_in, out_size, ws_size); grid = -1; return; }
        int dev = 0, cus = 0, per_cu = 0;
        hipGetDevice(&dev); hipDeviceGetAttribute(&cus, hipDeviceAttributeMultiprocessorCount, dev);
        if (hipFuncSetAttribute((const void*)hybrid_fwd, hipFuncAttributeMaxDynamicSharedMemorySize, LDS_BYTES) != hipSuccess) { fprintf(stderr, "kernel_launch: hipFuncSetAttribute failed\n"); grid = -1; return; }
        if (hipOccupancyMaxActiveBlocksPerMultiprocessor(&per_cu, (const void*)hybrid_fwd, NWAVES * 64, LDS_BYTES) != hipSuccess || per_cu < 1) { fprintf(stderr, "kernel_launch: occupancy query gives %d\n", per_cu); per_cu = 1; }
        (void)hipGetLastError();
        grid = cus * 1;
        fprintf(stderr, "kernel_launch: grid %d (per_cu %d)\n", grid, per_cu);
    }
    if (grid < 0) return;
    hipMemsetAsync((char*)d_ws + WS_CTL, 0, ZERO_BYTES, stream);
    Params p{};
    const float** pp = (const float**)&p;
    for (int i = 0; i < 25; ++i) pp[i] = (const float*)d_in[i];
    p.out = (float*)d_out; p.ws = (unsigned char*)d_ws;
    void* args[] = {&p};
    hipError_t e = hipLaunchCooperativeKernel((const void*)hybrid_fwd, dim3(grid), dim3(NWAVES * 64), args, LDS_BYTES, stream);
    if (e != hipSuccess) fprintf(stderr, "cooperative launch failed: %s (grid %d)\n", hipGetErrorString(e), grid);
}
```

```cpp
#include <hip/hip_runtime.h>
#include <hip/hip_cooperative_groups.h>
#include <cstdio>
#include <cstdint>
#include <cmath>
namespace cg = cooperative_groups;
__device__ __forceinline__ int fresh_lane() { int l; asm volatile("v_mbcnt_lo_u32_b32 %0, -1, 0\n\tv_mbcnt_hi_u32_b32 %0, -1, %0" : "=v"(l)); return l; }
__device__ __forceinline__ int fresh_wave() { return (int)__builtin_amdgcn_readfirstlane(threadIdx.x >> 6); }
namespace pg8 {
#define PG8_LAS __attribute__((address_space(3)))
typedef unsigned short bf16_t;
typedef short bf16x8 __attribute__((ext_vector_type(8)));
typedef float f32x4 __attribute__((ext_vector_type(4)));
typedef unsigned u32x4 __attribute__((ext_vector_type(4)));
constexpr int BM = 256, BK = 64, HALF = 128, HTB = HALF * BK * 2  , STAGE_BYTES = 8 * HTB, NXCD = 8, WGM = 8;

__host__ __device__ __forceinline__ int lds_byte(int r, int c) { const int st = (r >> 4) * 2 + (c >> 5), rr = r & 15, cc = c & 31, ob = rr * 64 + cc * 2; return st * 1024 + (ob ^ (((ob >> 9) & 1) << 5)); }
__host__ __device__ __forceinline__ void stage_rc(int b, int& R, int& C) { const int st = b / 1024, sb = b % 1024, swz = sb ^ (((sb >> 9) & 1) << 5); R = (st >> 1) * 16 + swz / 64; C = (st & 1) * 32 + (swz % 64) / 2; }
__host__ __device__ __forceinline__ int perm32(int rho) { const int n = rho >> 4, i = rho & 15; return 8 * (i >> 2) + 4 * n + (i & 3); }

struct Unit { int pm, pn, kx; };
struct Gemm { const bf16_t* A; const bf16_t* Bt; int M, N, K; };

struct Order {
    int nM, nN, nwg, G, c, skip, ntk, nsub, S;
    __device__ __forceinline__ void init(int nM_, int nN_, int G_, int c_, int skip_, int ntk_, int S_) { nM = nM_; nN = nN_; nwg = nM_ * nN_; G = G_; c = c_; skip = skip_; ntk = ntk_; S = S_; nsub = S_ ? 2 * nN_ * S_ : 0; }
    __device__ __forceinline__ bool next(int i, Unit& u) const {
        const long L = (long)i * G + c; if (L >= nwg + nsub) return false;
        if (L < nsub) { const int r = (int)L, s = r % S, tile = r / S; const int nts = ntk / S; u.pn = tile % nN; u.pm = 32 + 33 * (tile / nN); u.kx = (s * nts) | (nts << 8) | (1 << 16) | (s << 17); return true; }
        int wgid = (int)L - nsub; { const int q = nwg / NXCD, r = nwg % NXCD, xcd = wgid % NXCD, off = wgid / NXCD; wgid = (xcd < r ? xcd * (q + 1) : r * (q + 1) + (xcd - r) * q) + off; }
        const int nig = WGM * nN, gid = wgid / nig, fm = gid * WGM, gsz = (nM - fm) < WGM ? (nM - fm) : WGM;
        int pm = fm + ((wgid % nig) % gsz); if (skip) pm += pm >> 5;
        u.pm = pm; u.pn = (wgid % nig) / gsz; u.kx = ntk << 8; return true;
    }
    __device__ __forceinline__ void a_ready(const Unit&) const {}
    __device__ __forceinline__ void done(const Unit&) const {}
};
__device__ __forceinline__ unsigned cvt_pk_bf16(float lo, float hi) { unsigned r; asm volatile("v_cvt_pk_bf16_f32 %0, %1, %2" : "=v"(r) : "v"(lo), "v"(hi)); return r; }
template <class Epi, class Sched, bool ALIGN_EPI = false, bool SP2 = false>
__device__ __forceinline__ void gemm_phase(PG8_LAS unsigned char* lds, const Gemm g, const Sched& S, const Epi& E, const int wave_id) {
    const int wid = wave_id, lane = fresh_lane(), tid = wid * 64 + lane, wr = wid >> 2, wc = wid & 3, fr = lane & 15, fq = lane >> 4;
    const int K = g.K;
    unsigned voffA[2], voffB[2];
#pragma unroll
    for (int i = 0; i < 2; ++i) { int R, C; stage_rc(tid * 16 + i * 8192, R, C); const int Rb = Epi::PERM ? ((R & ~31) + perm32(R & 31)) : R;
        voffA[i] = (unsigned)(R * K + C) * 2u; voffB[i] = (unsigned)(Rb * K + C) * 2u; }
    const size_t kstep = (size_t)(BK * 2);
    const size_t hstep = (size_t)HALF * K * 2;
    const size_t tstep = 2 * hstep;
    const unsigned ldsw = (unsigned)wid * 1024u;
    const int aoff = lds_byte(wr * 64 + fr, fq * 8), boff = lds_byte(wc * 32 + fr, fq * 8);
#define PG8_SA(b, h) (((b) * 2 + (h)) * HTB)
#define PG8_SB(b, h) ((4 + (b) * 2 + (h)) * HTB)
#define PG8_STAGE(bufoff, gbase, voff) do { _Pragma("unroll") for (int _i = 0; _i < 2; ++_i) \
        __builtin_amdgcn_global_load_lds((const unsigned*)((const char*)(gbase) + (voff)[_i]), (PG8_LAS unsigned*)(lds + (bufoff) + ldsw + _i * 8192), 16, 0, 0); } while (0)
#define PG8_LDA(dst, b, h) do { _Pragma("unroll") for (int m = 0; m < 4; ++m) _Pragma("unroll") for (int k = 0; k < 2; ++k) dst[m][k] = *(const PG8_LAS bf16x8*)(lds + PG8_SA(b, h) + aoff + m * 2048 + k * 1024); } while (0)
#define PG8_LDB(dst, b, h) do { _Pragma("unroll") for (int n = 0; n < 2; ++n) _Pragma("unroll") for (int k = 0; k < 2; ++k) dst[n][k] = *(const PG8_LAS bf16x8*)(lds + PG8_SB(b, h) + boff + n * 2048 + k * 1024); } while (0)
#define PG8_MMA(ai, bj, At, Bt) do { __builtin_amdgcn_s_setprio(1); _Pragma("unroll") for (int m = 0; m < 4; ++m) _Pragma("unroll") for (int n = 0; n < 2; ++n) _Pragma("unroll") for (int k = 0; k < 2; ++k) \
        acc[ai][bj][m][n] = __builtin_amdgcn_mfma_f32_16x16x32_bf16(Bt[n][k], At[m][k], acc[ai][bj][m][n], 0, 0, 0); __builtin_amdgcn_s_setprio(0); } while (0)
#define PG8_WAIT_V(n) asm volatile("s_waitcnt vmcnt(" #n ")" ::: "memory")
#define PG8_WAIT_L(n) asm volatile("s_waitcnt lgkmcnt(" #n ")" ::: "memory")
#define PG8_BAR __builtin_amdgcn_s_barrier()
#define PG8_SCHED __builtin_amdgcn_sched_barrier(0)
    Unit cur, nxt; int ui = 0;
    if (!S.next(0, cur)) return;
    f32x4 acc[2][2][4][2];
#pragma unroll
    for (int a = 0; a < 2; ++a)
#pragma unroll
        for (int b = 0; b < 2; ++b)
#pragma unroll
            for (int m = 0; m < 4; ++m)
#pragma unroll
                for (int n = 0; n < 2; ++n) acc[a][b][m][n] = (f32x4){0.f, 0.f, 0.f, 0.f};
    bf16x8 At[4][2], B0[2][2], B1[2][2];
    const char* cA = (const char*)g.A + (size_t)cur.pm * tstep + (size_t)(cur.kx & 255) * kstep; const char* cB = (const char*)g.Bt + (size_t)cur.pn * tstep + (size_t)(cur.kx & 255) * kstep;
    S.a_ready(cur);
    if constexpr (SP2) {
        PG8_STAGE(PG8_SB(0, 0), cB, voffB); PG8_STAGE(PG8_SB(0, 1), cB + hstep, voffB); PG8_STAGE(PG8_SA(0, 0), cA, voffA); PG8_STAGE(PG8_SA(0, 1), cA + hstep, voffA);
        if (wr == 1) PG8_BAR;
        PG8_WAIT_V(2); PG8_BAR;
        PG8_STAGE(PG8_SB(1, 0), cB + kstep, voffB); PG8_STAGE(PG8_SA(1, 0), cA + kstep, voffA); PG8_STAGE(PG8_SB(1, 1), cB + hstep + kstep, voffB);
        PG8_WAIT_V(6); PG8_BAR;
    } else {
        PG8_STAGE(PG8_SB(0, 0), cB, voffB); PG8_STAGE(PG8_SA(0, 0), cA, voffA); PG8_STAGE(PG8_SB(0, 1), cB + hstep, voffB); PG8_STAGE(PG8_SA(0, 1), cA + hstep, voffA);
        if (wr == 1) PG8_BAR;
        PG8_WAIT_V(4); PG8_BAR;
        PG8_STAGE(PG8_SB(1, 0), cB + kstep, voffB); PG8_STAGE(PG8_SA(1, 0), cA + kstep, voffA); PG8_STAGE(PG8_SB(1, 1), cB + hstep + kstep, voffB);
        PG8_WAIT_V(6); PG8_BAR;
    }
    for (;;) {
        const bool has_next = S.next(ui + 1, nxt);
        const char* nA = has_next ? (const char*)g.A + (size_t)nxt.pm * tstep + (size_t)(nxt.kx & 255) * kstep : cA; const char* nB = has_next ? (const char*)g.Bt + (size_t)nxt.pn * tstep + (size_t)(nxt.kx & 255) * kstep : cB;
        const int nt = (cur.kx >> 8) & 255;
        for (int t = 0; t < nt; t += 2) {
            const bool last = (t == nt - 2);
            const char* a1 = cA + (size_t)(t + 1) * kstep;
            const char* a2 = last ? nA : cA + (size_t)(t + 2) * kstep; const char* b2 = last ? nB : cB + (size_t)(t + 2) * kstep;
            const char* a3 = a2 + kstep; const char* b3 = b2 + kstep;
            if (last && has_next) S.a_ready(nxt);
            if constexpr (SP2) {
            PG8_LDB(B0, 0, 0); PG8_LDB(B1, 0, 1); PG8_SCHED; PG8_LDA(At, 0, 0); PG8_STAGE(PG8_SA(1, 1), a1 + hstep, voffA);
            PG8_WAIT_V(8); PG8_WAIT_L(0); PG8_BAR; PG8_MMA(0, 0, At, B0); PG8_MMA(0, 1, At, B1); PG8_BAR; PG8_SCHED;
            PG8_LDA(At, 0, 1); PG8_STAGE(PG8_SB(0, 0), b2, voffB); PG8_STAGE(PG8_SB(0, 1), b2 + hstep, voffB); PG8_STAGE(PG8_SA(0, 0), a2, voffA);
            PG8_WAIT_V(8); PG8_WAIT_L(0); PG8_BAR; PG8_MMA(1, 0, At, B0); PG8_MMA(1, 1, At, B1); PG8_BAR; PG8_SCHED;
            PG8_LDB(B0, 1, 0); PG8_LDB(B1, 1, 1); PG8_SCHED; PG8_LDA(At, 1, 0); PG8_STAGE(PG8_SA(0, 1), a2 + hstep, voffA);
            PG8_WAIT_V(8); PG8_WAIT_L(0); PG8_BAR; PG8_MMA(0, 0, At, B0); PG8_MMA(0, 1, At, B1); PG8_BAR; PG8_SCHED;
            PG8_LDA(At, 1, 1); PG8_STAGE(PG8_SB(1, 0), b3, voffB); PG8_STAGE(PG8_SB(1, 1), b3 + hstep, voffB); PG8_STAGE(PG8_SA(1, 0), a3, voffA);
            PG8_WAIT_V(8); PG8_WAIT_L(0); PG8_BAR; PG8_MMA(1, 0, At, B0); PG8_MMA(1, 1, At, B1); PG8_BAR; PG8_SCHED;
            } else {
            PG8_LDB(B0, 0, 0); PG8_SCHED; PG8_LDA(At, 0, 0); PG8_STAGE(PG8_SA(1, 1), a1 + hstep, voffA);
            PG8_WAIT_L(8); PG8_BAR; PG8_WAIT_L(0); PG8_MMA(0, 0, At, B0); PG8_BAR; PG8_SCHED;
            PG8_LDB(B1, 0, 1); PG8_STAGE(PG8_SB(0, 0), b2, voffB);
            PG8_BAR; PG8_WAIT_L(0); PG8_MMA(0, 1, At, B1); PG8_BAR;
            PG8_LDA(At, 0, 1); PG8_STAGE(PG8_SA(0, 0), a2, voffA);
            PG8_BAR; PG8_WAIT_L(0); PG8_MMA(1, 0, At, B0); PG8_BAR; PG8_SCHED;
            PG8_STAGE(PG8_SB(0, 1), b2 + hstep, voffB);
            PG8_WAIT_V(6); PG8_BAR; PG8_MMA(1, 1, At, B1); PG8_BAR;
            PG8_LDB(B0, 1, 0); PG8_SCHED; PG8_LDA(At, 1, 0); PG8_STAGE(PG8_SA(0, 1), a2 + hstep, voffA);
            PG8_WAIT_L(8); PG8_BAR; PG8_WAIT_L(0); PG8_MMA(0, 0, At, B0); PG8_BAR; PG8_SCHED;
            PG8_LDB(B1, 1, 1); PG8_STAGE(PG8_SB(1, 0), b3, voffB);
            PG8_BAR; PG8_WAIT_L(0); PG8_MMA(0, 1, At, B1); PG8_BAR;
            PG8_LDA(At, 1, 1); PG8_STAGE(PG8_SA(1, 0), a3, voffA);
            PG8_BAR; PG8_WAIT_L(0); PG8_MMA(1, 0, At, B0); PG8_BAR; PG8_SCHED;
            PG8_STAGE(PG8_SB(1, 1), b3 + hstep, voffB);
            PG8_WAIT_V(6); PG8_BAR; PG8_MMA(1, 1, At, B1); PG8_BAR;
            }
        }
        if constexpr (ALIGN_EPI) { if (wr == 0) PG8_BAR; }
        if constexpr (!Epi::AFTER_DRAIN) { E(acc, cur, wr, wc, fr, fq); S.done(cur); }
        if (!has_next) break;
#pragma unroll
        for (int a = 0; a < 2; ++a)
#pragma unroll
            for (int b = 0; b < 2; ++b)
#pragma unroll
                for (int m = 0; m < 4; ++m)
#pragma unroll
                    for (int n = 0; n < 2; ++n) acc[a][b][m][n] = (f32x4){0.f, 0.f, 0.f, 0.f};
        cur = nxt; cA = nA; cB = nB; ++ui;
        if constexpr (ALIGN_EPI) { if (wr == 1) PG8_BAR; }
    }
    PG8_WAIT_V(0);
    if constexpr (!ALIGN_EPI) { if (wr == 0) PG8_BAR; }
    PG8_BAR;
    if constexpr (Epi::AFTER_DRAIN) { E.fused(acc, cur, wr, wc, fr, fq, lds, wid, lane); S.done(cur); }
#undef PG8_SA
#undef PG8_SB
#undef PG8_STAGE
#undef PG8_LDA
#undef PG8_LDB
#undef PG8_MMA
#undef PG8_WAIT_V
#undef PG8_WAIT_L
#undef PG8_BAR
#undef PG8_SCHED
}
}

#define LAS __attribute__((address_space(3)))
typedef unsigned short bf16_t;
typedef float f32x4 __attribute__((ext_vector_type(4)));
typedef float f32x2 __attribute__((ext_vector_type(2)));
typedef float f32x16 __attribute__((ext_vector_type(16)));
typedef short bf16x8 __attribute__((ext_vector_type(8)));
typedef short s16x4 __attribute__((ext_vector_type(4)));
typedef unsigned u32x4 __attribute__((ext_vector_type(4)));
typedef unsigned u32x2 __attribute__((ext_vector_type(2)));
typedef __bf16 bf16x2_t __attribute__((ext_vector_type(2)));

constexpr int DM = 1024, NB = 2, SEQ = 8192, CTXL = 256, SEQT = SEQ + CTXL, T = NB * SEQT;
constexpr int DFF = 2816, NFI = 2 * DFF;
constexpr int E_IN = 1952, E_INP = 2048, O_IN = 1792;
constexpr float EPS = 1e-6f;
constexpr float LOG2E = 1.4426950408889634f;
constexpr float C2_MLA = 0.10206207261596575f * LOG2E;
constexpr float C2_GQA = 0.125f * LOG2E;
constexpr int NWAVES = 8;

constexpr size_t MiB = 1u << 20;
constexpr size_t WS_XBUF = 256 * 1024  ;
constexpr size_t WS_CTL = 0, WS_MOD = 1 * MiB, WS_ROPE = 1 * MiB + 512 * 1024, ZERO_BYTES = 2 * MiB;
constexpr size_t WS_WFI = 2 * MiB, WS_WFO = 46 * MiB, WS_EWIN = 68 * MiB, WS_EWQB = 72 * MiB, WS_EWKVB = 73 * MiB, WS_EWOUT = 74 * MiB, WS_OWIN = 76 * MiB, WS_OWOUT = 80 * MiB;
constexpr size_t WS_H = 82 * MiB, WS_A = 148 * MiB, WS_SCR = 181 * MiB;
constexpr size_t WS_ACT = WS_SCR, WS_P = WS_SCR, WS_EQ = 181 * MiB, WS_EK = 206 * MiB, WS_EV = 231 * MiB, WS_Y = 248 * MiB;
constexpr size_t WS_QAN = 281 * MiB, WS_KVAN = 290 * MiB, WS_KR = 295 * MiB, WS_G = 281 * MiB, WS_OQ = 298 * MiB, WS_OK = 315 * MiB, WS_OV = 320 * MiB, WS_SB = 300 * MiB  , WS_CX = 317 * MiB, WS_PART = 300 * MiB  , WS_END = 344 * MiB;
static_assert(WS_WFI + 4 * (size_t)NFI * DM * 2 <= WS_WFO && WS_WFO + 4 * (size_t)DM * DFF * 2 <= WS_EWIN, "ws map");
static_assert(WS_H + (size_t)T * DM * 4 <= WS_A && WS_A + (size_t)T * DM * 2 <= WS_SCR && WS_ACT + (size_t)T * DFF * 2 <= WS_QAN, "ws map");
static_assert(WS_EQ + (size_t)T * 768 * 2 <= WS_EK && WS_EK + (size_t)T * 768 * 2 <= WS_EV && WS_EV + (size_t)T * 512 * 2 <= WS_Y && WS_Y + (size_t)T * DM * 2 <= WS_QAN, "ws map");
static_assert(WS_QAN + (size_t)T * 256 * 2 <= WS_KVAN && WS_KVAN + (size_t)T * 128 * 2 <= WS_KR && WS_KR + (size_t)T * 32 * 2 <= WS_OQ && WS_G + (size_t)T * 512 * 2 <= WS_OQ, "ws map");
static_assert(WS_OQ + (size_t)T * 512 * 2 <= WS_OK && WS_OK + (size_t)T * 128 * 2 <= WS_OV && WS_OV + (size_t)T * 128 * 2 <= WS_END && WS_P + (size_t)T * 2048 * 2 <= WS_Y, "ws map");

constexpr int RING_BYTES = 131072, LDS_BYTES = 147456;

struct Params {
    const float *x, *c, *ctx, *c_ctx, *w_mod, *b_mod, *norm_g, *w_ffn_in, *w_ffn_out;
    const float *e_w_in, *e_conv_w, *e_q_norm, *e_w_q_b, *e_kv_norm, *e_w_kv_b, *e_w_out;
    const float *o_w_in, *o_q_norm, *o_k_norm, *o_conv_w, *o_conv_b, *o_ln_g, *o_ln_b, *o_w_out, *final_g;
    float* out; unsigned char* ws;
};

__device__ __forceinline__ unsigned f2bf(float f) { unsigned u = __builtin_bit_cast(unsigned, f); return (u + 0x7fffu + ((u >> 16) & 1u)) >> 16; }
__device__ __forceinline__ unsigned pk2(float lo, float hi) { f32x2 v = {lo, hi}; bf16x2_t b = __builtin_convertvector(v, bf16x2_t); return __builtin_bit_cast(unsigned, b); }
__device__ __forceinline__ float bf_lo(unsigned w) { return __builtin_bit_cast(float, w << 16); }
__device__ __forceinline__ float bf_hi(unsigned w) { return __builtin_bit_cast(float, w & 0xffff0000u); }
__device__ __forceinline__ void unpack8(const u32x4 w, float (&f)[8]) { f[0] = bf_lo(w.x); f[1] = bf_hi(w.x); f[2] = bf_lo(w.y); f[3] = bf_hi(w.y); f[4] = bf_lo(w.z); f[5] = bf_hi(w.z); f[6] = bf_lo(w.w); f[7] = bf_hi(w.w); }
__device__ __forceinline__ u32x4 pack8(const float (&f)[8]) { u32x4 w; w.x = pk2(f[0], f[1]); w.y = pk2(f[2], f[3]); w.z = pk2(f[4], f[5]); w.w = pk2(f[6], f[7]); return w; }
template <int PAT> __device__ __forceinline__ float swz(float v) { return __builtin_bit_cast(float, __builtin_amdgcn_ds_swizzle(__builtin_bit_cast(int, v), PAT)); }
__device__ __forceinline__ float wave_sum(float v) {
    v += swz<0x041F>(v); v += swz<0x081F>(v); v += swz<0x101F>(v); v += swz<0x201F>(v); v += swz<0x401F>(v);
    auto rr = __builtin_amdgcn_permlane32_swap(__float_as_uint(v), __float_as_uint(v), false, false); return __uint_as_float(rr[0]) + __uint_as_float(rr[1]);
}
__device__ __forceinline__ float rdlane(float v, int k) { return __builtin_bit_cast(float, __builtin_amdgcn_readlane(__builtin_bit_cast(int, v), k)); }
__device__ __forceinline__ float silu_f(float v) { return v * __builtin_amdgcn_rcpf(1.f + __builtin_amdgcn_exp2f(-1.4426950408889634f * v)); }
__device__ __forceinline__ float sigmoid_f(float v) { return __builtin_amdgcn_rcpf(1.f + __builtin_amdgcn_exp2f(-1.4426950408889634f * v)); }
__device__ __forceinline__ int row_mi(int pm) { const int b = pm / 33; return (pm - b * 33 == 32) ? 2 : b; }

using pg8::Unit; using pg8::BM; using pg8::HALF;
#define EPI_FENCE() asm volatile("" ::: "memory")
template <int LDC> struct EpiStoreT {
    static constexpr bool PERM = true, AFTER_DRAIN = false;
    bf16_t* O;
    __device__ __forceinline__ void operator()(const f32x4 (&acc)[2][2][4][2], const Unit& u, int wr, int wc, int fr_, int fq_) const {
        int fr = fr_, fq = fq_; asm volatile("" : "+v"(fr), "+v"(fq));
        const unsigned off0 = (unsigned)(u.pm * BM + wr * 64 + fr) * LDC + (unsigned)(u.pn * BM + wc * 32 + 8 * fq);
#pragma unroll
        for (int ai = 0; ai < 2; ++ai)
#pragma unroll
            for (int m = 0; m < 4; ++m) { const unsigned off = off0 + (unsigned)(ai * HALF + m * 16) * LDC;
#pragma unroll
                for (int bj = 0; bj < 2; ++bj) { const f32x4 v0 = acc[ai][bj][m][0], v1 = acc[ai][bj][m][1]; u32x4 w; w.x = pk2(v0[0], v0[1]); w.y = pk2(v0[2], v0[3]); w.z = pk2(v1[0], v1[1]); w.w = pk2(v1[2], v1[3]);
                    *(u32x4*)(O + off + bj * HALF) = w; }
                EPI_FENCE(); }
    }
};
struct EpiSwiglu {
    static constexpr bool PERM = true, AFTER_DRAIN = false;
    bf16_t* O;
    __device__ __forceinline__ void operator()(const f32x4 (&acc)[2][2][4][2], const Unit& u, int wr, int wc, int fr_, int fq_) const {
        int fr = fr_, fq = fq_; asm volatile("" : "+v"(fr), "+v"(fq));
        const unsigned off0 = (unsigned)(u.pm * BM + wr * 64 + fr) * DFF + (unsigned)(u.pn * HALF + wc * 32 + 8 * fq);
#pragma unroll
        for (int ai = 0; ai < 2; ++ai)
#pragma unroll
            for (int m = 0; m < 4; ++m) { const unsigned off = off0 + (unsigned)(ai * HALF + m * 16) * DFF;
                float r[8];
#pragma unroll
                for (int n = 0; n < 2; ++n)
#pragma unroll
                    for (int e = 0; e < 4; ++e) { const float g = acc[ai][0][m][n][e], up = acc[ai][1][m][n][e]; r[n * 4 + e] = (g * up) * __builtin_amdgcn_rcpf(1.f + __builtin_amdgcn_exp2f(g)); }
                *(u32x4*)(O + off) = pack8(r); EPI_FENCE(); }
    }
};
__device__ __forceinline__ void ld8(const bf16_t* p, float (&f)[8]);
__device__ __forceinline__ void ldf8(const float* p, float (&f)[8]);
template <bool FIRST> struct EpiResidT {
    static constexpr bool PERM = true, AFTER_DRAIN = false;
    bf16_t* H; const float* gate  ; float* part; const float* xin; float coef;
    __device__ __forceinline__ void operator()(const f32x4 (&acc)[2][2][4][2], const Unit& u, int wr, int wc, int fr_, int fq_) const {
        int fr = fr_, fq = fq_; asm volatile("" : "+v"(fr), "+v"(fq));
        const unsigned colp = (unsigned)(u.pn * BM + wc * 32 + 8 * fq), rloc = (unsigned)(wr * 64 + fr);
        const float* gp = gate + (unsigned)row_mi(u.pm) * 9 * DM + colp;
        const unsigned xrow0 = (unsigned)((u.pm / 33) * SEQ + (u.pm % 33) * BM);
#pragma unroll
        for (int bj = 0; bj < 2; ++bj) { const f32x4 gv0 = *(const f32x4*)(gp + bj * HALF) * coef, gv1 = *(const f32x4*)(gp + bj * HALF + 4) * coef;
            if (u.kx >> 16) {
                float* pb = part + ((size_t)(u.kx >> 17) * 512 + (u.pm == 65 ? 256 : 0) + rloc) * DM + colp + bj * HALF;
#pragma unroll
                for (int ai = 0; ai < 2; ++ai)
#pragma unroll
                    for (int m = 0; m < 4; ++m) { float* p = pb + (unsigned)(ai * HALF + m * 16) * DM; *(f32x4*)p = gv0 * acc[ai][bj][m][0]; *(f32x4*)(p + 4) = gv1 * acc[ai][bj][m][1]; }
            } else {
                f32x4 hx[FIRST ? 8 : 1][2]; u32x4 hb[FIRST ? 1 : 8];
#pragma unroll
                for (int ai = 0; ai < 2; ++ai)
#pragma unroll
                    for (int m = 0; m < 4; ++m) { const unsigned rr = rloc + (unsigned)(ai * HALF + m * 16);
                        if (FIRST) { const float* xp = xin + (size_t)(xrow0 + rr) * DM + colp + bj * HALF; hx[FIRST ? ai * 4 + m : 0][0] = *(const f32x4*)xp; hx[FIRST ? ai * 4 + m : 0][1] = *(const f32x4*)(xp + 4); }
                        else hb[FIRST ? 0 : ai * 4 + m] = *(const u32x4*)(H + (size_t)((unsigned)u.pm * BM + rr) * DM + colp + bj * HALF); }
#pragma unroll
                for (int ai = 0; ai < 2; ++ai)
#pragma unroll
                    for (int m = 0; m < 4; ++m) { const unsigned rr = rloc + (unsigned)(ai * HALF + m * 16); float h[8];
                        if (FIRST) { const f32x4 x0 = hx[FIRST ? ai * 4 + m : 0][0], x1 = hx[FIRST ? ai * 4 + m : 0][1]; h[0] = x0[0]; h[1] = x0[1]; h[2] = x0[2]; h[3] = x0[3]; h[4] = x1[0]; h[5] = x1[1]; h[6] = x1[2]; h[7] = x1[3]; }
                        else unpack8(hb[FIRST ? 0 : ai * 4 + m], h);
                        const f32x4 d0 = gv0 * acc[ai][bj][m][0], d1 = gv1 * acc[ai][bj][m][1];
                        h[0] += d0[0]; h[1] += d0[1]; h[2] += d0[2]; h[3] += d0[3]; h[4] += d1[0]; h[5] += d1[1]; h[6] += d1[2]; h[7] += d1[3];
                        *(u32x4*)(H + (size_t)((unsigned)u.pm * BM + rr) * DM + colp + bj * HALF) = pack8(h); }
            }
            EPI_FENCE(); }
    }
};
struct EpiOddIn {
    static constexpr bool PERM = true, AFTER_DRAIN = false;
    bf16_t* O; bf16_t* G;
    __device__ __forceinline__ void operator()(const f32x4 (&acc)[2][2][4][2], const Unit& u, int wr, int wc, int fr_, int fq_) const {
        int fr = fr_, fq = fq_; asm volatile("" : "+v"(fr), "+v"(fq));
        const unsigned row0 = (unsigned)(u.pm * BM + wr * 64 + fr);
        if (u.pn < 3) {
            const unsigned off0 = row0 * 768u + (unsigned)(u.pn * BM + wc * 32 + 8 * fq);
#pragma unroll
            for (int ai = 0; ai < 2; ++ai)
#pragma unroll
                for (int m = 0; m < 4; ++m) { const unsigned off = off0 + (unsigned)(ai * HALF + m * 16) * 768u;
#pragma unroll
                    for (int bj = 0; bj < 2; ++bj) { const f32x4 v0 = acc[ai][bj][m][0], v1 = acc[ai][bj][m][1]; u32x4 w; w.x = pk2(v0[0], v0[1]); w.y = pk2(v0[2], v0[3]); w.z = pk2(v1[0], v1[1]); w.w = pk2(v1[2], v1[3]);
                        *(u32x4*)(O + off + bj * HALF) = w; }
                    EPI_FENCE(); }
        } else {
            const unsigned off0 = row0 * 512u + (unsigned)((u.pn - 3) * HALF + wc * 32 + 8 * fq);
#pragma unroll
            for (int ai = 0; ai < 2; ++ai)
#pragma unroll
                for (int m = 0; m < 4; ++m) { const unsigned off = off0 + (unsigned)(ai * HALF + m * 16) * 512u; float r[8];
#pragma unroll
                    for (int n = 0; n < 2; ++n)
#pragma unroll
                        for (int e = 0; e < 4; ++e) r[n * 4 + e] = acc[ai][0][m][n][e] * sigmoid_f(acc[ai][1][m][n][e]);
                    *(u32x4*)(G + off) = pack8(r); EPI_FENCE(); }
        }
    }
};
struct EpiOddQKV {
    static constexpr bool PERM = true, AFTER_DRAIN = false;
    bf16_t *Q, *K, *V, *G; const float *gq, *gk; const f32x2* rope  ; LAS float* xch;
    __device__ __forceinline__ void operator()(const f32x4 (&acc)[2][2][4][2], const Unit& u, int wr, int wc, int fr_, int fq_) const {
        int fr = fr_, fq = fq_; asm volatile("" : "+v"(fr), "+v"(fq));
        const unsigned row0 = (unsigned)(u.pm * BM + wr * 64 + fr);
        if (u.pn >= 3) {
            const unsigned off0 = row0 * 512u + (unsigned)((u.pn - 3) * HALF + wc * 32 + 8 * fq);
#pragma unroll
            for (int ai = 0; ai < 2; ++ai)
#pragma unroll
                for (int m = 0; m < 4; ++m) { const unsigned off = off0 + (unsigned)(ai * HALF + m * 16) * 512u; float r[8];
#pragma unroll
                    for (int n = 0; n < 2; ++n)
#pragma unroll
                        for (int e = 0; e < 4; ++e) r[n * 4 + e] = acc[ai][0][m][n][e] * sigmoid_f(acc[ai][1][m][n][e]);
                    *(u32x4*)(G + off) = pack8(r); EPI_FENCE(); }
            return;
        }
        const int wid = wr * 4 + wc;
        float ps[2][4][2];
#pragma unroll
        for (int ai = 0; ai < 2; ++ai)
#pragma unroll
            for (int m = 0; m < 4; ++m)
#pragma unroll
                for (int bj = 0; bj < 2; ++bj) { const f32x4 a = acc[ai][bj][m][0], b = acc[ai][bj][m][1];
                    float s_ = (a[0] * a[0] + a[1] * a[1]) + (a[2] * a[2] + a[3] * a[3]) + (b[0] * b[0] + b[1] * b[1]) + (b[2] * b[2] + b[3] * b[3]);
                    s_ += swz<0x401F>(s_);
                    { auto rr = __builtin_amdgcn_permlane32_swap(__float_as_uint(s_), __float_as_uint(s_), false, false); s_ = __uint_as_float(rr[0]) + __uint_as_float(rr[1]); }
                    ps[ai][m][bj] = s_;
                    if (fq == 0) xch[(((wid * 2 + ai) * 4 + m) * 2 + bj) * 16 + fr] = s_; }
        asm volatile("s_waitcnt lgkmcnt(0)\n\ts_barrier" ::: "memory");
        const int pw_ = wr * 4 + (wc ^ 1);
        const bool lat = (u.pm % 33) != 32; const int t0 = (int)row0 - (u.pm / 33) * SEQT;
        const int d0 = 32 * (wc & 1) + 8 * fq;
        float gqv[8], gkv[8];
        { const f32x4 x0 = *(const f32x4*)(gq + d0), x1 = *(const f32x4*)(gq + d0 + 4), y0 = *(const f32x4*)(gk + d0), y1 = *(const f32x4*)(gk + d0 + 4);
#pragma unroll
          for (int e = 0; e < 4; ++e) { gqv[e] = x0[e]; gqv[4 + e] = x1[e]; gkv[e] = y0[e]; gkv[4 + e] = y1[e]; } }
#pragma unroll
        for (int ai = 0; ai < 2; ++ai)
#pragma unroll
            for (int m = 0; m < 4; ++m) { const unsigned rr_ = (unsigned)(ai * HALF + m * 16); const int t = t0 + (int)rr_;
                f32x4 c01 = {1.f, 0.f, 1.f, 0.f}, c23 = {1.f, 0.f, 1.f, 0.f};
                if (lat) { const int pos = (wc & 1) ? (t & 63) : (t >> 6); const f32x4* rp = (const f32x4*)(rope + pos * 16 + 4 * fq); c01 = rp[0]; c23 = rp[1]; }
#pragma unroll
                for (int bj = 0; bj < 2; ++bj) { const f32x4 a = acc[ai][bj][m][0], b = acc[ai][bj][m][1];
                    float v[8] = {a[0], a[1], a[2], a[3], b[0], b[1], b[2], b[3]};
                    if (u.pn == 2 && bj == 1) {
                        *(u32x4*)(V + (size_t)(row0 + rr_) * 128 + wc * 32 + 8 * fq) = pack8(v); continue; }
                    const float tot = ps[ai][m][bj] + xch[(((pw_ * 2 + ai) * 4 + m) * 2 + bj) * 16 + fr];
                    const float rstd = 1.f / sqrtf(tot * (1.f / 64.f) + EPS);
                    const bool isq = (u.pn < 2); const float sc_ = isq ? C2_GQA : 1.f;
                    float o[8];
#pragma unroll
                    for (int p = 0; p < 4; ++p) { const float x0 = v[2 * p] * rstd * (isq ? gqv[2 * p] : gkv[2 * p]), x1 = v[2 * p + 1] * rstd * (isq ? gqv[2 * p + 1] : gkv[2 * p + 1]);
                        const float cs = (p < 2) ? c01[2 * p] : c23[2 * p - 4], sn = (p < 2) ? c01[2 * p + 1] : c23[2 * p - 3];
                        o[2 * p] = (x0 * cs - x1 * sn) * sc_; o[2 * p + 1] = (x0 * sn + x1 * cs) * sc_; }
                    if (isq) *(u32x4*)(Q + (size_t)(row0 + rr_) * 512 + u.pn * BM + bj * HALF + wc * 32 + 8 * fq) = pack8(o);
                    else *(u32x4*)(K + (size_t)(row0 + rr_) * 128 + wc * 32 + 8 * fq) = pack8(o); }
                EPI_FENCE(); }
    }
};
struct EpiEvenIn {
    static constexpr bool PERM = true, AFTER_DRAIN = false;
    bf16_t *SB, *CX, *QAN, *KVAN, *KR; const float *gq, *gkv; const f32x2* rope  ; LAS float* xch;
    __device__ __forceinline__ void operator()(const f32x4 (&acc)[2][2][4][2], const Unit& u, int wr, int wc, int fr_, int fq_) const {
        int fr = fr_, fq = fq_; asm volatile("" : "+v"(fr), "+v"(fq));
        const unsigned row0 = (unsigned)(u.pm * BM + wr * 64 + fr);
        if (u.pn < 2) {
            const unsigned off0 = row0 * 512u + (unsigned)(u.pn * BM + wc * 32 + 8 * fq);
#pragma unroll
            for (int ai = 0; ai < 2; ++ai)
#pragma unroll
                for (int m = 0; m < 4; ++m) { const unsigned off = off0 + (unsigned)(ai * HALF + m * 16) * 512u;
#pragma unroll
                    for (int bj = 0; bj < 2; ++bj) { const f32x4 v0 = acc[ai][bj][m][0], v1 = acc[ai][bj][m][1]; u32x4 w; w.x = pk2(v0[0], v0[1]); w.y = pk2(v0[2], v0[3]); w.z = pk2(v1[0], v1[1]); w.w = pk2(v1[2], v1[3]);
                        *(u32x4*)(SB + off + bj * HALF) = w; }
                    EPI_FENCE(); }
            return;
        }
        if (u.pn < 6) {
            const unsigned off0 = row0 * 512u + (unsigned)((u.pn - 2) * HALF + wc * 32 + 8 * fq);
#pragma unroll
            for (int ai = 0; ai < 2; ++ai)
#pragma unroll
                for (int m = 0; m < 4; ++m) { const unsigned off = off0 + (unsigned)(ai * HALF + m * 16) * 512u; float r[8];
#pragma unroll
                    for (int n = 0; n < 2; ++n)
#pragma unroll
                        for (int e = 0; e < 4; ++e) r[n * 4 + e] = acc[ai][0][m][n][e] * acc[ai][1][m][n][e];
                    *(u32x4*)(CX + off) = pack8(r); EPI_FENCE(); }
            return;
        }
        const bool isq = (u.pn == 6);
        const int wid = wr * 4 + wc;
        float ps[2][4];
#pragma unroll
        for (int ai = 0; ai < 2; ++ai)
#pragma unroll
            for (int m = 0; m < 4; ++m) { float s_ = 0.f;
#pragma unroll
                for (int bj = 0; bj < 2; ++bj) { if (bj == 1 && !isq) continue; const f32x4 a = acc[ai][bj][m][0], b = acc[ai][bj][m][1];
                    s_ += (a[0] * a[0] + a[1] * a[1]) + (a[2] * a[2] + a[3] * a[3]) + (b[0] * b[0] + b[1] * b[1]) + (b[2] * b[2] + b[3] * b[3]); }
                s_ += swz<0x401F>(s_);
                { auto rr = __builtin_amdgcn_permlane32_swap(__float_as_uint(s_), __float_as_uint(s_), false, false); s_ = __uint_as_float(rr[0]) + __uint_as_float(rr[1]); }
                ps[ai][m] = s_;
                if (fq == 0) xch[((wid * 2 + ai) * 4 + m) * 16 + fr] = s_; }
        asm volatile("s_waitcnt lgkmcnt(0)\n\ts_barrier" ::: "memory");
        const bool lat = (u.pm % 33) != 32; const int t0 = (int)row0 - (u.pm / 33) * SEQT;
        const float invn = isq ? (1.f / 256.f) : (1.f / 128.f);
        const float* gp = (isq ? gq : gkv) + wc * 32 + 8 * fq;
#pragma unroll
        for (int ai = 0; ai < 2; ++ai)
#pragma unroll
            for (int m = 0; m < 4; ++m) { const unsigned rr_ = (unsigned)(ai * HALF + m * 16);
                float tot = 0.f;
#pragma unroll
                for (int w4 = 0; w4 < 4; ++w4) tot += xch[(((wr * 4 + w4) * 2 + ai) * 4 + m) * 16 + fr];
                const float rstd = 1.f / sqrtf(tot * invn + EPS);
#pragma unroll
                for (int bj = 0; bj < 2; ++bj) { const f32x4 a = acc[ai][bj][m][0], b = acc[ai][bj][m][1];
                    if (isq || bj == 0) {
                        const f32x4 g0 = *(const f32x4*)(gp + bj * HALF), g1 = *(const f32x4*)(gp + bj * HALF + 4);
                        float o[8] = {a[0] * rstd * g0[0], a[1] * rstd * g0[1], a[2] * rstd * g0[2], a[3] * rstd * g0[3], b[0] * rstd * g1[0], b[1] * rstd * g1[1], b[2] * rstd * g1[2], b[3] * rstd * g1[3]};
                        if (isq) *(u32x4*)(QAN + (size_t)(row0 + rr_) * 256 + bj * HALF + wc * 32 + 8 * fq) = pack8(o);
                        else *(u32x4*)(KVAN + (size_t)(row0 + rr_) * 128 + wc * 32 + 8 * fq) = pack8(o);
                    } else if (wc == 0) {
                        const int t = t0 + (int)rr_;
                        f32x4 c01 = {1.f, 0.f, 1.f, 0.f}, c23 = {1.f, 0.f, 1.f, 0.f};
                        if (lat) { const int pos = (fq < 2) ? (t >> 6) : (t & 63); const f32x4* rp = (const f32x4*)(rope + pos * 16 + 4 * (fq & 1)); c01 = rp[0]; c23 = rp[1]; }
                        float o[8] = {a[0] * c01[0] - a[1] * c01[1], a[0] * c01[1] + a[1] * c01[0], a[2] * c01[2] - a[3] * c01[3], a[2] * c01[3] + a[3] * c01[2],
                                      b[0] * c23[0] - b[1] * c23[1], b[0] * c23[1] + b[1] * c23[0], b[2] * c23[2] - b[3] * c23[3], b[2] * c23[3] + b[3] * c23[2]};
                        const u32x4 kw = pack8(o); bf16_t* kp = KR + (size_t)(row0 + rr_) * 768 + 64 + 8 * fq;
#pragma unroll
                        for (int h = 0; h < 8; ++h) *(u32x4*)(kp + h * 96) = kw; } }
                EPI_FENCE(); }
    }
};
template <int MODE> struct EpiResidNorm {
    static constexpr bool PERM = true, AFTER_DRAIN = false;
    bf16_t* H; const float* gate; float* xbuf; unsigned* cnt; LAS float* xch; bf16_t* A; const float* ng; const float* modsh; float* out; float coef;
    __device__ __forceinline__ void operator()(f32x4 (&acc)[2][2][4][2], const Unit& u, int wr, int wc, int fr_, int fq_) const {
        int fr = fr_, fq = fq_; asm volatile("" : "+v"(fr), "+v"(fq));
        const unsigned colp = (unsigned)(u.pn * BM + wc * 32 + 8 * fq), rloc = (unsigned)(wr * 64 + fr);
        const int mi = row_mi(u.pm), wid = wr * 4 + wc;
        const float* gp = gate + (unsigned)mi * 9 * DM + colp;
        float ps[2][4];
#pragma unroll
        for (int ai = 0; ai < 2; ++ai)
#pragma unroll
            for (int m = 0; m < 4; ++m) ps[ai][m] = 0.f;
#pragma unroll
        for (int bj = 0; bj < 2; ++bj) { const f32x4 gv0 = *(const f32x4*)(gp + bj * HALF) * coef, gv1 = *(const f32x4*)(gp + bj * HALF + 4) * coef;
#pragma unroll
            for (int ai = 0; ai < 2; ++ai) { u32x4 hb[4];
#pragma unroll
                for (int m = 0; m < 4; ++m) hb[m] = *(const u32x4*)(H + (((unsigned)u.pm * BM + rloc + (unsigned)(ai * HALF + m * 16)) * DM + colp + bj * HALF));
#pragma unroll
                for (int m = 0; m < 4; ++m) { float h[8]; unpack8(hb[m], h);
                    const f32x4 d0 = gv0 * acc[ai][bj][m][0], d1 = gv1 * acc[ai][bj][m][1];
                    const f32x4 h0 = {h[0] + d0[0], h[1] + d0[1], h[2] + d0[2], h[3] + d0[3]}, h1 = {h[4] + d1[0], h[5] + d1[1], h[6] + d1[2], h[7] + d1[3]};
                    acc[ai][bj][m][0] = h0; acc[ai][bj][m][1] = h1;
                    ps[ai][m] += (h0[0] * h0[0] + h0[1] * h0[1]) + (h0[2] * h0[2] + h0[3] * h0[3]) + (h1[0] * h1[0] + h1[1] * h1[1]) + (h1[2] * h1[2] + h1[3] * h1[3]); }
                EPI_FENCE(); }
            EPI_FENCE(); }
#pragma unroll
        for (int ai = 0; ai < 2; ++ai)
#pragma unroll
            for (int m = 0; m < 4; ++m) { float s_ = ps[ai][m]; s_ += swz<0x401F>(s_);
                { auto rr = __builtin_amdgcn_permlane32_swap(__float_as_uint(s_), __float_as_uint(s_), false, false); s_ = __uint_as_float(rr[0]) + __uint_as_float(rr[1]); }
                if (fq == 0) xch[((wid * 2 + ai) * 4 + m) * 16 + fr] = s_; }
        asm volatile("s_waitcnt lgkmcnt(0)\n\ts_barrier" ::: "memory");
        if (wc == 0 && fq == 0) {
#pragma unroll
            for (int ai = 0; ai < 2; ++ai)
#pragma unroll
                for (int m = 0; m < 4; ++m) { float tot = 0.f;
#pragma unroll
                    for (int w4 = 0; w4 < 4; ++w4) tot += xch[(((wr * 4 + w4) * 2 + ai) * 4 + m) * 16 + fr];
                    __hip_atomic_store(xbuf + (((unsigned)u.pm * BM + rloc + (unsigned)(ai * HALF + m * 16)) * 4u + (unsigned)u.pn), tot, __ATOMIC_RELAXED, __HIP_MEMORY_SCOPE_AGENT); } }
        asm volatile("s_waitcnt vmcnt(0) lgkmcnt(0)\n\ts_barrier" ::: "memory");
        if (wid == 0) {
            if (fr == 0 && fq == 0) __hip_atomic_fetch_add(cnt + 64 * u.pm, 1u, __ATOMIC_RELAXED, __HIP_MEMORY_SCOPE_AGENT);
            unsigned it_ = 0;
            while ((unsigned)__builtin_amdgcn_readfirstlane(__hip_atomic_load(cnt + 64 * u.pm, __ATOMIC_RELAXED, __HIP_MEMORY_SCOPE_AGENT)) < 4u) { if (++it_ > (1u << 20)) break; __builtin_amdgcn_s_sleep(2); }
            __builtin_amdgcn_fence(__ATOMIC_ACQUIRE, "agent");
        }
        asm volatile("s_waitcnt vmcnt(0) lgkmcnt(0)\n\ts_barrier" ::: "memory");
        float rstd[2][4];
#pragma unroll
        for (int ai = 0; ai < 2; ++ai)
#pragma unroll
            for (int m = 0; m < 4; ++m) { const float* sl = xbuf + (((unsigned)u.pm * BM + rloc + (unsigned)(ai * HALF + m * 16)) * 4u); float tot = 0.f;
#pragma unroll
                for (int k4 = 0; k4 < 4; ++k4) tot += __hip_atomic_load(sl + k4, __ATOMIC_RELAXED, __HIP_MEMORY_SCOPE_AGENT);
                rstd[ai][m] = 1.f / sqrtf(tot * (1.f / DM) + EPS); EPI_FENCE(); }
        const unsigned orow0 = (unsigned)((u.pm / 33) * SEQ + (u.pm % 33) * BM);
#pragma unroll
        for (int bj = 0; bj < 2; ++bj) {
            float g8[8], sh8[8], sc8[8];
            ldf8(ng + colp + bj * HALF, g8);
            if (MODE == 1) { const float* mp = modsh + (unsigned)mi * 9 * DM + colp + bj * HALF; ldf8(mp, sh8); ldf8(mp + DM, sc8); }
#pragma unroll
            for (int ai = 0; ai < 2; ++ai)
#pragma unroll
                for (int m = 0; m < 4; ++m) { const unsigned rr = rloc + (unsigned)(ai * HALF + m * 16); const f32x4 h0 = acc[ai][bj][m][0], h1 = acc[ai][bj][m][1]; const float r_ = rstd[ai][m];
                    float h[8] = {h0[0], h0[1], h0[2], h0[3], h1[0], h1[1], h1[2], h1[3]};
                    if (MODE == 1) { float o[8];
#pragma unroll
                        for (int i = 0; i < 8; ++i) o[i] = h[i] * r_ * g8[i] * (sc8[i] + 1.f) + sh8[i];
                        *(u32x4*)(H + (((unsigned)u.pm * BM + rr) * DM + colp + bj * HALF)) = pack8(h);
                        *(u32x4*)(A + (((unsigned)u.pm * BM + rr) * DM + colp + bj * HALF)) = pack8(o); }
                    else { float* op = out + ((orow0 + rr) * DM + colp + bj * HALF);
                        *(f32x4*)op = (f32x4){h[0] * r_ * g8[0], h[1] * r_ * g8[1], h[2] * r_ * g8[2], h[3] * r_ * g8[3]};
                        *(f32x4*)(op + 4) = (f32x4){h[4] * r_ * g8[4], h[5] * r_ * g8[5], h[6] * r_ * g8[6], h[7] * r_ * g8[7]}; }
                    EPI_FENCE(); }
            EPI_FENCE(); }
    }
};
struct EpiQb {
    static constexpr bool PERM = false, AFTER_DRAIN = false;
    bf16_t* Q; const f32x2* rope  ;
    __device__ __forceinline__ void operator()(const f32x4 (&acc)[2][2][4][2], const Unit& u, int wr, int wc, int fr_, int fq_) const {
        int fr = fr_, fq = fq_; asm volatile("" : "+v"(fr), "+v"(fq));
        const int row0 = u.pm * BM + wr * 64 + fr, col0 = u.pn * BM + wc * 32 + 4 * fq;
        const bool lat = (u.pm % 33) != 32;
        const int t0 = row0 - (u.pm / 33) * SEQT;
#pragma unroll
        for (int bj = 0; bj < 2; ++bj)
#pragma unroll
            for (int n = 0; n < 2; ++n) { const int col = col0 + bj * HALF + n * 16; const int d = col % 96; const bool rot = (d >= 64) && lat;
                const int i0 = (d - 64) >> 1, f0 = i0 & 7;
#pragma unroll
                for (int ai = 0; ai < 2; ++ai) {
#pragma unroll
                    for (int m = 0; m < 4; ++m) { const int rr = ai * HALF + m * 16; const int t = t0 + rr; f32x4 v = acc[ai][bj][m][n];
                        if (rot) { const int pos = (i0 < 8) ? (t >> 6) : (t & 63);
                            const f32x2 cs0 = rope[pos * 16 + f0], cs1 = rope[pos * 16 + f0 + 1];
                            v = (f32x4){v[0] * cs0.x - v[1] * cs0.y, v[0] * cs0.y + v[1] * cs0.x, v[2] * cs1.x - v[3] * cs1.y, v[2] * cs1.y + v[3] * cs1.x}; }
                        v = v * C2_MLA; u32x2 w; w.x = pk2(v[0], v[1]); w.y = pk2(v[2], v[3]);
                        *(u32x2*)(Q + (unsigned)(row0 + rr) * 768 + col) = w; }
                    EPI_FENCE(); } }
    }
};
struct EpiKVb {
    static constexpr bool PERM = false, AFTER_DRAIN = false;
    bf16_t* K; bf16_t* V;
    __device__ __forceinline__ void operator()(const f32x4 (&acc)[2][2][4][2], const Unit& u, int wr, int wc, int fr_, int fq_) const {
        int fr = fr_, fq = fq_; asm volatile("" : "+v"(fr), "+v"(fq));
        const int row0 = u.pm * BM + wr * 64 + fr, col0 = u.pn * BM + wc * 32 + 4 * fq;
#pragma unroll
        for (int bj = 0; bj < 2; ++bj)
#pragma unroll
            for (int n = 0; n < 2; ++n) { const int col = col0 + bj * HALF + n * 16; const int h = col >> 7, d = col & 127;
                bf16_t* base = (d < 64) ? (K + h * 96 + d) : (V + h * 64 + (d - 64)); const unsigned pitch = (d < 64) ? 768u : 512u;
#pragma unroll
                for (int ai = 0; ai < 2; ++ai) {
#pragma unroll
                    for (int m = 0; m < 4; ++m) { const f32x4 v = acc[ai][bj][m][n]; u32x2 w; w.x = pk2(v[0], v[1]); w.y = pk2(v[2], v[3]);
                        *(u32x2*)(base + (unsigned)(row0 + ai * HALF + m * 16) * pitch) = w; }
                    EPI_FENCE(); } }
    }
};

constexpr int A_NSLOT = 3, A_KSLOT = 12288, A_VSLOT = 8192;
constexpr int A_K = 0, A_V = A_NSLOT * A_KSLOT, A_WS = A_V + A_NSLOT * A_VSLOT, A_OST = A_WS + 2048, A_BYTES = A_OST + 8 * 4096;
static_assert(A_BYTES <= RING_BYTES, "attention LDS");
__device__ __forceinline__ int crow(int r, int hi) { return (r & 3) + 8 * (r >> 2) + 4 * hi; }
__device__ __forceinline__ void glds16(const void* gsrc, unsigned lds_dst) { unsigned keep;
    asm volatile("s_mov_b32 %0, m0\n\ts_mov_b32 m0, %2\n\ts_nop 0\n\tglobal_load_lds_dwordx4 %1, off\n\ts_mov_b32 m0, %0" : "=&s"(keep) : "v"(gsrc), "s"(lds_dst) : "memory"); }
__device__ __forceinline__ void pv(f32x16* o, int vb, bf16x8 pa0, bf16x8 pa1, bf16x8 pa2, bf16x8 pa3) {
#pragma unroll
    for (int d0 = 0; d0 < 2; ++d0) { s16x4 lo[4], hi[4];
#pragma unroll
        for (int ks = 0; ks < 4; ++ks) {
            asm volatile("ds_read_b64_tr_b16 %0,%1 offset:%c2" : "=&v"(lo[ks]) : "v"(vb), "i"(d0 * 4096 + ks * 1024) : "memory");
            asm volatile("ds_read_b64_tr_b16 %0,%1 offset:%c2" : "=&v"(hi[ks]) : "v"(vb), "i"(d0 * 4096 + ks * 1024 + 512) : "memory"); }
        asm volatile("s_waitcnt lgkmcnt(0)" ::: "memory"); __builtin_amdgcn_sched_barrier(0);
#define PK(k) (bf16x8){lo[k][0], lo[k][1], lo[k][2], lo[k][3], hi[k][0], hi[k][1], hi[k][2], hi[k][3]}
        o[d0] = __builtin_amdgcn_mfma_f32_32x32x16_bf16(pa0, PK(0), o[d0], 0, 0, 0);
        o[d0] = __builtin_amdgcn_mfma_f32_32x32x16_bf16(pa1, PK(1), o[d0], 0, 0, 0);
        o[d0] = __builtin_amdgcn_mfma_f32_32x32x16_bf16(pa2, PK(2), o[d0], 0, 0, 0);
        o[d0] = __builtin_amdgcn_mfma_f32_32x32x16_bf16(pa3, PK(3), o[d0], 0, 0, 0);
#undef PK
    }
}
template <int NKD>
__device__ __forceinline__ void attn_unit(const bf16_t* Qu, int qp, const bf16_t* Ku, int kp, const bf16_t* Vu, int vp, bf16_t* Ou, int op, int NT, LAS unsigned char* shm, const int wave_id) {
    const int wid = wave_id, lane = fresh_lane(), r32 = lane & 31, hi = lane >> 5;
    const unsigned lds0 = (unsigned)(uintptr_t)shm;
    LAS float* wsf = (LAS float*)(shm + A_WS) + wid * 64;
    const bf16_t* Qw = Qu + (size_t)(wid * 32) * qp;
    const bf16_t* ksrc = Ku + (size_t)lane * kp + wid * 8;
    const bf16_t* ksrc2 = Ku + (size_t)lane * kp + (8 + (wid & 3)) * 8;
    const bf16_t* vsrc = Vu + (size_t)(16 * (wid & 3) + (lane >> 2)) * vp + (wid >> 2) * 32 + (lane & 3) * 8;
    const unsigned kdst = lds0 + A_K + wid * 1024, kdst2 = lds0 + A_K + (8 + (wid & 3)) * 1024, vdst = lds0 + A_V + wid * 1024;
#define DMA_TILE(t, s) do { glds16(ksrc + (size_t)(t) * 64 * kp, (unsigned)__builtin_amdgcn_readfirstlane(kdst + (s) * A_KSLOT)); \
        if (NKD == 6) glds16(ksrc2 + (size_t)(t) * 64 * kp, (unsigned)__builtin_amdgcn_readfirstlane(kdst2 + (s) * A_KSLOT)); \
        glds16(vsrc + (size_t)(t) * 64 * vp, (unsigned)__builtin_amdgcn_readfirstlane(vdst + (s) * A_VSLOT)); } while (0)
    bf16x8 qr[NKD];
#pragma unroll
    for (int d0 = 0; d0 < NKD; ++d0) qr[d0] = *(const bf16x8*)(Qw + (size_t)r32 * qp + d0 * 16 + hi * 8);
    DMA_TILE(0, 0); if (NT > 1) DMA_TILE(1, 1);
    const int vb0 = (int)(lds0 + A_V) + ((lane >> 4) & 1) * 32 + (lane & 3) * 8 + (4 * hi + ((lane & 15) >> 2)) * 64;
    const LAS unsigned char* kp0 = shm + A_K + hi * 1024 + r32 * 16;
    float mhat = -INFINITY, l_reg = 0.f; f32x16 o[2]; o[0] = f32x16{}; o[1] = f32x16{};
    int sl = 0, sl2 = 2;
    for (int t = 0; t < NT; ++t) {
        if (t + 1 < NT) { if (NKD == 6) asm volatile("s_waitcnt vmcnt(3) lgkmcnt(0)\n\ts_barrier" ::: "memory"); else asm volatile("s_waitcnt vmcnt(2) lgkmcnt(0)\n\ts_barrier" ::: "memory"); }
        else asm volatile("s_waitcnt vmcnt(0) lgkmcnt(0)\n\ts_barrier" ::: "memory");
        if (t + 2 < NT) DMA_TILE(t + 2, sl2);
        f32x16 p0, p1;
        { const LAS unsigned char* kb = kp0 + sl * A_KSLOT;
#pragma unroll
          for (int d0 = 0; d0 < NKD; ++d0) {
              const bf16x8 b0 = *(const LAS bf16x8*)(kb + d0 * 2048), b1 = *(const LAS bf16x8*)(kb + d0 * 2048 + 512);
              if (d0 == 0) { p0 = __builtin_amdgcn_mfma_f32_32x32x16_bf16(b0, qr[0], f32x16{}, 0, 0, 0); p1 = __builtin_amdgcn_mfma_f32_32x32x16_bf16(b1, qr[0], f32x16{}, 0, 0, 0); }
              else { p0 = __builtin_amdgcn_mfma_f32_32x32x16_bf16(b0, qr[d0], p0, 0, 0, 0); p1 = __builtin_amdgcn_mfma_f32_32x32x16_bf16(b1, qr[d0], p1, 0, 0, 0); } } }
        float rm = __builtin_fmaxf(p0[0], p1[0]);
#pragma unroll
        for (int r = 1; r < 16; ++r) rm = __builtin_fmaxf(rm, __builtin_fmaxf(p0[r], p1[r]));
        { auto rr = __builtin_amdgcn_permlane32_swap(__float_as_uint(rm), __float_as_uint(rm), false, false); rm = __builtin_fmaxf(__uint_as_float(rr[0]), __uint_as_float(rr[1])); }
        if (__any(rm > mhat + 8.f)) {
            const float mn = __builtin_fmaxf(mhat, rm); const float f = __builtin_amdgcn_exp2f(mhat - mn); mhat = mn; l_reg *= f;
            if (hi == 0) wsf[r32] = f;
            asm volatile("s_waitcnt lgkmcnt(0)" ::: "memory");
#pragma unroll
            for (int r = 0; r < 16; ++r) { const float fr_ = wsf[crow(r, hi)]; o[0][r] *= fr_; o[1][r] *= fr_; }
        }
        float sacc = 0.f;
#pragma unroll
        for (int r = 0; r < 16; ++r) { p0[r] = __builtin_amdgcn_exp2f(p0[r] - mhat); p1[r] = __builtin_amdgcn_exp2f(p1[r] - mhat); sacc += p0[r] + p1[r]; }
        l_reg += sacc;
        u32x4 pw0, pw1, pw2, pw3;
        pw0 = (u32x4){pk2(p0[0], p0[1]), pk2(p0[2], p0[3]), pk2(p0[4], p0[5]), pk2(p0[6], p0[7])};
        pw1 = (u32x4){pk2(p0[8], p0[9]), pk2(p0[10], p0[11]), pk2(p0[12], p0[13]), pk2(p0[14], p0[15])};
        pw2 = (u32x4){pk2(p1[0], p1[1]), pk2(p1[2], p1[3]), pk2(p1[4], p1[5]), pk2(p1[6], p1[7])};
        pw3 = (u32x4){pk2(p1[8], p1[9]), pk2(p1[10], p1[11]), pk2(p1[12], p1[13]), pk2(p1[14], p1[15])};
        pv(o, vb0 + sl * A_VSLOT, __builtin_bit_cast(bf16x8, pw0), __builtin_bit_cast(bf16x8, pw1), __builtin_bit_cast(bf16x8, pw2), __builtin_bit_cast(bf16x8, pw3));
        sl = (sl == 2) ? 0 : sl + 1; sl2 = (sl2 == 2) ? 0 : sl2 + 1;
    }
    { auto rr = __builtin_amdgcn_permlane32_swap(__float_as_uint(l_reg), __float_as_uint(l_reg), false, false); l_reg = __uint_as_float(rr[0]) + __uint_as_float(rr[1]); }
    if (hi == 0) wsf[32 + r32] = l_reg;
    asm volatile("s_waitcnt lgkmcnt(0)" ::: "memory");
    LAS bf16_t* stg = (LAS bf16_t*)(shm + A_OST) + wid * 2048;
#pragma unroll
    for (int r = 0; r < 16; ++r) { const int orow = crow(r, hi); const float rl = __builtin_amdgcn_rcpf(wsf[32 + orow]);
        stg[orow * 64 + r32] = (bf16_t)f2bf(o[0][r] * rl); stg[orow * 64 + 32 + r32] = (bf16_t)f2bf(o[1][r] * rl); }
    asm volatile("s_waitcnt lgkmcnt(0)" ::: "memory");
    bf16_t* Ow = Ou + (size_t)(wid * 32) * op;
#pragma unroll
    for (int i = 0; i < 4; ++i) { const int row = i * 8 + (lane >> 3), ch = lane & 7; const u32x4 v = *(const LAS u32x4*)(stg + row * 64 + ch * 8); *(u32x4*)(Ow + (size_t)row * op + ch * 8) = v; }
    asm volatile("s_waitcnt vmcnt(0) lgkmcnt(0)\n\ts_barrier" ::: "memory");
#undef DMA_TILE
}


namespace tat {
using bf16 = unsigned short;
using bf16x8 = __attribute__((ext_vector_type(8))) short;
using s16x4 = __attribute__((ext_vector_type(4))) short;
using f32x16 = __attribute__((ext_vector_type(16))) float;
using u32x4 = __attribute__((ext_vector_type(4))) unsigned;
constexpr int D = 64, NW = 8, QBLK = 32, QB = QBLK * NW, KVBLK = 64;
__device__ __forceinline__ int crow(int r, int hi) { return (r & 3) + 8 * (r >> 2) + 4 * hi; }
#define SBAR() __builtin_amdgcn_sched_barrier(0)
constexpr int NSLOT=3, SLOTB=8192;
__device__ __forceinline__ unsigned f2bf_t(float f){unsigned u=__builtin_bit_cast(unsigned,f);return (u+0x7fffu+((u>>16)&1u))>>16;}
constexpr int KSLOTMAX=12288; constexpr int LDS_K=0, LDS_V=NSLOT*KSLOTMAX, LDS_WS=NSLOT*KSLOTMAX+NSLOT*SLOTB, LDS_OST=LDS_WS+NW*64*4, LDS_BYTES=LDS_OST+NW*4096;
constexpr float C2=0.125f*1.4426950408889634f;
__device__ __forceinline__ void glds16(const void*gsrc,unsigned lds_dst){unsigned keep;
  asm volatile("s_mov_b32 %0, m0\n\ts_mov_b32 m0, %2\n\ts_nop 0\n\tglobal_load_lds_dwordx4 %1, off\n\ts_mov_b32 m0, %0":"=&s"(keep):"v"(gsrc),"s"(lds_dst):"memory");}
__device__ __forceinline__ float max3f(float a,float b,float c){float r;asm("v_max3_f32 %0, %1, %2, %3":"=v"(r):"v"(a),"v"(b),"v"(c));return r;}
__device__ __forceinline__ float max2f(float a,float b){float r;asm("v_max_f32_e32 %0, %1, %2":"=v"(r):"v"(a),"v"(b));return r;}
__device__ __forceinline__ float fadd_s(float a,float b){float r;asm("v_add_f32_e32 %0, %1, %2":"=v"(r):"v"(a),"v"(b));return r;}
__device__ __forceinline__ float fsub_s(float a,float b){float r;asm("v_sub_f32_e32 %0, %1, %2":"=v"(r):"v"(a),"v"(b));return r;}
typedef float f32x2_t __attribute__((ext_vector_type(2))); typedef __bf16 bf16x2_t __attribute__((ext_vector_type(2)));
__device__ __forceinline__ unsigned cvtpk_s(float lo,float hi){f32x2_t v={lo,hi};bf16x2_t b=__builtin_convertvector(v,bf16x2_t);return __builtin_bit_cast(unsigned,b);}
#define WAIT_BAR(N) asm volatile("s_waitcnt vmcnt(" #N ") lgkmcnt(0)\n\ts_barrier":::"memory")

template<int NKD> __device__ __forceinline__ void qkt(f32x16&p0,f32x16&p1,const char*Kslot,const bf16x8*qr,const f32x16&negm,int r32,int hi){
  const char*kb=Kslot+hi*1024+r32*16;
  #pragma unroll
  for(int d0=0;d0<NKD;++d0){
    const bf16x8 b0=*reinterpret_cast<const bf16x8*>(kb+d0*2048);
    const bf16x8 b1=*reinterpret_cast<const bf16x8*>(kb+d0*2048+512);
    if(d0==0){p0=__builtin_amdgcn_mfma_f32_32x32x16_bf16(b0,qr[0],negm,0,0,0);p1=__builtin_amdgcn_mfma_f32_32x32x16_bf16(b1,qr[0],negm,0,0,0);}
    else{p0=__builtin_amdgcn_mfma_f32_32x32x16_bf16(b0,qr[d0],p0,0,0,0);p1=__builtin_amdgcn_mfma_f32_32x32x16_bf16(b1,qr[d0],p1,0,0,0);}}
}
typedef __attribute__((address_space(3))) const char* lds_cptr;
typedef short v4i16_t __attribute__((ext_vector_type(4)));
template<int NKD> __device__ __forceinline__ void kload8(bf16x8*kf,lds_cptr kp){
  if(NKD==6){ kf[8]=*(const __attribute__((address_space(3))) bf16x8*)(kp+8192); kf[9]=*(const __attribute__((address_space(3))) bf16x8*)(kp+8704); kf[10]=*(const __attribute__((address_space(3))) bf16x8*)(kp+10240); kf[11]=*(const __attribute__((address_space(3))) bf16x8*)(kp+10752); }
  kf[0]=*(const __attribute__((address_space(3))) bf16x8*)(kp);      kf[1]=*(const __attribute__((address_space(3))) bf16x8*)(kp+512);
  kf[2]=*(const __attribute__((address_space(3))) bf16x8*)(kp+2048); kf[3]=*(const __attribute__((address_space(3))) bf16x8*)(kp+2560);
  kf[4]=*(const __attribute__((address_space(3))) bf16x8*)(kp+4096); kf[5]=*(const __attribute__((address_space(3))) bf16x8*)(kp+4608);
  kf[6]=*(const __attribute__((address_space(3))) bf16x8*)(kp+6144); kf[7]=*(const __attribute__((address_space(3))) bf16x8*)(kp+6656);
}
__device__ __forceinline__ void kload2(bf16x8*kf,lds_cptr kp,int j){ kf[2*j]=*(const __attribute__((address_space(3))) bf16x8*)(kp+j*2048); kf[2*j+1]=*(const __attribute__((address_space(3))) bf16x8*)(kp+j*2048+512); }
__device__ __forceinline__ s16x4 vtr(lds_cptr p){ return __builtin_bit_cast(s16x4,__builtin_amdgcn_ds_read_tr16_b64_v4i16((__attribute__((address_space(3))) v4i16_t*)p)); }
__device__ __forceinline__ float rowmax(const f32x16&p0,const f32x16&p1){
  float a=max3f(p0[0],p0[1],p1[0]),b=max3f(p0[2],p0[3],p1[1]);a=max3f(a,p1[2],p1[3]);
  #pragma unroll
  for(int r=4;r<16;r+=4){a=max3f(a,p0[r],p0[r+1]);b=max3f(b,p0[r+2],p0[r+3]);a=max3f(a,p1[r],p1[r+1]);b=max3f(b,p1[r+2],p1[r+3]);}
  const float m=max2f(a,b);
  auto rr=__builtin_amdgcn_permlane32_swap(__float_as_uint(m),__float_as_uint(m),false,false);
  return max2f(__uint_as_float(rr[0]),__uint_as_float(rr[1]));
}
__device__ __forceinline__ void pv(f32x16*o,int vb,bf16x8 pa0,bf16x8 pa1,bf16x8 pa2,bf16x8 pa3){
  #pragma unroll
  for(int d0=0;d0<2;++d0){s16x4 lo[4],hi[4];
    #pragma unroll
    for(int ks=0;ks<4;++ks){
      asm volatile("ds_read_b64_tr_b16 %0,%1 offset:%c2":"=&v"(lo[ks]):"v"(vb),"i"(d0*4096+ks*1024):"memory");
      asm volatile("ds_read_b64_tr_b16 %0,%1 offset:%c2":"=&v"(hi[ks]):"v"(vb),"i"(d0*4096+ks*1024+512):"memory");}
    asm volatile("s_waitcnt lgkmcnt(0)":::"memory");SBAR();
    #define PK(k) (bf16x8){lo[k][0],lo[k][1],lo[k][2],lo[k][3],hi[k][0],hi[k][1],hi[k][2],hi[k][3]}
    o[d0]=__builtin_amdgcn_mfma_f32_32x32x16_bf16(pa0,PK(0),o[d0],0,0,0);
    o[d0]=__builtin_amdgcn_mfma_f32_32x32x16_bf16(pa1,PK(1),o[d0],0,0,0);
    o[d0]=__builtin_amdgcn_mfma_f32_32x32x16_bf16(pa2,PK(2),o[d0],0,0,0);
    o[d0]=__builtin_amdgcn_mfma_f32_32x32x16_bf16(pa3,PK(3),o[d0],0,0,0);
    #undef PK
  }
}
#ifndef ATTN_STORE16
#define ATTN_STORE16(p,v) (*(u32x4*)(p)=(v))
#endif
template<int THRL,int NKD,int QP,int KP,int VP,int OP> __device__ __forceinline__ void attn_unit(const bf16*Qu,const bf16*__restrict__ Ku,const bf16*__restrict__ Vu,bf16*Ou,const int NT,char*shm,const int wave_id){
  const int lane=fresh_lane(),r32=lane&31,hi=lane>>5; const int wid=wave_id;
  const bf16*Qw=Qu+(long)(wid*QBLK)*QP;
  const bf16*Kh=Ku,*Vh=Vu;
  const unsigned lds0=(unsigned)(uintptr_t)shm;
  float*wsf=(float*)(shm+LDS_WS)+wid*64;
  const bf16*ksrc=Kh+(long)lane*KP+wid*8; const bf16*ksrc2=Kh+(long)lane*KP+(8+(wid&3))*8;
  const bf16*vsrc=Vh+(long)(16*(wid&3)+(lane>>2))*VP+(wid>>2)*32+(lane&3)*8;
  const unsigned kdst=lds0+LDS_K+wid*1024, kdst2=lds0+LDS_K+(8+(wid&3))*1024, vdst=lds0+LDS_V+wid*1024;
  #define KOFF(s_) ((NKD==6)?((s_)+((s_)>>1)):(s_))
  #define DMA_K(t,slot) do{ glds16(ksrc+(long)(t)*KVBLK*KP,(unsigned)__builtin_amdgcn_readfirstlane(kdst+KOFF(slot))); if(NKD==6) glds16(ksrc2+(long)(t)*KVBLK*KP,(unsigned)__builtin_amdgcn_readfirstlane(kdst2+KOFF(slot))); }while(0)
  #define WAIT_KV() do{ if(NKD==6){WAIT_BAR(3);} else {WAIT_BAR(2);} }while(0)
  #define DMA_V(t,slot) glds16(vsrc+(long)(t)*KVBLK*VP,(unsigned)__builtin_amdgcn_readfirstlane(vdst+(slot)))
  const int vb0=(int)(lds0+LDS_V)+((lane>>4)&1)*32+(lane&3)*8+(4*hi+((lane&15)>>2))*64;
  const char*Kbase=shm+LDS_K; bf16x8 kf[2*NKD];
  const lds_cptr shm3=(lds_cptr)shm; const lds_cptr kp0=shm3+LDS_K+hi*1024+r32*16; const lds_cptr vp0=shm3+LDS_V+((lane>>4)&1)*32+(lane&3)*8+(4*hi+((lane&15)>>2))*64;
  DMA_K(0,0);DMA_V(0,0);DMA_K(1,SLOTB);
  bf16x8 qr[NKD];
  #pragma unroll
  for(int d0=0;d0<NKD;++d0)qr[d0]=*reinterpret_cast<const bf16x8*>(&Qw[(long)r32*QP+d0*16+hi*8]);
  float mhat=0.f,l_reg=0.f;f32x16 o[2];o[0]=f32x16{};o[1]=f32x16{};f32x16 negm=f32x16{};asm volatile("":"+v"(negm));
  #define CMASK(P0,P1,t) do{}while(0)
  bool resc=false;
  #define START(P0,P1) do{ const float rm=rowmax(P0,P1); resc=false; \
    { const float dl=rm; mhat=fadd_s(mhat,dl); \
      _Pragma("unroll") for(int r=0;r<16;++r){P0[r]=fsub_s(P0[r],dl);P1[r]=fsub_s(P1[r],dl);} \
      _Pragma("unroll") for(int r=0;r<16;++r)negm[r]=-mhat; asm volatile("":"+v"(negm)); } \
    _Pragma("unroll") for(int r=0;r<16;++r)P0[r]=__builtin_amdgcn_exp2f(P0[r]); }while(0)
  #define RESC() do{ if(resc){ asm volatile("s_waitcnt lgkmcnt(0)":::"memory"); \
      _Pragma("unroll") for(int d_=0;d_<2;++d_) _Pragma("unroll") for(int r=0;r<16;++r)o[d_][r]*=wsf[crow(r,hi)]; } }while(0)
  f32x16 pA0,pA1,pB0,pB1;
  int sl_prev=0,sl_cur=0,sl_next=SLOTB;
  #define ROT() do{sl_prev=sl_cur;sl_cur=sl_next;sl_next=(sl_next==(NSLOT-1)*SLOTB)?0:sl_next+SLOTB;}while(0)
  DMA_K(2,2*SLOTB);
  WAIT_BAR(3);
  qkt<NKD>(pA0,pA1,Kbase,qr,negm,r32,hi);asm volatile("s_nop 15\n\ts_nop 7":"+v"(pA0),"+v"(pA1));CMASK(pA0,pA1,0);
  START(pA0,pA1);
  _Pragma("unroll") for(int r=0;r<16;++r)pA1[r]=__builtin_amdgcn_exp2f(pA1[r]);
  WAIT_BAR(0);
  DMA_K(3,0);DMA_V(1,SLOTB);
  ROT();
  kload8<NKD>(kf,kp0+KOFF(sl_cur));
  WAIT_KV();
  s16x4 vlo[8],vhi[8]; u32x4 pw0,pw1,pw2,pw3;
  #define PKW(P,B) cvtpk_s(P[B],P[B+1])
  #define PAF(k) __builtin_bit_cast(bf16x8,pw##k)
  #define VFR(i) (bf16x8){vlo[i][0],vlo[i][1],vlo[i][2],vlo[i][3],vhi[i][0],vhi[i][1],vhi[i][2],vhi[i][3]}
  #define PIN(x) asm volatile("":"+v"(x))
  #define MX3(a,b,c) __builtin_fmaxf(__builtin_fmaxf((a),(b)),(c))
  #define GAPA(MF,A0,A1,A2,A3,W0,W1,PW) do{ MF; sacc+=A0; sacc+=A1; sacc+=A2; sacc+=A3; PIN(sacc); W0; W1; PIN(PW); SBAR(); }while(0)
  #define EX(v) __builtin_amdgcn_exp2f(v)
  #define GAPB(MF,X,B) do{ MF; X[B]=EX(X[B]); X[B+1]=EX(X[B+1]); X[B+2]=EX(X[B+2]); X[B+3]=EX(X[B+3]); PIN(X); SBAR(); }while(0)
  #define VRD(i) do{ vlo[i]=vtr(vp_+(((i)>>2)*4096+((i)&3)*1024)); vhi[i]=vtr(vp_+(((i)>>2)*4096+((i)&3)*1024+512)); }while(0)
  #define KRD(G,j) do{ if(G){ kload2(kf,kp0+KOFF(sl_next),j); SBAR(); } }while(0)
  #define STEP(C0,C1,P0,P1,t,GK,GV,GL) do{ SBAR(); \
    const lds_cptr vp_=vp0+sl_prev; \
    VRD(0); SBAR(); float sacc=(P0[0]+P0[1]); \
    GAPA(C0=__builtin_amdgcn_mfma_f32_32x32x16_bf16(kf[0],qr[0],negm,0,0,0), P0[2],P0[3],P0[4],P0[5],     pw0[0]=PKW(P0,0), pw0[1]=PKW(P0,2), pw0); \
    VRD(4); SBAR(); GAPA(C1=__builtin_amdgcn_mfma_f32_32x32x16_bf16(kf[1],qr[0],negm,0,0,0), P0[6],P0[7],P0[8],P0[9],     pw0[2]=PKW(P0,4), pw0[3]=PKW(P0,6), pw0); \
    VRD(1); SBAR(); GAPA(C0=__builtin_amdgcn_mfma_f32_32x32x16_bf16(kf[2],qr[1],C0,0,0,0),   P0[10],P0[11],P0[12],P0[13], pw1[0]=PKW(P0,8), pw1[1]=PKW(P0,10), pw1); \
    VRD(5); SBAR(); GAPA(C1=__builtin_amdgcn_mfma_f32_32x32x16_bf16(kf[3],qr[1],C1,0,0,0),   P0[14],P0[15],P1[0],P1[1],   pw1[2]=PKW(P0,12),pw1[3]=PKW(P0,14), pw1); \
    VRD(2); SBAR(); GAPA(C0=__builtin_amdgcn_mfma_f32_32x32x16_bf16(kf[4],qr[2],C0,0,0,0),   P1[2],P1[3],P1[4],P1[5],     pw2[0]=PKW(P1,0), pw2[1]=PKW(P1,2), pw2); \
    VRD(6); SBAR(); GAPA(C1=__builtin_amdgcn_mfma_f32_32x32x16_bf16(kf[5],qr[2],C1,0,0,0),   P1[6],P1[7],P1[8],P1[9],     pw2[2]=PKW(P1,4), pw2[3]=PKW(P1,6), pw2); \
    VRD(3); SBAR(); GAPA(C0=__builtin_amdgcn_mfma_f32_32x32x16_bf16(kf[6],qr[3],C0,0,0,0),   P1[10],P1[11],P1[12],P1[13], pw3[0]=PKW(P1,8), pw3[1]=PKW(P1,10), pw3); \
    VRD(7); SBAR(); GAPA(C1=__builtin_amdgcn_mfma_f32_32x32x16_bf16(kf[7],qr[3],C1,0,0,0),   P1[14],P1[15],0.f,0.f,       pw3[2]=PKW(P1,12),pw3[3]=PKW(P1,14), pw3); \
    if(NKD==6){ C0=__builtin_amdgcn_mfma_f32_32x32x16_bf16(kf[(NKD==6)?8:0],qr[(NKD==6)?4:0],C0,0,0,0); C1=__builtin_amdgcn_mfma_f32_32x32x16_bf16(kf[(NKD==6)?9:0],qr[(NKD==6)?4:0],C1,0,0,0); \
      C0=__builtin_amdgcn_mfma_f32_32x32x16_bf16(kf[(NKD==6)?10:0],qr[(NKD==6)?5:0],C0,0,0,0); C1=__builtin_amdgcn_mfma_f32_32x32x16_bf16(kf[(NKD==6)?11:0],qr[(NKD==6)?5:0],C1,0,0,0); SBAR(); } \
    l_reg+=sacc; \
    if(GK){DMA_K((t)+3,sl_cur);} if(GV){DMA_V((t)+1,sl_next);} \
    CMASK(C0,C1,t); \
    { float a=MX3(C0[0],C0[1],C1[0]),b=MX3(C0[2],C0[3],C1[1]); a=MX3(a,C1[2],C1[3]); \
      _Pragma("unroll") for(int r=4;r<16;r+=4){a=MX3(a,C0[r],C0[r+1]);b=MX3(b,C0[r+2],C0[r+3]);a=MX3(a,C1[r],C1[r+1]);b=MX3(b,C1[r+2],C1[r+3]);} \
      float rm=__builtin_fmaxf(a,b); { auto rr=__builtin_amdgcn_permlane32_swap(__float_as_uint(rm),__float_as_uint(rm),false,false); rm=__builtin_fmaxf(__uint_as_float(rr[0]),__uint_as_float(rr[1])); } \
      resc=false; \
      if(__builtin_expect(__any(rm>(float)THRL),0)){ const float dl=__builtin_fmaxf(rm,0.f); mhat+=dl; \
        _Pragma("unroll") for(int r=0;r<16;++r){C0[r]-=dl;C1[r]-=dl;} \
        _Pragma("unroll") for(int r=0;r<16;++r)negm[r]=-mhat; asm volatile("":"+v"(negm)); \
        const float f=__builtin_amdgcn_exp2f(-dl); l_reg*=f; if(hi==0)wsf[r32]=f; resc=true; } } \
    SBAR(); \
    GAPB(o[0]=__builtin_amdgcn_mfma_f32_32x32x16_bf16(PAF(0),VFR(0),o[0],0,0,0), C0,0); \
    GAPB(o[1]=__builtin_amdgcn_mfma_f32_32x32x16_bf16(PAF(0),VFR(4),o[1],0,0,0), C0,4); \
    KRD(GL,0); GAPB(o[0]=__builtin_amdgcn_mfma_f32_32x32x16_bf16(PAF(1),VFR(1),o[0],0,0,0), C0,8); \
    KRD(GL,1); GAPB(o[1]=__builtin_amdgcn_mfma_f32_32x32x16_bf16(PAF(1),VFR(5),o[1],0,0,0), C0,12); \
    KRD(GL,2); GAPB(o[0]=__builtin_amdgcn_mfma_f32_32x32x16_bf16(PAF(2),VFR(2),o[0],0,0,0), C1,0); \
    KRD(GL,3); GAPB(o[1]=__builtin_amdgcn_mfma_f32_32x32x16_bf16(PAF(2),VFR(6),o[1],0,0,0), C1,4); \
    if(NKD==6){KRD(GL,(NKD==6)?4:0);} GAPB(o[0]=__builtin_amdgcn_mfma_f32_32x32x16_bf16(PAF(3),VFR(3),o[0],0,0,0), C1,8); \
    if(NKD==6){KRD(GL,(NKD==6)?5:0);} GAPB(o[1]=__builtin_amdgcn_mfma_f32_32x32x16_bf16(PAF(3),VFR(7),o[1],0,0,0), C1,12); \
    }while(0)
  int t=1;
  #undef CMASK
  #define CMASK(P0,P1,t) do{}while(0)
  for(;t+5<NT;t+=2){
    STEP(pB0,pB1,pA0,pA1,t,true,true,true);     WAIT_KV(); RESC(); ROT();
    STEP(pA0,pA1,pB0,pB1,t+1,true,true,true);   WAIT_KV(); RESC(); ROT();
  }
  #undef CMASK
  #define CMASK(P0,P1,t) do{}while(0)
  #define ENDW(tt) do{ if((tt)+3<NT){WAIT_KV();} else if((tt)+2<NT){WAIT_BAR(1);} else {WAIT_BAR(0);} }while(0)
  for(;t+1<NT;t+=2){
    STEP(pB0,pB1,pA0,pA1,t,(t+3<NT),(t+1<NT),(t+1<NT));       ENDW(t);   RESC(); ROT();
    STEP(pA0,pA1,pB0,pB1,t+1,(t+4<NT),(t+2<NT),(t+2<NT));     ENDW(t+1); RESC(); ROT();
  }
  STEP(pB0,pB1,pA0,pA1,NT-1,false,false,false); RESC();
  { float sacc=pB0[0]+pB0[1]; _Pragma("unroll") for(int r=2;r<16;++r)sacc+=pB0[r]; _Pragma("unroll") for(int r=0;r<16;++r)sacc+=pB1[r]; l_reg+=sacc;
    pw0=(u32x4){PKW(pB0,0),PKW(pB0,2),PKW(pB0,4),PKW(pB0,6)};pw1=(u32x4){PKW(pB0,8),PKW(pB0,10),PKW(pB0,12),PKW(pB0,14)};pw2=(u32x4){PKW(pB1,0),PKW(pB1,2),PKW(pB1,4),PKW(pB1,6)};pw3=(u32x4){PKW(pB1,8),PKW(pB1,10),PKW(pB1,12),PKW(pB1,14)};
    SBAR(); pv(o,vb0+sl_cur,PAF(0),PAF(1),PAF(2),PAF(3)); }
  #undef PKW
  #undef PAF
  #undef VFR
  #undef PIN
  #undef MX3
  #undef GAPA
  #undef GAPB
  #undef EX
  #undef VRD
  #undef KRD
  #undef STEP
  #undef ENDW
  {auto rr=__builtin_amdgcn_permlane32_swap(__float_as_uint(l_reg),__float_as_uint(l_reg),false,false);l_reg=__uint_as_float(rr[0])+__uint_as_float(rr[1]);}
  if(hi==0)wsf[32+r32]=l_reg;asm volatile("s_waitcnt lgkmcnt(0)":::"memory");
  float rli[16];
  #pragma unroll
  for(int r=0;r<16;++r)rli[r]=__builtin_amdgcn_rcpf(wsf[32+crow(r,hi)]);
  bf16*Ow=Ou+(long)(wid*QBLK)*OP;
  { bf16*stg=(bf16*)(shm+LDS_OST)+wid*2048;
    #pragma unroll
    for(int r=0;r<16;++r){const int orow=crow(r,hi);
      #pragma unroll
      for(int d0=0;d0<2;++d0)stg[orow*64+d0*32+r32]=(bf16)f2bf_t(o[d0][r]*rli[r]);}
    asm volatile("s_waitcnt lgkmcnt(0)":::"memory");
    #pragma unroll
    for(int i=0;i<4;++i){const int row=i*8+(lane>>3),ch=lane&7; const u32x4 v=*(const u32x4*)(stg+row*64+ch*8); ATTN_STORE16(Ow+(long)row*OP+ch*8,v);} }
  asm volatile("s_waitcnt lgkmcnt(0)\n\ts_barrier":::"memory");
  #undef DMA_K
  #undef KOFF
  #undef WAIT_KV
  #undef DMA_V
  #undef CMASK
  #undef START
  #undef RESC
  #undef ROT
}

#undef SBAR
#undef WAIT_BAR
}

struct Fr { int lane, wave, gw, NGW, vcu, G; LAS unsigned char* lds; };

__device__ __forceinline__ void tr_item(const float* W, int K, int N, bf16_t* WT, int drow0, int k0, int n0, LAS float* scr, int lane, const float wsc = 1.0f) {
    { f32x4 w[8];
#pragma unroll
      for (int i = 0; i < 8; ++i) w[i] = *(const f32x4*)(W + (size_t)(k0 + 8 * i + (lane >> 3)) * N + n0 + 4 * (lane & 7));
#pragma unroll
      for (int i = 0; i < 8; ++i) { LAS float* d = scr + (8 * i + (lane >> 3)) * 33 + 4 * (lane & 7); d[0] = w[i].x; d[1] = w[i].y; d[2] = w[i].z; d[3] = w[i].w; } }
    asm volatile("s_waitcnt lgkmcnt(0)" ::: "memory");
    const int c = lane & 7;
#pragma unroll
    for (int j = 0; j < 4; ++j) { const int n = (lane >> 3) + 8 * j; const LAS float* s = scr + (8 * c) * 33 + n;
        u32x4 o; o.x = pk2(s[0 * 33] * wsc, s[1 * 33] * wsc); o.y = pk2(s[2 * 33] * wsc, s[3 * 33] * wsc); o.z = pk2(s[4 * 33] * wsc, s[5 * 33] * wsc); o.w = pk2(s[6 * 33] * wsc, s[7 * 33] * wsc);
        *(u32x4*)(WT + (size_t)(drow0 + n) * K + k0 + 8 * c) = o; }
    asm volatile("s_waitcnt lgkmcnt(0)" ::: "memory");
}

constexpr int I_FI = 16 * 176, I_FO = 44 * 32, I_EIN = 16 * 61, I_EQB = 4 * 24, I_EKVB = 2 * 32, I_SQ = 16 * 32, I_OIN = 16 * 56;
constexpr int I_E4 = I_EIN + I_EQB + I_EKVB + I_SQ, I_O2 = I_OIN + I_SQ;
constexpr int N_TR0 = 2 * I_FI + 2 * I_FO + I_E4, N_TR1 = 2 * I_FI + 2 * I_FO + I_O2;
__device__ __forceinline__ void tr_decode(const Params& P, const Fr& F, int it, LAS float* scr) {
    unsigned char* ws = P.ws;
        int r = it;
        if (r < 4 * I_FI) { const int mat = r / I_FI; r -= mat * I_FI; const int kb = r / 176, nb = r % 176, n0 = nb * 32, g = n0 / DFF, j = n0 - g * DFF;
            tr_item(P.w_ffn_in + (size_t)mat * DM * NFI, DM, NFI, (bf16_t*)(ws + WS_WFI) + (size_t)mat * NFI * DM, (j / 128) * 256 + g * 128 + (j % 128), kb * 64, n0, scr, F.lane, g ? -0.6931471805599453f : -1.4426950408889634f); return; }
        r -= 4 * I_FI;
        if (r < 4 * I_FO) { const int mat = r / I_FO; r -= mat * I_FO; const int kb = r / 32, nb = r % 32;
            tr_item(P.w_ffn_out + (size_t)mat * DFF * DM, DFF, DM, (bf16_t*)(ws + WS_WFO) + (size_t)mat * DM * DFF, nb * 32, kb * 64, nb * 32, scr, F.lane); return; }
        r -= 4 * I_FO;
        if (r < I_EIN) { const int kb = r / 61, nb = r % 61, n0 = nb * 32; int dr = n0;
            if (n0 >= 512 && n0 < 1024) { const int j = n0 - 512; dr = 512 + (j / 128) * 256 + (j % 128); } else if (n0 >= 1024 && n0 < 1536) { const int j = n0 - 1024; dr = 512 + (j / 128) * 256 + 128 + (j % 128); }
            tr_item(P.e_w_in, DM, E_IN, (bf16_t*)(ws + WS_EWIN), dr, kb * 64, n0, scr, F.lane); return; }
        r -= I_EIN;
        if (r < I_EQB) { const int kb = r / 24, nb = r % 24; tr_item(P.e_w_q_b, 256, 768, (bf16_t*)(ws + WS_EWQB), nb * 32, kb * 64, nb * 32, scr, F.lane); return; }
        r -= I_EQB;
        if (r < I_EKVB) { const int kb = r / 32, nb = r % 32; tr_item(P.e_w_kv_b, 128, 1024, (bf16_t*)(ws + WS_EWKVB), nb * 32, kb * 64, nb * 32, scr, F.lane); return; }
        r -= I_EKVB;
        if (r < I_SQ) { const int kb = r / 32, nb = r % 32; tr_item(P.e_w_out, DM, DM, (bf16_t*)(ws + WS_EWOUT), nb * 32, kb * 64, nb * 32, scr, F.lane); return; }
        r -= I_SQ;
        if (r < I_OIN) { const int kb = r / 56, nb = r % 56, n0 = nb * 32; int dr = n0;
            if (n0 >= 1280) { const int j = n0 - 1280; dr = 768 + (j / 128) * 256 + 128 + (j % 128); } else if (n0 >= 768) { const int j = n0 - 768; dr = 768 + (j / 128) * 256 + (j % 128); }
            tr_item(P.o_w_in, DM, O_IN, (bf16_t*)(ws + WS_OWIN), dr, kb * 64, n0, scr, F.lane); return; }
        r -= I_OIN;
        { const int kb = r / 32, nb = r % 32; tr_item(P.o_w_out, DM, DM, (bf16_t*)(ws + WS_OWOUT), nb * 32, kb * 64, nb * 32, scr, F.lane); }
}
__device__ __forceinline__ void tr_items(const Params& P, const Fr& F, int which, int worker, int nworkers) {
    LAS float* scr = (LAS float*)(F.lds + F.wave * 16384);
    const int n = which ? N_TR1 : N_TR0;
    for (int v = worker; v < n; v += nworkers) { int it;
        if (v < 2 * I_FI) it = which * 2 * I_FI + v;
        else if (v < 2 * I_FI + 2 * I_FO) it = 4 * I_FI + which * 2 * I_FO + (v - 2 * I_FI);
        else it = 4 * I_FI + 4 * I_FO + which * I_E4 + (v - 2 * I_FI - 2 * I_FO);
        tr_decode(P, F, it, scr); }
}
__device__ __forceinline__ void p0_prologue(const Params& P, const Fr& F0, const bool do_mod) {
    Fr F = F0; F.lane = fresh_lane();
    unsigned char* ws = P.ws;
    tr_items(P, F, 0, F.gw, F.NGW);
    { u32x4* z = (u32x4*)((bf16_t*)(ws + WS_EWIN) + (size_t)E_IN * DM); const int n16 = 96 * DM * 2 / 16;
      for (int i = F.gw * 64 + F.lane; i < n16; i += F.NGW * 64) z[i] = (u32x4){0u, 0u, 0u, 0u}; }
    if (do_mod) { float* MOD = (float*)(ws + WS_MOD);
      for (int it = F.gw; it < 2 * 36 * 16; it += F.NGW) {
          const int l = it / (36 * 16), r = it % (36 * 16), jb = r / 16, kc = r % 16, k0 = kc * 64;
          const float s0 = silu_f(P.c[k0 + F.lane]), s1 = silu_f(P.c[DM + k0 + F.lane]), s2 = silu_f(P.c_ctx[k0 + F.lane]);
          const float* wp = P.w_mod + ((size_t)l * DM + k0) * 9216 + jb * 256 + F.lane * 4;
          f32x4 a0 = {0.f, 0.f, 0.f, 0.f}, a1 = a0, a2 = a0;
#pragma unroll 8
          for (int k = 0; k < 64; ++k) { const f32x4 w = *(const f32x4*)(wp + (size_t)k * 9216); a0 += w * rdlane(s0, k); a1 += w * rdlane(s1, k); a2 += w * rdlane(s2, k); }
          if (kc == 0) { const f32x4 bv = *(const f32x4*)(P.b_mod + (size_t)l * 9216 + jb * 256 + F.lane * 4); a0 += bv; a1 += bv; a2 += bv; }
          float* mp = MOD + (size_t)l * 3 * 9216 + jb * 256 + F.lane * 4;
#pragma unroll
          for (int e = 0; e < 4; ++e) { atomicAdd(mp + e, a0[e]); atomicAdd(mp + 9216 + e, a1[e]); atomicAdd(mp + 2 * 9216 + e, a2[e]); }
      } }
    { f32x2* rt = (f32x2*)(ws + WS_ROPE);
      for (int i = F.gw * 64 + F.lane; i < 2 * 128 * 16; i += F.NGW * 64) {
          const int kind = i >> 11, pos = (i >> 4) & 127, f = i & 15; const float nf = kind ? 16.f : 8.f;
          const float inv = exp2f(-((float)f / nf) * 13.287712379549449f);
          const float ang = (float)pos * inv;
          const double rev = (double)ang * 0.15915494309189535; const float fr_ = (float)(rev - __builtin_rint(rev));
          rt[i] = (f32x2){__builtin_amdgcn_cosf(fr_), __builtin_amdgcn_sinf(fr_)}; } }
}

__device__ __forceinline__ void ld8(const bf16_t* p, float (&f)[8]) { unpack8(*(const u32x4*)p, f); }
__device__ __forceinline__ void ldf8(const float* p, float (&f)[8]) { const f32x4 a = *(const f32x4*)p, b = *(const f32x4*)(p + 4); f[0] = a.x; f[1] = a.y; f[2] = a.z; f[3] = a.w; f[4] = b.x; f[5] = b.y; f[6] = b.z; f[7] = b.w; }
__device__ __forceinline__ void norm_finish(float (&v0)[8], float (&v1)[8], const float (&g0)[8], const float (&g1)[8], const float* shp, bf16_t* arow) {
    float s = 0.f;
#pragma unroll
    for (int i = 0; i < 8; ++i) s += v0[i] * v0[i] + v1[i] * v1[i];
    const float rstd = 1.f / sqrtf(wave_sum(s) * (1.f / DM) + EPS);
    float sh0[8], sh1[8], sc0[8], sc1[8]; ldf8(shp, sh0); ldf8(shp + 512, sh1); ldf8(shp + DM, sc0); ldf8(shp + DM + 512, sc1);
    float o0[8], o1[8];
#pragma unroll
    for (int i = 0; i < 8; ++i) { o0[i] = v0[i] * rstd * g0[i] * (sc0[i] + 1.f) + sh0[i]; o1[i] = v1[i] * rstd * g1[i] * (sc1[i] + 1.f) + sh1[i]; }
    *(u32x4*)arow = pack8(o0); *(u32x4*)(arow + 512) = pack8(o1);
}
__device__ __forceinline__ void norm_phase(const Params& P, const Fr& F0, int l, int j, int nslab) {
    Fr F = F0; F.lane = fresh_lane();
    bf16_t* Hb = (bf16_t*)(P.ws + WS_H); bf16_t* A = (bf16_t*)(P.ws + WS_A); const float* MOD = (const float*)(P.ws + WS_MOD);
    const int c0 = F.lane * 8;
    float g0[8], g1[8]; ldf8(P.norm_g + (size_t)(l * 3 + j) * DM + c0, g0); ldf8(P.norm_g + (size_t)(l * 3 + j) * DM + 512 + c0, g1);
    const bool from_input = (l == 0 && j == 0), ctx_from_input = (l == 0 && j <= 1);
    const bool uneven = (nslab > 0) && (F.NGW == 2048);
    const int rbase = uneven ? (F.gw < 512 ? F.gw : 1024 + (F.gw - 512)) : F.gw, rstride = uneven ? (F.gw < 512 ? 512 : 1536) : F.NGW, rend = uneven ? (F.gw < 512 ? 1024 : NB * SEQ) : NB * SEQ;
    u32x4 qa0 = {0u, 0u, 0u, 0u}, qa1 = qa0, qb0 = qa0, qb1 = qa0; f32x4 fa[4], fb[4];
#pragma unroll
    for (int i = 0; i < 4; ++i) { fa[i] = (f32x4){0.f, 0.f, 0.f, 0.f}; fb[i] = fa[i]; }
#define NP_LOAD(r_) do { const int ra_ = (r_), rb_ = ((r_) + rstride < rend) ? (r_) + rstride : (r_); \
        if (from_input) { const float* pa_ = P.x + (size_t)ra_ * DM + c0; const float* pb_ = P.x + (size_t)rb_ * DM + c0; \
            fa[0] = *(const f32x4*)pa_; fa[1] = *(const f32x4*)(pa_ + 4); fa[2] = *(const f32x4*)(pa_ + 512); fa[3] = *(const f32x4*)(pa_ + 516); \
            fb[0] = *(const f32x4*)pb_; fb[1] = *(const f32x4*)(pb_ + 4); fb[2] = *(const f32x4*)(pb_ + 512); fb[3] = *(const f32x4*)(pb_ + 516); } \
        else { const int ba_ = ra_ / SEQ, bb_ = rb_ / SEQ; const size_t rowa_ = (size_t)ba_ * SEQT + (ra_ - ba_ * SEQ), rowb_ = (size_t)bb_ * SEQT + (rb_ - bb_ * SEQ); \
            qa0 = *(const u32x4*)(Hb + rowa_ * DM + c0); qa1 = *(const u32x4*)(Hb + rowa_ * DM + 512 + c0); qb0 = *(const u32x4*)(Hb + rowb_ * DM + c0); qb1 = *(const u32x4*)(Hb + rowb_ * DM + 512 + c0); } } while (0)
    if (rbase < rend) NP_LOAD(rbase);
    for (int r = rbase; r < rend; r += 2 * rstride) { const int ra = r, rb = (r + rstride < rend) ? r + rstride : r;
        const int ba = ra / SEQ, bb = rb / SEQ; const size_t rowa = (size_t)ba * SEQT + (ra - ba * SEQ), rowb = (size_t)bb * SEQT + (rb - bb * SEQ);
        float va0[8], va1[8], vb0[8], vb1[8];
        if (from_input) {
#pragma unroll
            for (int i = 0; i < 4; ++i) { va0[i] = fa[0][i]; va0[4 + i] = fa[1][i]; va1[i] = fa[2][i]; va1[4 + i] = fa[3][i]; vb0[i] = fb[0][i]; vb0[4 + i] = fb[1][i]; vb1[i] = fb[2][i]; vb1[4 + i] = fb[3][i]; } }
        else { unpack8(qa0, va0); unpack8(qa1, va1); unpack8(qb0, vb0); unpack8(qb1, vb1); }
        { const int rn = (r + 2 * rstride < rend) ? r + 2 * rstride : r; NP_LOAD(rn); }
        norm_finish(va0, va1, g0, g1, MOD + ((size_t)(l * 3 + ba) * 9 + 3 * j) * DM + c0, A + rowa * DM + c0);
        if (rb != ra) norm_finish(vb0, vb1, g0, g1, MOD + ((size_t)(l * 3 + bb) * 9 + 3 * j) * DM + c0, A + rowb * DM + c0); }
#undef NP_LOAD
    for (int r = F.gw; r < NB * CTXL; r += F.NGW) { const int b = r / CTXL, tc = r - b * CTXL; const size_t row = (size_t)b * SEQT + SEQ + tc;
        float v0[8], v1[8];
        if (ctx_from_input) { const float* inrow = P.ctx + (size_t)r * DM; ldf8(inrow + c0, v0); ldf8(inrow + 512 + c0, v1); }
        else { ld8(Hb + row * DM + c0, v0); ld8(Hb + row * DM + 512 + c0, v1); }
        if (nslab > 0) {
            const float* pr = (const float*)(P.ws + WS_PART) + (size_t)r * DM + c0;
            for (int sl = 0; sl < nslab; sl += 4) { float a0[8], a1[8], b0[8], b1[8], c0_[8], c1_[8], d0[8], d1[8];
                const bool two = (sl + 2 < nslab);
                ldf8(pr + (size_t)sl * 512 * DM, a0); ldf8(pr + (size_t)sl * 512 * DM + 512, a1); ldf8(pr + (size_t)(sl + 1) * 512 * DM, b0); ldf8(pr + (size_t)(sl + 1) * 512 * DM + 512, b1);
                const size_t s2 = two ? (size_t)(sl + 2) : (size_t)sl, s3 = two ? (size_t)(sl + 3) : (size_t)sl;
                ldf8(pr + s2 * 512 * DM, c0_); ldf8(pr + s2 * 512 * DM + 512, c1_); ldf8(pr + s3 * 512 * DM, d0); ldf8(pr + s3 * 512 * DM + 512, d1);
                const float m2 = two ? 1.f : 0.f;
#pragma unroll
                for (int i = 0; i < 8; ++i) { v0[i] += (a0[i] + b0[i]) + m2 * (c0_[i] + d0[i]); v1[i] += (a1[i] + b1[i]) + m2 * (c1_[i] + d1[i]); } }
            *(u32x4*)(Hb + row * DM + c0) = pack8(v0); *(u32x4*)(Hb + row * DM + 512 + c0) = pack8(v1); }
        norm_finish(v0, v1, g0, g1, MOD + ((size_t)(l * 3 + 2) * 9 + 3 * j) * DM + c0, A + row * DM + c0); }
}
__device__ __forceinline__ void final_norm(const Params& P, const Fr& F0) {
    Fr F = F0; F.lane = fresh_lane();
    const bf16_t* Hb = (const bf16_t*)(P.ws + WS_H); const int c0 = F.lane * 8;
    float g0[8], g1[8]; ldf8(P.final_g + c0, g0); ldf8(P.final_g + 512 + c0, g1);
    for (int r0 = F.gw; r0 < NB * SEQ; r0 += 2 * F.NGW) { const int ra = r0, rb = (r0 + F.NGW < NB * SEQ) ? r0 + F.NGW : r0;
        const int ba = ra / SEQ, bb = rb / SEQ; const size_t rowa = (size_t)ba * SEQT + (ra - ba * SEQ), rowb = (size_t)bb * SEQT + (rb - bb * SEQ);
        const u32x4 ra0 = *(const u32x4*)(Hb + rowa * DM + c0), ra1 = *(const u32x4*)(Hb + rowa * DM + 512 + c0), rb0 = *(const u32x4*)(Hb + rowb * DM + c0), rb1 = *(const u32x4*)(Hb + rowb * DM + 512 + c0);
#pragma unroll
        for (int h = 0; h < 2; ++h) { float v0[8], v1[8]; unpack8(h ? rb0 : ra0, v0); unpack8(h ? rb1 : ra1, v1); const int r = h ? rb : ra; if (h && rb == ra) break;
        float s = 0.f;
#pragma unroll
        for (int i = 0; i < 8; ++i) s += v0[i] * v0[i] + v1[i] * v1[i];
        const float rstd = 1.f / sqrtf(wave_sum(s) * (1.f / DM) + EPS);
        float* op = P.out + (size_t)r * DM + c0;
        *(f32x4*)op = (f32x4){v0[0] * rstd * g0[0], v0[1] * rstd * g0[1], v0[2] * rstd * g0[2], v0[3] * rstd * g0[3]};
        *(f32x4*)(op + 4) = (f32x4){v0[4] * rstd * g0[4], v0[5] * rstd * g0[5], v0[6] * rstd * g0[6], v0[7] * rstd * g0[7]};
        *(f32x4*)(op + 512) = (f32x4){v1[0] * rstd * g1[0], v1[1] * rstd * g1[1], v1[2] * rstd * g1[2], v1[3] * rstd * g1[3]};
        *(f32x4*)(op + 516) = (f32x4){v1[4] * rstd * g1[4], v1[5] * rstd * g1[5], v1[6] * rstd * g1[6], v1[7] * rstd * g1[7]}; } }
}


__device__ __forceinline__ void elem_even(const Params& P, const Fr& F0) {
    Fr F = F0; F.lane = fresh_lane();
    const bf16_t* PP = (const bf16_t*)(P.ws + WS_P); bf16_t* Y = (bf16_t*)(P.ws + WS_Y); bf16_t* QAN = (bf16_t*)(P.ws + WS_QAN); bf16_t* KVAN = (bf16_t*)(P.ws + WS_KVAN); bf16_t* KR = (bf16_t*)(P.ws + WS_KR);
    const f32x2* rope = (const f32x2*)(P.ws + WS_ROPE);
    const int lane = F.lane, ch0 = lane * 8;
    float w0[8], w1[8], w2[8]; ldf8(P.e_conv_w + ch0, w0); ldf8(P.e_conv_w + 512 + ch0, w1); ldf8(P.e_conv_w + 1024 + ch0, w2);
    const int seg = lane < 32 ? 0 : lane < 48 ? 1 : lane < 52 ? 2 : 3;
    const int scol = lane < 32 ? 1536 + lane * 8 : lane < 48 ? 1792 + (lane - 32) * 8 : lane < 52 ? 1920 + (lane - 48) * 8 : 0;
    float gn[8];
    if (seg == 0) ldf8(P.e_q_norm + lane * 8, gn); else if (seg == 1) ldf8(P.e_kv_norm + (lane - 32) * 8, gn); else { for (int i = 0; i < 8; ++i) gn[i] = 1.f; }
    u32x4 rsb, rc0, rx0, rsv, rcm, rxm, rcp, rxp; float mmk, mpk;
#define EV_LOAD(rw) do { const int b_ = (rw) / SEQT, t_ = (rw) - b_ * SEQT; const bool lat_ = t_ < SEQ; const int s0_ = lat_ ? 0 : SEQ, s1_ = lat_ ? SEQ : SEQT; \
        const bool hm_ = (t_ - 1 >= s0_), hp_ = (t_ + 1 < s1_); const bf16_t* Pr_ = PP + (size_t)(rw) * E_INP; const bf16_t* Pm_ = hm_ ? Pr_ - E_INP : Pr_; const bf16_t* Pp_ = hp_ ? Pr_ + E_INP : Pr_; \
        rsb = *(const u32x4*)(Pr_ + ch0); rc0 = *(const u32x4*)(Pr_ + 512 + ch0); rx0 = *(const u32x4*)(Pr_ + 1024 + ch0); rsv = *(const u32x4*)(Pr_ + scol); \
        rcm = *(const u32x4*)(Pm_ + 512 + ch0); rxm = *(const u32x4*)(Pm_ + 1024 + ch0); rcp = *(const u32x4*)(Pp_ + 512 + ch0); rxp = *(const u32x4*)(Pp_ + 1024 + ch0); mmk = hm_ ? 1.f : 0.f; mpk = hp_ ? 1.f : 0.f; } while (0)
    if (F.gw < T) EV_LOAD(F.gw);
    for (int row = F.gw; row < T; row += F.NGW) { const int b = row / SEQT, t = row - b * SEQT; const bool lat = t < SEQ;
        float sb[8], c0[8], x0[8], cm[8], xm[8], cp[8], xp[8], sv[8];
        unpack8(rsb, sb); unpack8(rc0, c0); unpack8(rx0, x0); unpack8(rsv, sv); unpack8(rcm, cm); unpack8(rxm, xm); unpack8(rcp, cp); unpack8(rxp, xp);
        const float mm = mmk, mp = mpk;
        { const int nrow = (row + F.NGW < T) ? row + F.NGW : row; EV_LOAD(nrow); }
#pragma unroll
        for (int i = 0; i < 8; ++i) { cm[i] *= mm; cp[i] *= mp; }
        float ya[8];
#pragma unroll
        for (int i = 0; i < 8; ++i) ya[i] = sb[i] * (w0[i] * (cm[i] * xm[i]) + w1[i] * (c0[i] * x0[i]) + w2[i] * (cp[i] * xp[i]));
        *(u32x4*)(Y + (size_t)row * DM + ch0) = pack8(ya);
        float ss = 0.f;
#pragma unroll
        for (int i = 0; i < 8; ++i) ss += sv[i] * sv[i];
        const float sq = wave_sum(seg == 0 ? ss : 0.f), skv = wave_sum(seg == 1 ? ss : 0.f);
        if (seg == 0) { const float rstd = 1.f / sqrtf(sq * (1.f / 256.f) + EPS); float o[8];
#pragma unroll
            for (int i = 0; i < 8; ++i) o[i] = sv[i] * rstd * gn[i];
            *(u32x4*)(QAN + (size_t)row * 256 + lane * 8) = pack8(o); }
        else if (seg == 1) { const float rstd = 1.f / sqrtf(skv * (1.f / 128.f) + EPS); float o[8];
#pragma unroll
            for (int i = 0; i < 8; ++i) o[i] = sv[i] * rstd * gn[i];
            *(u32x4*)(KVAN + (size_t)row * 128 + (lane - 32) * 8) = pack8(o); }
        else if (seg == 2) { const int j = lane - 48; float o[8];
#pragma unroll
            for (int p = 0; p < 4; ++p) { const int i = 4 * j + p; float cs = 1.f, sn = 0.f;
                if (lat) { const int pos = (i < 8) ? (t >> 6) : (t & 63); const f32x2 r2 = rope[pos * 16 + (i & 7)]; cs = r2.x; sn = r2.y; }
                o[2 * p] = sv[2 * p] * cs - sv[2 * p + 1] * sn; o[2 * p + 1] = sv[2 * p] * sn + sv[2 * p + 1] * cs; }
            *(u32x4*)(KR + (size_t)row * 32 + j * 8) = pack8(o); } }
#undef EV_LOAD
}
__device__ __forceinline__ void conv_even(const Params& P, const Fr& F0, const int row0_, const int row1_, const int worker, const int nworkers) {
    Fr F = F0; F.lane = fresh_lane();
    const bf16_t* SB = (const bf16_t*)(P.ws + WS_SB); const bf16_t* CX = (const bf16_t*)(P.ws + WS_CX); bf16_t* Y = (bf16_t*)(P.ws + WS_Y);
    const int ch0 = F.lane * 8;
    float w0[8], w1[8], w2[8]; ldf8(P.e_conv_w + ch0, w0); ldf8(P.e_conv_w + 512 + ch0, w1); ldf8(P.e_conv_w + 1024 + ch0, w2);
    u32x4 rsb, rc0, rcm, rcp; float mmk, mpk;
#define CE_LOAD(rw) do { const int b_ = (rw) / SEQT, t_ = (rw) - b_ * SEQT; const bool lat_ = t_ < SEQ; const int s0_ = lat_ ? 0 : SEQ, s1_ = lat_ ? SEQ : SEQT; \
        const bool hm_ = (t_ - 1 >= s0_), hp_ = (t_ + 1 < s1_); const bf16_t* C_ = CX + (size_t)(rw) * 512 + ch0; \
        rsb = *(const u32x4*)(SB + (size_t)(rw) * 512 + ch0); rc0 = *(const u32x4*)C_; rcm = *(const u32x4*)(hm_ ? C_ - 512 : C_); rcp = *(const u32x4*)(hp_ ? C_ + 512 : C_); mmk = hm_ ? 1.f : 0.f; mpk = hp_ ? 1.f : 0.f; } while (0)
    if (row0_ + worker < row1_) CE_LOAD(row0_ + worker);
    for (int row = row0_ + worker; row < row1_; row += nworkers) {
        float sb[8], c0[8], cm[8], cp[8]; unpack8(rsb, sb); unpack8(rc0, c0); unpack8(rcm, cm); unpack8(rcp, cp);
        const float mm = mmk, mp = mpk;
        { const int nrow = (row + nworkers < row1_) ? row + nworkers : row; CE_LOAD(nrow); }
        float ya[8];
#pragma unroll
        for (int i = 0; i < 8; ++i) ya[i] = sb[i] * (w0[i] * (cm[i] * mm) + w1[i] * c0[i] + w2[i] * (cp[i] * mp));
        *(u32x4*)(Y + (size_t)row * DM + ch0) = pack8(ya); }
#undef CE_LOAD
}
__device__ __forceinline__ void kr_copy(const Params& P, const Fr& F0) {
    Fr F = F0; F.lane = fresh_lane();
    const bf16_t* KR = (const bf16_t*)(P.ws + WS_KR); bf16_t* K = (bf16_t*)(P.ws + WS_EK);
    for (int row = F.gw; row < T; row += F.NGW) { const int h = F.lane >> 3, q = F.lane & 7;
        const u32x2 v = *(const u32x2*)(KR + (size_t)row * 32 + q * 4); *(u32x2*)(K + (size_t)row * 768 + h * 96 + 64 + q * 4) = v; }
}
__device__ __forceinline__ void elem_odd(const Params& P, const Fr& F0) {
    Fr F = F0; F.lane = fresh_lane();
    const bf16_t* PP = (const bf16_t*)(P.ws + WS_P); bf16_t* Q = (bf16_t*)(P.ws + WS_OQ); bf16_t* K = (bf16_t*)(P.ws + WS_OK);
    const f32x2* rope = (const f32x2*)(P.ws + WS_ROPE) + 2048;
    const int lane = F.lane, l8 = lane & 7;
    float gq[8], gk[8]; ldf8(P.o_q_norm + l8 * 8, gq); ldf8(P.o_k_norm + l8 * 8, gk);
    u32x4 rq_, rk_; f32x2 rr_[4];
#define OD_LOAD(rw) do { const int b_ = (rw) / SEQT, t_ = (rw) - b_ * SEQT; const bool lat_ = t_ < SEQ; const bf16_t* Pr_ = PP + (size_t)(rw) * 768; \
        rq_ = *(const u32x4*)(Pr_ + lane * 8); rk_ = *(const u32x4*)(Pr_ + 512 + (lane & 15) * 8); \
        _Pragma("unroll") for (int p_ = 0; p_ < 4; ++p_) { const int i_ = 4 * l8 + p_; const int pos_ = lat_ ? ((i_ < 16) ? (t_ >> 6) : (t_ & 63)) : 0; const f32x2 r2_ = rope[pos_ * 16 + (i_ & 15)]; rr_[p_] = lat_ ? r2_ : (f32x2){1.f, 0.f}; } } while (0)
    if (F.gw < T) OD_LOAD(F.gw);
    for (int row = F.gw; row < T; row += F.NGW) {
        float q[8], k[8]; unpack8(rq_, q); unpack8(rk_, k);
        float cs[4], sn[4];
#pragma unroll
        for (int p = 0; p < 4; ++p) { cs[p] = rr_[p].x; sn[p] = rr_[p].y; }
        { const int nrow = (row + F.NGW < T) ? row + F.NGW : row; OD_LOAD(nrow); }
        float sq = 0.f, sk = 0.f;
#pragma unroll
        for (int i = 0; i < 8; ++i) { sq += q[i] * q[i]; sk += k[i] * k[i]; }
        sq += swz<0x041F>(sq); sq += swz<0x081F>(sq); sq += swz<0x101F>(sq);
        sk += swz<0x041F>(sk); sk += swz<0x081F>(sk); sk += swz<0x101F>(sk);
        const float rq = 1.f / sqrtf(sq * (1.f / 64.f) + EPS), rk = 1.f / sqrtf(sk * (1.f / 64.f) + EPS);
        float qo[8], ko[8];
#pragma unroll
        for (int p = 0; p < 4; ++p) { const float q0 = q[2 * p] * rq * gq[2 * p], q1 = q[2 * p + 1] * rq * gq[2 * p + 1]; qo[2 * p] = (q0 * cs[p] - q1 * sn[p]) * C2_GQA; qo[2 * p + 1] = (q0 * sn[p] + q1 * cs[p]) * C2_GQA;
            const float k0 = k[2 * p] * rk * gk[2 * p], k1 = k[2 * p + 1] * rk * gk[2 * p + 1]; ko[2 * p] = k0 * cs[p] - k1 * sn[p]; ko[2 * p + 1] = k0 * sn[p] + k1 * cs[p]; }
        *(u32x4*)(Q + (size_t)row * 512 + lane * 8) = pack8(qo);
        if (lane < 16) *(u32x4*)(K + (size_t)row * 128 + lane * 8) = pack8(ko); }
#undef OD_LOAD
}
__device__ __forceinline__ void conv_odd(const Params& P, const Fr& F0) {
    Fr F = F0; F.lane = fresh_lane();
    const bf16_t* G = (const bf16_t*)(P.ws + WS_G); bf16_t* Y = (bf16_t*)(P.ws + WS_Y);
    const int lane = F.lane, ch0 = lane * 8;
    constexpr int TK = 8;
    float bias[8], lg[8], lb[8]; ldf8(P.o_conv_b + ch0, bias); ldf8(P.o_ln_g + ch0, lg); ldf8(P.o_ln_b + ch0, lb);
    for (int it = F.gw; it < NB * SEQ / TK; it += F.NGW) { const int b = it / (SEQ / TK), t0 = (it - b * (SEQ / TK)) * TK;
        const bf16_t* Gb = G + (size_t)b * SEQT * 512 + ch0;
        float acc[TK][8];
#pragma unroll
        for (int q = 0; q < TK; ++q)
#pragma unroll
            for (int i = 0; i < 8; ++i) acc[q][i] = bias[i];
        u32x4 gcur[TK + 3];
#pragma unroll
        for (int r = 0; r < TK + 3; ++r) { const int tt = t0 - 15 + r; gcur[r] = (tt >= 0 && tt < SEQ) ? *(const u32x4*)(Gb + (size_t)tt * 512) : (u32x4){0u, 0u, 0u, 0u}; }
#pragma unroll 1
        for (int jc = 0; jc < 32; jc += 4) {
            u32x4 gnxt[TK + 3]; float w[4][8];
#pragma unroll
            for (int jj = 0; jj < 4; ++jj) { if (jc + jj < 31) ldf8(P.o_conv_w + (jc + jj) * 512 + ch0, w[jj]); else { for (int i = 0; i < 8; ++i) w[jj][i] = 0.f; } }
#pragma unroll
            for (int r = 0; r < TK + 3; ++r) { const int tt = t0 + jc + 4 - 15 + r; gnxt[r] = (jc + 4 < 32 && tt >= 0 && tt < SEQ) ? *(const u32x4*)(Gb + (size_t)tt * 512) : (u32x4){0u, 0u, 0u, 0u}; }
#pragma unroll
            for (int r = 0; r < TK + 3; ++r) { float gv[8]; unpack8(gcur[r], gv);
#pragma unroll
                for (int q = 0; q < TK; ++q) { const int jj = r - q; if (jj >= 0 && jj < 4) {
#pragma unroll
                    for (int i = 0; i < 8; ++i) acc[q][i] += w[jj][i] * gv[i]; } } }
#pragma unroll
            for (int r = 0; r < TK + 3; ++r) gcur[r] = gnxt[r]; }
#pragma unroll
        for (int q = 0; q < TK; ++q) { float s = 0.f;
#pragma unroll
            for (int i = 0; i < 8; ++i) s += acc[q][i];
            const float mu = wave_sum(s) * (1.f / 512.f); float s2 = 0.f;
#pragma unroll
            for (int i = 0; i < 8; ++i) { acc[q][i] -= mu; s2 += acc[q][i] * acc[q][i]; }
            const float rstd = 1.f / sqrtf(wave_sum(s2) * (1.f / 512.f) + EPS); float o[8];
#pragma unroll
            for (int i = 0; i < 8; ++i) o[i] = silu_f(acc[q][i] * rstd * lg[i] + lb[i]);
            *(u32x4*)(Y + ((size_t)b * SEQT + t0 + q) * DM + 512 + ch0) = pack8(o); } }
}

#define XB_TMO      128
#define XB_XCNT(j)  (256  + 64 * (j))
#define XB_XSUB(j)  (1280 + 64 * (j))
#define XB_XGEN(j)  (2304 + 64 * (j))
#define XB_TOP      3328
#define XB_TOPGEN   3392
#define XCD_BAR_WORDS 3456
#define XB_SPIN_CAP (1u << 18)

__device__ __forceinline__ unsigned xb_ld(unsigned* p)              { return __hip_atomic_load(p, __ATOMIC_RELAXED, __HIP_MEMORY_SCOPE_AGENT); }
__device__ __forceinline__ unsigned xb_add(unsigned* p, unsigned v) { return __hip_atomic_fetch_add(p, v, __ATOMIC_RELAXED, __HIP_MEMORY_SCOPE_AGENT); }
__device__ __forceinline__ unsigned xb_xcc_id() { return (unsigned)__builtin_amdgcn_s_getreg((3 << 11) | 20) & 0xFu; }
#define XB_SPIN(cond, bar) do { unsigned _sp = 0; while (cond) { __builtin_amdgcn_s_sleep(1); \
    if ((++_sp & 255u) == 0u) { if (xb_ld(&(bar)[XB_TMO])) break; if (_sp > XB_SPIN_CAP) { atomicAdd(&(bar)[XB_TMO], 1u); break; } } } } while (0)

struct XcdBarrier {
    unsigned* bar; unsigned x;
    volatile __attribute__((address_space(3))) unsigned* st;
};

__device__ __forceinline__ XcdBarrier xcd_barrier_post(unsigned* bar, volatile __attribute__((address_space(3))) unsigned* st) {
    XcdBarrier b; b.bar = bar; b.x = xb_xcc_id(); b.st = st;
    if (threadIdx.x == 0) (void)xb_add(&bar[XB_XCNT(b.x)], 1u);
    return b;
}
__device__ __forceinline__ void xcd_barrier_complete(unsigned* bar, unsigned x, unsigned& nloc, unsigned& nx) {
    const unsigned G = gridDim.x * gridDim.y * gridDim.z;
    unsigned sum, cnt, mine, sp = 0u;
    for (;;) {
        sum = 0u; cnt = 0u; mine = 0u;
#pragma unroll
        for (unsigned j = 0; j < 16; ++j) { const unsigned c = xb_ld(&bar[XB_XCNT(j)]); sum += c; cnt += (c > 0u) ? 1u : 0u; mine = (j == x) ? c : mine; }
        if (sum == G) break;
        __builtin_amdgcn_s_sleep(1);
        if ((++sp & 255u) == 0u) { if (xb_ld(&bar[XB_TMO])) break; if (sp > XB_SPIN_CAP) { atomicAdd(&bar[XB_TMO], 1u); break; } }
    }
    nloc = mine > 0u ? mine : 1u; nx = cnt > 0u ? cnt : 1u;
}

__device__ __forceinline__ void xcd_barrier(const XcdBarrier& b) {
    asm volatile("s_waitcnt vmcnt(0)" ::: "memory");
    __syncthreads();
    if (threadIdx.x == 0) {
        unsigned* bar = b.bar;
        __builtin_amdgcn_s_waitcnt(0);
        unsigned nloc = b.st[0], nx = b.st[1];
        if (nloc == 0u) { xcd_barrier_complete(bar, b.x, nloc, nx); b.st[0] = nloc; b.st[1] = nx; }
        const unsigned old = xb_add(&bar[XB_XSUB(b.x)], 1u);
        const unsigned gen = old / nloc;
        if (old + 1u == (gen + 1u) * nloc) {
            __builtin_amdgcn_fence(__ATOMIC_RELEASE, "agent");
            asm volatile("s_waitcnt vmcnt(0)" ::: "memory");
            const unsigned og = xb_add(&bar[XB_TOP], 1u);
            const unsigned tg = og / nx;
            if (og + 1u == (tg + 1u) * nx) xb_add(&bar[XB_TOPGEN], 1u);
            else XB_SPIN(xb_ld(&bar[XB_TOPGEN]) == tg, bar);
            __builtin_amdgcn_fence(__ATOMIC_ACQUIRE, "agent");
            xb_add(&bar[XB_XGEN(b.x)], 1u);
            asm volatile("s_waitcnt vmcnt(0)" ::: "memory");
        } else {
            XB_SPIN(xb_ld(&bar[XB_XGEN(b.x)]) == gen, bar);
            __builtin_amdgcn_fence(__ATOMIC_ACQUIRE, "agent");
            asm volatile("s_waitcnt vmcnt(0)" ::: "memory");
        }
    }
    __syncthreads();
}

#ifdef NO_ATTN
#define ATTN6(...) do{}while(0)
#define ATTN4(...) do{}while(0)
#else
#define ATTN6 attn_unit<6>
#define ATTN4 attn_unit<4>
#endif
#ifdef NO_GEMM
#define GEMM(...) do{}while(0)
#define GEMM_ROT(...) do{}while(0)
#else
template <class E> struct EpiOn { static constexpr bool v = true; };
#ifdef ONLY_EPI
template <class E> struct EpiSel { static constexpr bool v = false; }; template <> struct EpiSel<ONLY_EPI> { static constexpr bool v = true; };
#else
template <class E> struct EpiSel { static constexpr bool v = true; };
#endif
#define GEMM(EpiT, Aptr, Bptr, Kdim, nMl, nNt, skipc, SPL, ...) do { if constexpr (EpiSel<EpiT>::v) { pg8::Gemm g_{(const bf16_t*)(Aptr), (const bf16_t*)(Bptr), T, 0, (Kdim)}; pg8::Order S_; S_.init((nMl), (nNt), F.G, (int)blockIdx.x, (skipc), (Kdim) / 64, (SPL)); \
        EpiT E_{__VA_ARGS__}; pg8::gemm_phase<EpiT, pg8::Order, true, true>(F.lds, g_, S_, E_, F.wave); } } while (0)
#define GEMM_ROT(ROT, EpiT, Aptr, Bptr, Kdim, nMl, nNt, skipc, SPL, ...) do { if constexpr (EpiSel<EpiT>::v) { pg8::Gemm g_{(const bf16_t*)(Aptr), (const bf16_t*)(Bptr), T, 0, (Kdim)}; pg8::Order S_; S_.init((nMl), (nNt), F.G, (int)((blockIdx.x + (ROT)) % gridDim.x), (skipc), (Kdim) / 64, (SPL)); \
        EpiT E_{__VA_ARGS__}; pg8::gemm_phase<EpiT, pg8::Order, true, true>(F.lds, g_, S_, E_, F.wave); } } while (0)
#endif

__global__ void __launch_bounds__(NWAVES * 64, 2) hybrid_fwd(Params P) {
    extern __shared__ __attribute__((aligned(16))) unsigned char lds_raw[];
    cg::grid_group grid = cg::this_grid();
    Fr F; F.lds = (LAS unsigned char*)lds_raw; F.lane = 0; F.wave = __builtin_amdgcn_readfirstlane(threadIdx.x >> 6);
    F.G = gridDim.x; { const int bx = blockIdx.x; F.vcu = (F.G % 8 == 0) ? (bx % 8) * (F.G / 8) + bx / 8 : bx; }
    F.gw = F.vcu * NWAVES + F.wave; F.NGW = F.G * NWAVES;
    unsigned char* ws = P.ws;
    bf16_t* Hb = (bf16_t*)(ws + WS_H); const float* MOD = (const float*)(ws + WS_MOD);
    volatile LAS unsigned* MISC = (volatile LAS unsigned*)(F.lds + RING_BYTES + 320);
    if (threadIdx.x < 32) MISC[threadIdx.x] = 0u;
    __syncthreads();
    XcdBarrier xbar = xcd_barrier_post((unsigned*)(ws + WS_CTL) + 4096, MISC + 8);
#define SYNC() xcd_barrier(xbar)
#ifndef PROBE
#define PROBE 0
#endif
#ifndef NO_P0
    if (PROBE & 16) { p0_prologue(P, F, false); SYNC(); }
    p0_prologue(P, F, true);
#endif
    if (P.ws == nullptr) grid.sync();
    SYNC();
    { constexpr int l = 0;
        const float* modl = MOD + (size_t)l * 3 * 9 * DM;
        if (PROBE & 4) { norm_phase(P, F, l, 0, 0); SYNC(); }
        norm_phase(P, F, l, 0, (l == 1) ? 22 : 0); SYNC();
        if (PROBE & 2) { GEMM(EpiSwiglu, ws + WS_A, ws + WS_WFI + (size_t)(l * 2 + 0) * NFI * DM * 2, DM, 66, 22, 0, 0, (bf16_t*)(ws + WS_ACT)); SYNC(); }
        GEMM(EpiSwiglu, ws + WS_A, ws + WS_WFI + (size_t)(l * 2 + 0) * NFI * DM * 2, DM, 66, 22, 0, 0, (bf16_t*)(ws + WS_ACT)); SYNC();
        if (PROBE & 8) { GEMM(EpiResidT<(l == 0)>, ws + WS_ACT, ws + WS_WFO + (size_t)(l * 2 + 0) * DM * DFF * 2, DFF, 64, 4, 1, 22, Hb, modl + 2 * DM, (float*)(ws + WS_PART), P.x, 0.0f); SYNC(); }
        GEMM(EpiResidT<(l == 0)>, ws + WS_ACT, ws + WS_WFO + (size_t)(l * 2 + 0) * DM * DFF * 2, DFF, 64, 4, 1, 22, Hb, modl + 2 * DM, (float*)(ws + WS_PART), P.x, 0.5f); SYNC();
        if (PROBE & 4) { norm_phase(P, F, l, 1, 0); SYNC(); }
        norm_phase(P, F, l, 1, 22); SYNC();
        if (l == 0) {
            GEMM(EpiEvenIn, ws + WS_A, ws + WS_EWIN, DM, 66, 8, 0, 0, (bf16_t*)(ws + WS_SB), (bf16_t*)(ws + WS_CX), (bf16_t*)(ws + WS_QAN), (bf16_t*)(ws + WS_KVAN), (bf16_t*)(ws + WS_EK), P.e_q_norm, P.e_kv_norm, (const f32x2*)(ws + WS_ROPE), (LAS float*)(F.lds + RING_BYTES + 1024));
            if (blockIdx.x >= 16) { Fr F2 = F; F2.lane = fresh_lane(); tr_items(P, F2, 1, ((int)blockIdx.x - 16) * NWAVES + F.wave, (F.G - 16) * NWAVES); }
            SYNC();
            if (F.G == 256) { if (blockIdx.x < 206) conv_even(P, F, 0, 11536, (int)blockIdx.x * NWAVES + F.wave, 206 * NWAVES); else conv_even(P, F, 11536, T, ((int)blockIdx.x - 206) * NWAVES + F.wave, 50 * NWAVES); }
            else conv_even(P, F, 0, T, F.gw, F.NGW);
            GEMM(EpiQb, ws + WS_QAN, ws + WS_EWQB, 256, 66, 3, 0, 0, (bf16_t*)(ws + WS_EQ), (const f32x2*)(ws + WS_ROPE));
            GEMM_ROT(58, EpiKVb, ws + WS_KVAN, ws + WS_EWKVB, 128, 66, 4, 0, 0, (bf16_t*)(ws + WS_EK), (bf16_t*)(ws + WS_EV));
            SYNC();
            for (int rep_ = 0; rep_ < ((PROBE & 1) ? 2 : 1); ++rep_) {
            { const bf16_t* Q = (const bf16_t*)(ws + WS_EQ); const bf16_t* K = (const bf16_t*)(ws + WS_EK); const bf16_t* V = (const bf16_t*)(ws + WS_EV); bf16_t* Y = (bf16_t*)(ws + WS_Y);
              for (int i = 0; i < 2; ++i) { const int u = 2 * F.vcu + i; if (u >= 512) break; const int bh = u >> 5, qb = u & 31, b = bh >> 3, h = bh & 7; const size_t r0 = (size_t)b * SEQT;
                  tat::attn_unit<8, 6, 768, 768, 512, DM>(Q + (r0 + qb * 256) * 768 + h * 96, K + r0 * 768 + h * 96, V + r0 * 512 + h * 64, Y + (r0 + qb * 256) * DM + 512 + h * 64, SEQT / 64, (char*)lds_raw, F.wave); }
              if ((F.vcu & 15) == 0 && F.vcu < 256) { const int bh = F.vcu >> 4, b = bh >> 3, h = bh & 7; const size_t r0 = (size_t)b * SEQT + SEQ;
                  tat::attn_unit<8, 6, 768, 768, 512, DM>(Q + r0 * 768 + h * 96, K + r0 * 768 + h * 96, V + r0 * 512 + h * 64, Y + r0 * DM + 512 + h * 64, CTXL / 64, (char*)lds_raw, F.wave); } }
            SYNC(); }
        if (PROBE & 8) { GEMM(EpiResidT<false>, ws + WS_Y, ws + WS_EWOUT, DM, 64, 4, 1, 8, Hb, modl + 5 * DM, (float*)(ws + WS_PART), P.x, 0.0f); SYNC(); }
            GEMM(EpiResidT<false>, ws + WS_Y, ws + WS_EWOUT, DM, 64, 4, 1, 8, Hb, modl + 5 * DM, (float*)(ws + WS_PART), P.x, 1.0f); SYNC();
        } else {
            GEMM(EpiOddQKV, ws + WS_A, ws + WS_OWIN, DM, 66, 7, 0, 0, (bf16_t*)(ws + WS_OQ), (bf16_t*)(ws + WS_OK), (bf16_t*)(ws + WS_OV), (bf16_t*)(ws + WS_G), P.o_q_norm, P.o_k_norm, (const f32x2*)(ws + WS_ROPE) + 2048, (LAS float*)(F.lds + RING_BYTES + 1024)); SYNC();
#ifndef NO_CONV
            conv_odd(P, F);
#endif
            for (int rep_ = 0; rep_ < ((PROBE & 1) ? 2 : 1); ++rep_) {
            { const bf16_t* Q = (const bf16_t*)(ws + WS_OQ); const bf16_t* K = (const bf16_t*)(ws + WS_OK); const bf16_t* V = (const bf16_t*)(ws + WS_OV); bf16_t* Y = (bf16_t*)(ws + WS_Y);
              for (int i = 0; i < 2; ++i) { const int u = 2 * F.vcu + i; if (u >= 512) break; const int bh = u >> 5, qb = u & 31, b = bh >> 3, h = bh & 7; const size_t r0 = (size_t)b * SEQT;
                  tat::attn_unit<8, 4, 512, 128, 128, DM>(Q + (r0 + qb * 256) * 512 + h * 64, K + r0 * 128 + (h >> 2) * 64, V + r0 * 128 + (h >> 2) * 64, Y + (r0 + qb * 256) * DM + h * 64, SEQT / 64, (char*)lds_raw, F.wave); } }
            SYNC(); }
        if (PROBE & 8) { GEMM(EpiResidT<false>, ws + WS_Y, ws + WS_OWOUT, DM, 64, 4, 1, 0, Hb, modl + 5 * DM, (float*)(ws + WS_PART), P.x, 0.0f); SYNC(); }
            GEMM(EpiResidT<false>, ws + WS_Y, ws + WS_OWOUT, DM, 64, 4, 1, 0, Hb, modl + 5 * DM, (float*)(ws + WS_PART), P.x, 1.0f); SYNC();
        }
        const int nml = (l == 1) ? 64 : 66, skipc = (l == 1) ? 1 : 0;
        if (PROBE & 4) { norm_phase(P, F, l, 2, 0); SYNC(); }
        norm_phase(P, F, l, 2, (l == 0) ? 8 : 0); SYNC();
        if (PROBE & 2) { GEMM(EpiSwiglu, ws + WS_A, ws + WS_WFI + (size_t)(l * 2 + 1) * NFI * DM * 2, DM, nml, 22, skipc, 0, (bf16_t*)(ws + WS_ACT)); SYNC(); }
        GEMM(EpiSwiglu, ws + WS_A, ws + WS_WFI + (size_t)(l * 2 + 1) * NFI * DM * 2, DM, nml, 22, skipc, 0, (bf16_t*)(ws + WS_ACT)); SYNC();
        if (PROBE & 8) { GEMM(EpiResidT<false>, ws + WS_ACT, ws + WS_WFO + (size_t)(l * 2 + 1) * DM * DFF * 2, DFF, 64, 4, 1, (l == 0 ? 22 : 0), Hb, modl + 8 * DM, (float*)(ws + WS_PART), P.x, 0.0f); SYNC(); }
        if (l == 0) { GEMM(EpiResidT<false>, ws + WS_ACT, ws + WS_WFO + (size_t)(l * 2 + 1) * DM * DFF * 2, DFF, 64, 4, 1, 22, Hb, modl + 8 * DM, (float*)(ws + WS_PART), P.x, 0.5f); SYNC(); }
        else { GEMM(EpiResidNorm<2>, ws + WS_ACT, ws + WS_WFO + (size_t)(l * 2 + 1) * DM * DFF * 2, DFF, 64, 4, 1, 0, Hb, modl + 8 * DM, (float*)(ws + WS_XBUF) + (size_t)T * 4, (unsigned*)(ws + WS_CTL) + 16384 + 8192, (LAS float*)(F.lds + RING_BYTES + 1024), (bf16_t*)(ws + WS_A), P.final_g, modl, P.out, 0.5f); }
        }
    { constexpr int l = 1;
        const float* modl = MOD + (size_t)l * 3 * 9 * DM;
        if (PROBE & 4) { norm_phase(P, F, l, 0, 0); SYNC(); }
        norm_phase(P, F, l, 0, (l == 1) ? 22 : 0); SYNC();
        if (PROBE & 2) { GEMM(EpiSwiglu, ws + WS_A, ws + WS_WFI + (size_t)(l * 2 + 0) * NFI * DM * 2, DM, 66, 22, 0, 0, (bf16_t*)(ws + WS_ACT)); SYNC(); }
        GEMM(EpiSwiglu, ws + WS_A, ws + WS_WFI + (size_t)(l * 2 + 0) * NFI * DM * 2, DM, 66, 22, 0, 0, (bf16_t*)(ws + WS_ACT)); SYNC();
        if (PROBE & 8) { GEMM(EpiResidT<(l == 0)>, ws + WS_ACT, ws + WS_WFO + (size_t)(l * 2 + 0) * DM * DFF * 2, DFF, 64, 4, 1, 22, Hb, modl + 2 * DM, (float*)(ws + WS_PART), P.x, 0.0f); SYNC(); }
        GEMM(EpiResidT<(l == 0)>, ws + WS_ACT, ws + WS_WFO + (size_t)(l * 2 + 0) * DM * DFF * 2, DFF, 64, 4, 1, 22, Hb, modl + 2 * DM, (float*)(ws + WS_PART), P.x, 0.5f); SYNC();
        if (PROBE & 4) { norm_phase(P, F, l, 1, 0); SYNC(); }
        norm_phase(P, F, l, 1, 22); SYNC();
        if (l == 0) {
            GEMM(EpiEvenIn, ws + WS_A, ws + WS_EWIN, DM, 66, 8, 0, 0, (bf16_t*)(ws + WS_SB), (bf16_t*)(ws + WS_CX), (bf16_t*)(ws + WS_QAN), (bf16_t*)(ws + WS_KVAN), (bf16_t*)(ws + WS_EK), P.e_q_norm, P.e_kv_norm, (const f32x2*)(ws + WS_ROPE), (LAS float*)(F.lds + RING_BYTES + 1024));
            if (blockIdx.x >= 16) { Fr F2 = F; F2.lane = fresh_lane(); tr_items(P, F2, 1, ((int)blockIdx.x - 16) * NWAVES + F.wave, (F.G - 16) * NWAVES); }
            SYNC();
            if (F.G == 256) { if (blockIdx.x < 206) conv_even(P, F, 0, 11536, (int)blockIdx.x * NWAVES + F.wave, 206 * NWAVES); else conv_even(P, F, 11536, T, ((int)blockIdx.x - 206) * NWAVES + F.wave, 50 * NWAVES); }
            else conv_even(P, F, 0, T, F.gw, F.NGW);
            GEMM(EpiQb, ws + WS_QAN, ws + WS_EWQB, 256, 66, 3, 0, 0, (bf16_t*)(ws + WS_EQ), (const f32x2*)(ws + WS_ROPE));
            GEMM_ROT(58, EpiKVb, ws + WS_KVAN, ws + WS_EWKVB, 128, 66, 4, 0, 0, (bf16_t*)(ws + WS_EK), (bf16_t*)(ws + WS_EV));
            SYNC();
            for (int rep_ = 0; rep_ < ((PROBE & 1) ? 2 : 1); ++rep_) {
            { const bf16_t* Q = (const bf16_t*)(ws + WS_EQ); const bf16_t* K = (const bf16_t*)(ws + WS_EK); const bf16_t* V = (const bf16_t*)(ws + WS_EV); bf16_t* Y = (bf16_t*)(ws + WS_Y);
              for (int i = 0; i < 2; ++i) { const int u = 2 * F.vcu + i; if (u >= 512) break; const int bh = u >> 5, qb = u & 31, b = bh >> 3, h = bh & 7; const size_t r0 = (size_t)b * SEQT;
                  tat::attn_unit<8, 6, 768, 768, 512, DM>(Q + (r0 + qb * 256) * 768 + h * 96, K + r0 * 768 + h * 96, V + r0 * 512 + h * 64, Y + (r0 + qb * 256) * DM + 512 + h * 64, SEQT / 64, (char*)lds_raw, F.wave); }
              if ((F.vcu & 15) == 0 && F.vcu < 256) { const int bh = F.vcu >> 4, b = bh >> 3, h = bh & 7; const size_t r0 = (size_t)b * SEQT + SEQ;
                  tat::attn_unit<8, 6, 768, 768, 512, DM>(Q + r0 * 768 + h * 96, K + r0 * 768 + h * 96, V + r0 * 512 + h * 64, Y + r0 * DM + 512 + h * 64, CTXL / 64, (char*)lds_raw, F.wave); } }
            SYNC(); }
        if (PROBE & 8) { GEMM(EpiResidT<false>, ws + WS_Y, ws + WS_EWOUT, DM, 64, 4, 1, 8, Hb, modl + 5 * DM, (float*)(ws + WS_PART), P.x, 0.0f); SYNC(); }
            GEMM(EpiResidT<false>, ws + WS_Y, ws + WS_EWOUT, DM, 64, 4, 1, 8, Hb, modl + 5 * DM, (float*)(ws + WS_PART), P.x, 1.0f); SYNC();
        } else {
            GEMM(EpiOddQKV, ws + WS_A, ws + WS_OWIN, DM, 66, 7, 0, 0, (bf16_t*)(ws + WS_OQ), (bf16_t*)(ws + WS_OK), (bf16_t*)(ws + WS_OV), (bf16_t*)(ws + WS_G), P.o_q_norm, P.o_k_norm, (const f32x2*)(ws + WS_ROPE) + 2048, (LAS float*)(F.lds + RING_BYTES + 1024)); SYNC();
#ifndef NO_CONV
            conv_odd(P, F);
#endif
            for (int rep_ = 0; rep_ < ((PROBE & 1) ? 2 : 1); ++rep_) {
            { const bf16_t* Q = (const bf16_t*)(ws + WS_OQ); const bf16_t* K = (const bf16_t*)(ws + WS_OK); const bf16_t* V = (const bf16_t*)(ws + WS_OV); bf16_t* Y = (bf16_t*)(ws + WS_Y);
              for (int i = 0; i < 2; ++i) { const int u = 2 * F.vcu + i; if (u >= 512) break; const int bh = u >> 5, qb = u & 31, b = bh >> 3, h = bh & 7; const size_t r0 = (size_t)b * SEQT;
                  tat::attn_unit<8, 4, 512, 128, 128, DM>(Q + (r0 + qb * 256) * 512 + h * 64, K + r0 * 128 + (h >> 2) * 64, V + r0 * 128 + (h >> 2) * 64, Y + (r0 + qb * 256) * DM + h * 64, SEQT / 64, (char*)lds_raw, F.wave); } }
            SYNC(); }
        if (PROBE & 8) { GEMM(EpiResidT<false>, ws + WS_Y, ws + WS_OWOUT, DM, 64, 4, 1, 0, Hb, modl + 5 * DM, (float*)(ws + WS_PART), P.x, 0.0f); SYNC(); }
            GEMM(EpiResidT<false>, ws + WS_Y, ws + WS_OWOUT, DM, 64, 4, 1, 0, Hb, modl + 5 * DM, (float*)(ws + WS_PART), P.x, 1.0f); SYNC();
        }
        const int nml = (l == 1) ? 64 : 66, skipc = (l == 1) ? 1 : 0;
        if (PROBE & 4) { norm_phase(P, F, l, 2, 0); SYNC(); }
        norm_phase(P, F, l, 2, (l == 0) ? 8 : 0); SYNC();
        if (PROBE & 2) { GEMM(EpiSwiglu, ws + WS_A, ws + WS_WFI + (size_t)(l * 2 + 1) * NFI * DM * 2, DM, nml, 22, skipc, 0, (bf16_t*)(ws + WS_ACT)); SYNC(); }
        GEMM(EpiSwiglu, ws + WS_A, ws + WS_WFI + (size_t)(l * 2 + 1) * NFI * DM * 2, DM, nml, 22, skipc, 0, (bf16_t*)(ws + WS_ACT)); SYNC();
        if (PROBE & 8) { GEMM(EpiResidT<false>, ws + WS_ACT, ws + WS_WFO + (size_t)(l * 2 + 1) * DM * DFF * 2, DFF, 64, 4, 1, (l == 0 ? 22 : 0), Hb, modl + 8 * DM, (float*)(ws + WS_PART), P.x, 0.0f); SYNC(); }
        if (l == 0) { GEMM(EpiResidT<false>, ws + WS_ACT, ws + WS_WFO + (size_t)(l * 2 + 1) * DM * DFF * 2, DFF, 64, 4, 1, 22, Hb, modl + 8 * DM, (float*)(ws + WS_PART), P.x, 0.5f); SYNC(); }
        else { GEMM(EpiResidNorm<2>, ws + WS_ACT, ws + WS_WFO + (size_t)(l * 2 + 1) * DM * DFF * 2, DFF, 64, 4, 1, 0, Hb, modl + 8 * DM, (float*)(ws + WS_XBUF) + (size_t)T * 4, (unsigned*)(ws + WS_CTL) + 16384 + 8192, (LAS float*)(F.lds + RING_BYTES + 1024), (bf16_t*)(ws + WS_A), P.final_g, modl, P.out, 0.5f); }
        }
}

extern "C" void kernel_launch(void* const* d_in, const int* in_sizes, int n_in, void* d_out, int out_size, void* d_ws, size_t ws_size, hipStream_t stream) {
    static int grid = 0;
    if (grid == 0) {
        if (n_in != 25 || out_size != NB * SEQ * DM || ws_size < WS_END) { fprintf(stderr, "kernel_launch: unexpected shapes (n_in %d out %d ws %zu)\n", n_in, out_size, ws_size); grid = -1; return; }
        int dev = 0, cus = 0, per_cu = 0;
        hipGetDevice(&dev); hipDeviceGetAttribute(&cus, hipDeviceAttributeMultiprocessorCount, dev);
        if (hipFuncSetAttribute((const void*)hybrid_fwd, hipFuncAttributeMaxDynamicSharedMemorySize, LDS_BYTES) != hipSuccess) { fprintf(stderr, "kernel_launch: hipFuncSetAttribute failed\n"); grid = -1; return; }
        if (hipOccupancyMaxActiveBlocksPerMultiprocessor(&per_cu, (const void*)hybrid_fwd, NWAVES * 64, LDS_BYTES) != hipSuccess || per_cu < 1) { fprintf(stderr, "kernel_launch: occupancy query gives %d\n", per_cu); per_cu = 1; }
        (void)hipGetLastError();
        grid = cus * 1;
        fprintf(stderr, "kernel_launch: grid %d (per_cu %d)\n", grid, per_cu);
    }
    if (grid < 0) return;
    hipMemsetAsync((char*)d_ws + WS_CTL, 0, ZERO_BYTES, stream);
    Params p{};
    const float** pp = (const float**)&p;
    for (int i = 0; i < 25; ++i) pp[i] = (const float*)d_in[i];
    p.out = (float*)d_out; p.ws = (unsigned char*)d_ws;
    void* args[] = {&p};
    hipError_t e = hipLaunchCooperativeKernel((const void*)hybrid_fwd, dim3(grid), dim3(NWAVES * 64), args, LDS_BYTES, stream);
    if (e != hipSuccess) fprintf(stderr, "cooperative launch failed: %s (grid %d)\n", hipGetErrorString(e), grid);
}
```

```cpp
#include <hip/hip_runtime.h>
#include <hip/hip_cooperative_groups.h>
#include <cstdio>
#include <cstdint>
#include <cmath>
namespace cg = cooperative_groups;
__device__ __forceinline__ int fresh_lane() { int l; asm volatile("v_mbcnt_lo_u32_b32 %0, -1, 0\n\tv_mbcnt_hi_u32_b32 %0, -1, %0" : "=v"(l)); return l; }
__device__ __forceinline__ int fresh_wave() { return (int)__builtin_amdgcn_readfirstlane(threadIdx.x >> 6); }
namespace pg8 {
#define PG8_LAS __attribute__((address_space(3)))
typedef unsigned short bf16_t;
typedef short bf16x8 __attribute__((ext_vector_type(8)));
typedef float f32x4 __attribute__((ext_vector_type(4)));
typedef unsigned u32x4 __attribute__((ext_vector_type(4)));
constexpr int BM = 256, BK = 64, HALF = 128, HTB = HALF * BK * 2  , STAGE_BYTES = 8 * HTB, NXCD = 8, WGM = 8;

__host__ __device__ __forceinline__ int lds_byte(int r, int c) { const int st = (r >> 4) * 2 + (c >> 5), rr = r & 15, cc = c & 31, ob = rr * 64 + cc * 2; return st * 1024 + (ob ^ (((ob >> 9) & 1) << 5)); }
__host__ __device__ __forceinline__ void stage_rc(int b, int& R, int& C) { const int st = b / 1024, sb = b % 1024, swz = sb ^ (((sb >> 9) & 1) << 5); R = (st >> 1) * 16 + swz / 64; C = (st & 1) * 32 + (swz % 64) / 2; }
__host__ __device__ __forceinline__ int perm32(int rho) { const int n = rho >> 4, i = rho & 15; return 8 * (i >> 2) + 4 * n + (i & 3); }

struct Unit { int pm, pn, kx; };
struct Gemm { const bf16_t* A; const bf16_t* Bt; int M, N, K; };

struct Order {
    int nM, nN, nwg, G, c, skip, ntk, nsub, S;
    __device__ __forceinline__ void init(int nM_, int nN_, int G_, int c_, int skip_, int ntk_, int S_) { nM = nM_; nN = nN_; nwg = nM_ * nN_; G = G_; c = c_; skip = skip_; ntk = ntk_; S = S_; nsub = S_ ? 2 * nN_ * S_ : 0; }
    __device__ __forceinline__ bool next(int i, Unit& u) const {
        const long L = (long)i * G + c; if (L >= nwg + nsub) return false;
        if (L < nsub) { const int r = (int)L, s = r % S, tile = r / S; const int nts = ntk / S; u.pn = tile % nN; u.pm = 32 + 33 * (tile / nN); u.kx = (s * nts) | (nts << 8) | (1 << 16) | (s << 17); return true; }
        int wgid = (int)L - nsub; { const int q = nwg / NXCD, r = nwg % NXCD, xcd = wgid % NXCD, off = wgid / NXCD; wgid = (xcd < r ? xcd * (q + 1) : r * (q + 1) + (xcd - r) * q) + off; }
        const int nig = WGM * nN, gid = wgid / nig, fm = gid * WGM, gsz = (nM - fm) < WGM ? (nM - fm) : WGM;
        int pm = fm + ((wgid % nig) % gsz); if (skip) pm += pm >> 5;
        u.pm = pm; u.pn = (wgid % nig) / gsz; u.kx = ntk << 8; return true;
    }
    __device__ __forceinline__ void a_ready(const Unit&) const {}
    __device__ __forceinline__ void done(const Unit&) const {}
};
__device__ __forceinline__ unsigned cvt_pk_bf16(float lo, float hi) { unsigned r; asm volatile("v_cvt_pk_bf16_f32 %0, %1, %2" : "=v"(r) : "v"(lo), "v"(hi)); return r; }
template <class Epi, class Sched, bool ALIGN_EPI = false, bool SP2 = false>
__device__ __forceinline__ void gemm_phase(PG8_LAS unsigned char* lds, const Gemm g, const Sched& S, const Epi& E, const int wave_id) {
    const int wid = wave_id, lane = fresh_lane(), tid = wid * 64 + lane, wr = wid >> 2, wc = wid & 3, fr = lane & 15, fq = lane >> 4;
    const int K = g.K;
    unsigned voffA[2], voffB[2];
#pragma unroll
    for (int i = 0; i < 2; ++i) { int R, C; stage_rc(tid * 16 + i * 8192, R, C); const int Rb = Epi::PERM ? ((R & ~31) + perm32(R & 31)) : R;
        voffA[i] = (unsigned)(R * K + C) * 2u; voffB[i] = (unsigned)(Rb * K + C) * 2u; }
    const size_t kstep = (size_t)(BK * 2);
    const size_t hstep = (size_t)HALF * K * 2;
    const size_t tstep = 2 * hstep;
    const unsigned ldsw = (unsigned)wid * 1024u;
    const int aoff = lds_byte(wr * 64 + fr, fq * 8), boff = lds_byte(wc * 32 + fr, fq * 8);
#define PG8_SA(b, h) (((b) * 2 + (h)) * HTB)
#define PG8_SB(b, h) ((4 + (b) * 2 + (h)) * HTB)
#define PG8_STAGE(bufoff, gbase, voff) do { _Pragma("unroll") for (int _i = 0; _i < 2; ++_i) \
        __builtin_amdgcn_global_load_lds((const unsigned*)((const char*)(gbase) + (voff)[_i]), (PG8_LAS unsigned*)(lds + (bufoff) + ldsw + _i * 8192), 16, 0, 0); } while (0)
#define PG8_LDA(dst, b, h) do { _Pragma("unroll") for (int m = 0; m < 4; ++m) _Pragma("unroll") for (int k = 0; k < 2; ++k) dst[m][k] = *(const PG8_LAS bf16x8*)(lds + PG8_SA(b, h) + aoff + m * 2048 + k * 1024); } while (0)
#define PG8_LDB(dst, b, h) do { _Pragma("unroll") for (int n = 0; n < 2; ++n) _Pragma("unroll") for (int k = 0; k < 2; ++k) dst[n][k] = *(const PG8_LAS bf16x8*)(lds + PG8_SB(b, h) + boff + n * 2048 + k * 1024); } while (0)
#define PG8_MMA(ai, bj, At, Bt) do { __builtin_amdgcn_s_setprio(1); _Pragma("unroll") for (int m = 0; m < 4; ++m) _Pragma("unroll") for (int n = 0; n < 2; ++n) _Pragma("unroll") for (int k = 0; k < 2; ++k) \
        acc[ai][bj][m][n] = __builtin_amdgcn_mfma_f32_16x16x32_bf16(Bt[n][k], At[m][k], acc[ai][bj][m][n], 0, 0, 0); __builtin_amdgcn_s_setprio(0); } while (0)
#define PG8_WAIT_V(n) asm volatile("s_waitcnt vmcnt(" #n ")" ::: "memory")
#define PG8_WAIT_L(n) asm volatile("s_waitcnt lgkmcnt(" #n ")" ::: "memory")
#define PG8_BAR __builtin_amdgcn_s_barrier()
#define PG8_SCHED __builtin_amdgcn_sched_barrier(0)
    Unit cur, nxt; int ui = 0;
    if (!S.next(0, cur)) return;
    f32x4 acc[2][2][4][2];
#pragma unroll
    for (int a = 0; a < 2; ++a)
#pragma unroll
        for (int b = 0; b < 2; ++b)
#pragma unroll
            for (int m = 0; m < 4; ++m)
#pragma unroll
                for (int n = 0; n < 2; ++n) acc[a][b][m][n] = (f32x4){0.f, 0.f, 0.f, 0.f};
    bf16x8 At[4][2], B0[2][2], B1[2][2];
    const char* cA = (const char*)g.A + (size_t)cur.pm * tstep + (size_t)(cur.kx & 255) * kstep; const char* cB = (const char*)g.Bt + (size_t)cur.pn * tstep + (size_t)(cur.kx & 255) * kstep;
    S.a_ready(cur);
    if constexpr (SP2) {
        PG8_STAGE(PG8_SB(0, 0), cB, voffB); PG8_STAGE(PG8_SB(0, 1), cB + hstep, voffB); PG8_STAGE(PG8_SA(0, 0), cA, voffA); PG8_STAGE(PG8_SA(0, 1), cA + hstep, voffA);
        if (wr == 1) PG8_BAR;
        PG8_WAIT_V(2); PG8_BAR;
        PG8_STAGE(PG8_SB(1, 0), cB + kstep, voffB); PG8_STAGE(PG8_SA(1, 0), cA + kstep, voffA); PG8_STAGE(PG8_SB(1, 1), cB + hstep + kstep, voffB);
        PG8_WAIT_V(6); PG8_BAR;
    } else {
        PG8_STAGE(PG8_SB(0, 0), cB, voffB); PG8_STAGE(PG8_SA(0, 0), cA, voffA); PG8_STAGE(PG8_SB(0, 1), cB + hstep, voffB); PG8_STAGE(PG8_SA(0, 1), cA + hstep, voffA);
        if (wr == 1) PG8_BAR;
        PG8_WAIT_V(4); PG8_BAR;
        PG8_STAGE(PG8_SB(1, 0), cB + kstep, voffB); PG8_STAGE(PG8_SA(1, 0), cA + kstep, voffA); PG8_STAGE(PG8_SB(1, 1), cB + hstep + kstep, voffB);
        PG8_WAIT_V(6); PG8_BAR;
    }
    for (;;) {
        const bool has_next = S.next(ui + 1, nxt);
        const char* nA = has_next ? (const char*)g.A + (size_t)nxt.pm * tstep + (size_t)(nxt.kx & 255) * kstep : cA; const char* nB = has_next ? (const char*)g.Bt + (size_t)nxt.pn * tstep + (size_t)(nxt.kx & 255) * kstep : cB;
        const int nt = (cur.kx >> 8) & 255;
        for (int t = 0; t < nt; t += 2) {
            const bool last = (t == nt - 2);
            const char* a1 = cA + (size_t)(t + 1) * kstep;
            const char* a2 = last ? nA : cA + (size_t)(t + 2) * kstep; const char* b2 = last ? nB : cB + (size_t)(t + 2) * kstep;
            const char* a3 = a2 + kstep; const char* b3 = b2 + kstep;
            if (last && has_next) S.a_ready(nxt);
            if constexpr (SP2) {
            PG8_LDB(B0, 0, 0); PG8_LDB(B1, 0, 1); PG8_SCHED; PG8_LDA(At, 0, 0); PG8_STAGE(PG8_SA(1, 1), a1 + hstep, voffA);
            PG8_WAIT_V(8); PG8_WAIT_L(0); PG8_BAR; PG8_MMA(0, 0, At, B0); PG8_MMA(0, 1, At, B1); PG8_BAR; PG8_SCHED;
            PG8_LDA(At, 0, 1); PG8_STAGE(PG8_SB(0, 0), b2, voffB); PG8_STAGE(PG8_SB(0, 1), b2 + hstep, voffB); PG8_STAGE(PG8_SA(0, 0), a2, voffA);
            PG8_WAIT_V(8); PG8_WAIT_L(0); PG8_BAR; PG8_MMA(1, 0, At, B0); PG8_MMA(1, 1, At, B1); PG8_BAR; PG8_SCHED;
            PG8_LDB(B0, 1, 0); PG8_LDB(B1, 1, 1); PG8_SCHED; PG8_LDA(At, 1, 0); PG8_STAGE(PG8_SA(0, 1), a2 + hstep, voffA);
            PG8_WAIT_V(8); PG8_WAIT_L(0); PG8_BAR; PG8_MMA(0, 0, At, B0); PG8_MMA(0, 1, At, B1); PG8_BAR; PG8_SCHED;
            PG8_LDA(At, 1, 1); PG8_STAGE(PG8_SB(1, 0), b3, voffB); PG8_STAGE(PG8_SB(1, 1), b3 + hstep, voffB); PG8_STAGE(PG8_SA(1, 0), a3, voffA);
            PG8_WAIT_V(8); PG8_WAIT_L(0); PG8_BAR; PG8_MMA(1, 0, At, B0); PG8_MMA(1, 1, At, B1); PG8_BAR; PG8_SCHED;
            } else {
            PG8_LDB(B0, 0, 0); PG8_SCHED; PG8_LDA(At, 0, 0); PG8_STAGE(PG8_SA(1, 1), a1 + hstep, voffA);
            PG8_WAIT_L(8); PG8_BAR; PG8_WAIT_L(0); PG8_MMA(0, 0, At, B0); PG8_BAR; PG8_SCHED;
            PG8_LDB(B1, 0, 1); PG8_STAGE(PG8_SB(0, 0), b2, voffB);
            PG8_BAR; PG8_WAIT_L(0); PG8_MMA(0, 1, At, B1); PG8_BAR;
            PG8_LDA(At, 0, 1); PG8_STAGE(PG8_SA(0, 0), a2, voffA);
            PG8_BAR; PG8_WAIT_L(0); PG8_MMA(1, 0, At, B0); PG8_BAR; PG8_SCHED;
            PG8_STAGE(PG8_SB(0, 1), b2 + hstep, voffB);
            PG8_WAIT_V(6); PG8_BAR; PG8_MMA(1, 1, At, B1); PG8_BAR;
            PG8_LDB(B0, 1, 0); PG8_SCHED; PG8_LDA(At, 1, 0); PG8_STAGE(PG8_SA(0, 1), a2 + hstep, voffA);
            PG8_WAIT_L(8); PG8_BAR; PG8_WAIT_L(0); PG8_MMA(0, 0, At, B0); PG8_BAR; PG8_SCHED;
            PG8_LDB(B1, 1, 1); PG8_STAGE(PG8_SB(1, 0), b3, voffB);
            PG8_BAR; PG8_WAIT_L(0); PG8_MMA(0, 1, At, B1); PG8_BAR;
            PG8_LDA(At, 1, 1); PG8_STAGE(PG8_SA(1, 0), a3, voffA);
            PG8_BAR; PG8_WAIT_L(0); PG8_MMA(1, 0, At, B0); PG8_BAR; PG8_SCHED;
            PG8_STAGE(PG8_SB(1, 1), b3 + hstep, voffB);
            PG8_WAIT_V(6); PG8_BAR; PG8_MMA(1, 1, At, B1); PG8_BAR;
            }
        }
        if constexpr (ALIGN_EPI) { if (wr == 0) PG8_BAR; }
        if constexpr (!Epi::AFTER_DRAIN) { E(acc, cur, wr, wc, fr, fq); S.done(cur); }
        if (!has_next) break;
#pragma unroll
        for (int a = 0; a < 2; ++a)
#pragma unroll
            for (int b = 0; b < 2; ++b)
#pragma unroll
                for (int m = 0; m < 4; ++m)
#pragma unroll
                    for (int n = 0; n < 2; ++n) acc[a][b][m][n] = (f32x4){0.f, 0.f, 0.f, 0.f};
        cur = nxt; cA = nA; cB = nB; ++ui;
        if constexpr (ALIGN_EPI) { if (wr == 1) PG8_BAR; }
    }
    PG8_WAIT_V(0);
    if constexpr (!ALIGN_EPI) { if (wr == 0) PG8_BAR; }
    PG8_BAR;
    if constexpr (Epi::AFTER_DRAIN) { E.fused(acc, cur, wr, wc, fr, fq, lds, wid, lane); S.done(cur); }
#undef PG8_SA
#undef PG8_SB
#undef PG8_STAGE
#undef PG8_LDA
#undef PG8_LDB
#undef PG8_MMA
#undef PG8_WAIT_V
#undef PG8_WAIT_L
#undef PG8_BAR
#undef PG8_SCHED
}
}

#define LAS __attribute__((address_space(3)))
typedef unsigned short bf16_t;
typedef float f32x4 __attribute__((ext_vector_type(4)));
typedef float f32x2 __attribute__((ext_vector_type(2)));
typedef float f32x16 __attribute__((ext_vector_type(16)));
typedef short bf16x8 __attribute__((ext_vector_type(8)));
typedef short s16x4 __attribute__((ext_vector_type(4)));
typedef unsigned u32x4 __attribute__((ext_vector_type(4)));
typedef unsigned u32x2 __attribute__((ext_vector_type(2)));
typedef __bf16 bf16x2_t __attribute__((ext_vector_type(2)));

constexpr int DM = 1024, NB = 2, SEQ = 8192, CTXL = 256, SEQT = SEQ + CTXL, T = NB * SEQT;
constexpr int DFF = 2816, NFI = 2 * DFF;
constexpr int E_IN = 1952, E_INP = 2048, O_IN = 1792;
constexpr float EPS = 1e-6f;
constexpr float LOG2E = 1.4426950408889634f;
constexpr float C2_MLA = 0.10206207261596575f * LOG2E;
constexpr float C2_GQA = 0.125f * LOG2E;
constexpr int NWAVES = 8;

constexpr size_t MiB = 1u << 20;
constexpr size_t WS_XBUF = 256 * 1024  ;
constexpr size_t WS_CTL = 0, WS_MOD = 1 * MiB, WS_ROPE = 1 * MiB + 512 * 1024, ZERO_BYTES = 2 * MiB;
constexpr size_t WS_WFI = 2 * MiB, WS_WFO = 46 * MiB, WS_EWIN = 68 * MiB, WS_EWQB = 72 * MiB, WS_EWKVB = 73 * MiB, WS_EWOUT = 74 * MiB, WS_OWIN = 76 * MiB, WS_OWOUT = 80 * MiB;
constexpr size_t WS_H = 82 * MiB, WS_A = 148 * MiB, WS_SCR = 181 * MiB;
constexpr size_t WS_ACT = WS_SCR, WS_P = WS_SCR, WS_EQ = 181 * MiB, WS_EK = 206 * MiB, WS_EV = 231 * MiB, WS_Y = 248 * MiB;
constexpr size_t WS_QAN = 281 * MiB, WS_KVAN = 290 * MiB, WS_KR = 295 * MiB, WS_G = 281 * MiB, WS_OQ = 298 * MiB, WS_OK = 315 * MiB, WS_OV = 320 * MiB, WS_SB = 300 * MiB  , WS_CX = 317 * MiB, WS_PART = 300 * MiB  , WS_END = 344 * MiB;
static_assert(WS_WFI + 4 * (size_t)NFI * DM * 2 <= WS_WFO && WS_WFO + 4 * (size_t)DM * DFF * 2 <= WS_EWIN, "ws map");
static_assert(WS_H + (size_t)T * DM * 4 <= WS_A && WS_A + (size_t)T * DM * 2 <= WS_SCR && WS_ACT + (size_t)T * DFF * 2 <= WS_QAN, "ws map");
static_assert(WS_EQ + (size_t)T * 768 * 2 <= WS_EK && WS_EK + (size_t)T * 768 * 2 <= WS_EV && WS_EV + (size_t)T * 512 * 2 <= WS_Y && WS_Y + (size_t)T * DM * 2 <= WS_QAN, "ws map");
static_assert(WS_QAN + (size_t)T * 256 * 2 <= WS_KVAN && WS_KVAN + (size_t)T * 128 * 2 <= WS_KR && WS_KR + (size_t)T * 32 * 2 <= WS_OQ && WS_G + (size_t)T * 512 * 2 <= WS_OQ, "ws map");
static_assert(WS_OQ + (size_t)T * 512 * 2 <= WS_OK && WS_OK + (size_t)T * 128 * 2 <= WS_OV && WS_OV + (size_t)T * 128 * 2 <= WS_END && WS_P + (size_t)T * 2048 * 2 <= WS_Y, "ws map");

constexpr int RING_BYTES = 131072, LDS_BYTES = 147456;

struct Params {
    const float *x, *c, *ctx, *c_ctx, *w_mod, *b_mod, *norm_g, *w_ffn_in, *w_ffn_out;
    const float *e_w_in, *e_conv_w, *e_q_norm, *e_w_q_b, *e_kv_norm, *e_w_kv_b, *e_w_out;
    const float *o_w_in, *o_q_norm, *o_k_norm, *o_conv_w, *o_conv_b, *o_ln_g, *o_ln_b, *o_w_out, *final_g;
    float* out; unsigned char* ws;
};

__device__ __forceinline__ unsigned f2bf(float f) { unsigned u = __builtin_bit_cast(unsigned, f); return (u + 0x7fffu + ((u >> 16) & 1u)) >> 16; }
__device__ __forceinline__ unsigned pk2(float lo, float hi) { f32x2 v = {lo, hi}; bf16x2_t b = __builtin_convertvector(v, bf16x2_t); return __builtin_bit_cast(unsigned, b); }
__device__ __forceinline__ float bf_lo(unsigned w) { return __builtin_bit_cast(float, w << 16); }
__device__ __forceinline__ float bf_hi(unsigned w) { return __builtin_bit_cast(float, w & 0xffff0000u); }
__device__ __forceinline__ void unpack8(const u32x4 w, float (&f)[8]) { f[0] = bf_lo(w.x); f[1] = bf_hi(w.x); f[2] = bf_lo(w.y); f[3] = bf_hi(w.y); f[4] = bf_lo(w.z); f[5] = bf_hi(w.z); f[6] = bf_lo(w.w); f[7] = bf_hi(w.w); }
__device__ __forceinline__ u32x4 pack8(const float (&f)[8]) { u32x4 w; w.x = pk2(f[0], f[1]); w.y = pk2(f[2], f[3]); w.z = pk2(f[4], f[5]); w.w = pk2(f[6], f[7]); return w; }
template <int PAT> __device__ __forceinline__ float swz(float v) { return __builtin_bit_cast(float, __builtin_amdgcn_ds_swizzle(__builtin_bit_cast(int, v), PAT)); }
__device__ __forceinline__ float wave_sum(float v) {
    v += swz<0x041F>(v); v += swz<0x081F>(v); v += swz<0x101F>(v); v += swz<0x201F>(v); v += swz<0x401F>(v);
    auto rr = __builtin_amdgcn_permlane32_swap(__float_as_uint(v), __float_as_uint(v), false, false); return __uint_as_float(rr[0]) + __uint_as_float(rr[1]);
}
__device__ __forceinline__ float rdlane(float v, int k) { return __builtin_bit_cast(float, __builtin_amdgcn_readlane(__builtin_bit_cast(int, v), k)); }
__device__ __forceinline__ float silu_f(float v) { return v * __builtin_amdgcn_rcpf(1.f + __builtin_amdgcn_exp2f(-1.4426950408889634f * v)); }
__device__ __forceinline__ float sigmoid_f(float v) { return __builtin_amdgcn_rcpf(1.f + __builtin_amdgcn_exp2f(-1.4426950408889634f * v)); }
__device__ __forceinline__ int row_mi(int pm) { const int b = pm / 33; return (pm - b * 33 == 32) ? 2 : b; }

using pg8::Unit; using pg8::BM; using pg8::HALF;
#define EPI_FENCE() asm volatile("" ::: "memory")
template <int LDC> struct EpiStoreT {
    static constexpr bool PERM = true, AFTER_DRAIN = false;
    bf16_t* O;
    __device__ __forceinline__ void operator()(const f32x4 (&acc)[2][2][4][2], const Unit& u, int wr, int wc, int fr_, int fq_) const {
        int fr = fr_, fq = fq_; asm volatile("" : "+v"(fr), "+v"(fq));
        const unsigned off0 = (unsigned)(u.pm * BM + wr * 64 + fr) * LDC + (unsigned)(u.pn * BM + wc * 32 + 8 * fq);
#pragma unroll
        for (int ai = 0; ai < 2; ++ai)
#pragma unroll
            for (int m = 0; m < 4; ++m) { const unsigned off = off0 + (unsigned)(ai * HALF + m * 16) * LDC;
#pragma unroll
                for (int bj = 0; bj < 2; ++bj) { const f32x4 v0 = acc[ai][bj][m][0], v1 = acc[ai][bj][m][1]; u32x4 w; w.x = pk2(v0[0], v0[1]); w.y = pk2(v0[2], v0[3]); w.z = pk2(v1[0], v1[1]); w.w = pk2(v1[2], v1[3]);
                    *(u32x4*)(O + off + bj * HALF) = w; }
                EPI_FENCE(); }
    }
};
struct EpiSwiglu {
    static constexpr bool PERM = true, AFTER_DRAIN = false;
    bf16_t* O;
    __device__ __forceinline__ void operator()(const f32x4 (&acc)[2][2][4][2], const Unit& u, int wr, int wc, int fr_, int fq_) const {
        int fr = fr_, fq = fq_; asm volatile("" : "+v"(fr), "+v"(fq));
        const unsigned off0 = (unsigned)(u.pm * BM + wr * 64 + fr) * DFF + (unsigned)(u.pn * HALF + wc * 32 + 8 * fq);
#pragma unroll
        for (int ai = 0; ai < 2; ++ai)
#pragma unroll
            for (int m = 0; m < 4; ++m) { const unsigned off = off0 + (unsigned)(ai * HALF + m * 16) * DFF;
                float r[8];
#pragma unroll
                for (int n = 0; n < 2; ++n)
#pragma unroll
                    for (int e = 0; e < 4; ++e) { const float g = acc[ai][0][m][n][e], up = acc[ai][1][m][n][e]; r[n * 4 + e] = (g * up) * __builtin_amdgcn_rcpf(1.f + __builtin_amdgcn_exp2f(g)); }
                *(u32x4*)(O + off) = pack8(r); EPI_FENCE(); }
    }
};
__device__ __forceinline__ void ld8(const bf16_t* p, float (&f)[8]);
__device__ __forceinline__ void ldf8(const float* p, float (&f)[8]);
template <bool FIRST> struct EpiResidT {
    static constexpr bool PERM = true, AFTER_DRAIN = false;
    bf16_t* H; const float* gate  ; float* part; const float* xin; float coef;
    __device__ __forceinline__ void operator()(const f32x4 (&acc)[2][2][4][2], const Unit& u, int wr, int wc, int fr_, int fq_) const {
        int fr = fr_, fq = fq_; asm volatile("" : "+v"(fr), "+v"(fq));
        const unsigned colp = (unsigned)(u.pn * BM + wc * 32 + 8 * fq), rloc = (unsigned)(wr * 64 + fr);
        const float* gp = gate + (unsigned)row_mi(u.pm) * 9 * DM + colp;
        const unsigned xrow0 = (unsigned)((u.pm / 33) * SEQ + (u.pm % 33) * BM);
#pragma unroll
        for (int bj = 0; bj < 2; ++bj) { const f32x4 gv0 = *(const f32x4*)(gp + bj * HALF) * coef, gv1 = *(const f32x4*)(gp + bj * HALF + 4) * coef;
            if (u.kx >> 16) {
                float* pb = part + ((size_t)(u.kx >> 17) * 512 + (u.pm == 65 ? 256 : 0) + rloc) * DM + colp + bj * HALF;
#pragma unroll
                for (int ai = 0; ai < 2; ++ai)
#pragma unroll
                    for (int m = 0; m < 4; ++m) { float* p = pb + (unsigned)(ai * HALF + m * 16) * DM; *(f32x4*)p = gv0 * acc[ai][bj][m][0]; *(f32x4*)(p + 4) = gv1 * acc[ai][bj][m][1]; }
            } else {
                f32x4 hx[FIRST ? 8 : 1][2]; u32x4 hb[FIRST ? 1 : 8];
#pragma unroll
                for (int ai = 0; ai < 2; ++ai)
#pragma unroll
                    for (int m = 0; m < 4; ++m) { const unsigned rr = rloc + (unsigned)(ai * HALF + m * 16);
                        if (FIRST) { const float* xp = xin + (size_t)(xrow0 + rr) * DM + colp + bj * HALF; hx[FIRST ? ai * 4 + m : 0][0] = *(const f32x4*)xp; hx[FIRST ? ai * 4 + m : 0][1] = *(const f32x4*)(xp + 4); }
                        else hb[FIRST ? 0 : ai * 4 + m] = *(const u32x4*)(H + (size_t)((unsigned)u.pm * BM + rr) * DM + colp + bj * HALF); }
#pragma unroll
                for (int ai = 0; ai < 2; ++ai)
#pragma unroll
                    for (int m = 0; m < 4; ++m) { const unsigned rr = rloc + (unsigned)(ai * HALF + m * 16); float h[8];
                        if (FIRST) { const f32x4 x0 = hx[FIRST ? ai * 4 + m : 0][0], x1 = hx[FIRST ? ai * 4 + m : 0][1]; h[0] = x0[0]; h[1] = x0[1]; h[2] = x0[2]; h[3] = x0[3]; h[4] = x1[0]; h[5] = x1[1]; h[6] = x1[2]; h[7] = x1[3]; }
                        else unpack8(hb[FIRST ? 0 : ai * 4 + m], h);
                        const f32x4 d0 = gv0 * acc[ai][bj][m][0], d1 = gv1 * acc[ai][bj][m][1];
                        h[0] += d0[0]; h[1] += d0[1]; h[2] += d0[2]; h[3] += d0[3]; h[4] += d1[0]; h[5] += d1[1]; h[6] += d1[2]; h[7] += d1[3];
                        *(u32x4*)(H + (size_t)((unsigned)u.pm * BM + rr) * DM + colp + bj * HALF) = pack8(h); }
            }
            EPI_FENCE(); }
    }
};
struct EpiOddIn {
    static constexpr bool PERM = true, AFTER_DRAIN = false;
    bf16_t* O; bf16_t* G;
    __device__ __forceinline__ void operator()(const f32x4 (&acc)[2][2][4][2], const Unit& u, int wr, int wc, int fr_, int fq_) const {
        int fr = fr_, fq = fq_; asm volatile("" : "+v"(fr), "+v"(fq));
        const unsigned row0 = (unsigned)(u.pm * BM + wr * 64 + fr);
        if (u.pn < 3) {
            const unsigned off0 = row0 * 768u + (unsigned)(u.pn * BM + wc * 32 + 8 * fq);
#pragma unroll
            for (int ai = 0; ai < 2; ++ai)
#pragma unroll
                for (int m = 0; m < 4; ++m) { const unsigned off = off0 + (unsigned)(ai * HALF + m * 16) * 768u;
#pragma unroll
                    for (int bj = 0; bj < 2; ++bj) { const f32x4 v0 = acc[ai][bj][m][0], v1 = acc[ai][bj][m][1]; u32x4 w; w.x = pk2(v0[0], v0[1]); w.y = pk2(v0[2], v0[3]); w.z = pk2(v1[0], v1[1]); w.w = pk2(v1[2], v1[3]);
                        *(u32x4*)(O + off + bj * HALF) = w; }
                    EPI_FENCE(); }
        } else {
            const unsigned off0 = row0 * 512u + (unsigned)((u.pn - 3) * HALF + wc * 32 + 8 * fq);
#pragma unroll
            for (int ai = 0; ai < 2; ++ai)
#pragma unroll
                for (int m = 0; m < 4; ++m) { const unsigned off = off0 + (unsigned)(ai * HALF + m * 16) * 512u; float r[8];
#pragma unroll
                    for (int n = 0; n < 2; ++n)
#pragma unroll
                        for (int e = 0; e < 4; ++e) r[n * 4 + e] = acc[ai][0][m][n][e] * sigmoid_f(acc[ai][1][m][n][e]);
                    *(u32x4*)(G + off) = pack8(r); EPI_FENCE(); }
        }
    }
};
struct EpiOddQKV {
    static constexpr bool PERM = true, AFTER_DRAIN = false;
    bf16_t *Q, *K, *V, *G; const float *gq, *gk; const f32x2* rope  ; LAS float* xch;
    __device__ __forceinline__ void operator()(const f32x4 (&acc)[2][2][4][2], const Unit& u, int wr, int wc, int fr_, int fq_) const {
        int fr = fr_, fq = fq_; asm volatile("" : "+v"(fr), "+v"(fq));
        const unsigned row0 = (unsigned)(u.pm * BM + wr * 64 + fr);
        if (u.pn >= 3) {
            const unsigned off0 = row0 * 512u + (unsigned)((u.pn - 3) * HALF + wc * 32 + 8 * fq);
#pragma unroll
            for (int ai = 0; ai < 2; ++ai)
#pragma unroll
                for (int m = 0; m < 4; ++m) { const unsigned off = off0 + (unsigned)(ai * HALF + m * 16) * 512u; float r[8];
#pragma unroll
                    for (int n = 0; n < 2; ++n)
#pragma unroll
                        for (int e = 0; e < 4; ++e) r[n * 4 + e] = acc[ai][0][m][n][e] * sigmoid_f(acc[ai][1][m][n][e]);
                    *(u32x4*)(G + off) = pack8(r); EPI_FENCE(); }
            return;
        }
        const int wid = wr * 4 + wc;
        float ps[2][4][2];
#pragma unroll
        for (int ai = 0; ai < 2; ++ai)
#pragma unroll
            for (int m = 0; m < 4; ++m)
#pragma unroll
                for (int bj = 0; bj < 2; ++bj) { const f32x4 a = acc[ai][bj][m][0], b = acc[ai][bj][m][1];
                    float s_ = (a[0] * a[0] + a[1] * a[1]) + (a[2] * a[2] + a[3] * a[3]) + (b[0] * b[0] + b[1] * b[1]) + (b[2] * b[2] + b[3] * b[3]);
                    s_ += swz<0x401F>(s_);
                    { auto rr = __builtin_amdgcn_permlane32_swap(__float_as_uint(s_), __float_as_uint(s_), false, false); s_ = __uint_as_float(rr[0]) + __uint_as_float(rr[1]); }
                    ps[ai][m][bj] = s_;
                    if (fq == 0) xch[(((wid * 2 + ai) * 4 + m) * 2 + bj) * 16 + fr] = s_; }
        asm volatile("s_waitcnt lgkmcnt(0)\n\ts_barrier" ::: "memory");
        const int pw_ = wr * 4 + (wc ^ 1);
        const bool lat = (u.pm % 33) != 32; const int t0 = (int)row0 - (u.pm / 33) * SEQT;
        const int d0 = 32 * (wc & 1) + 8 * fq;
        float gqv[8], gkv[8];
        { const f32x4 x0 = *(const f32x4*)(gq + d0), x1 = *(const f32x4*)(gq + d0 + 4), y0 = *(const f32x4*)(gk + d0), y1 = *(const f32x4*)(gk + d0 + 4);
#pragma unroll
          for (int e = 0; e < 4; ++e) { gqv[e] = x0[e]; gqv[4 + e] = x1[e]; gkv[e] = y0[e]; gkv[4 + e] = y1[e]; } }
#pragma unroll
        for (int ai = 0; ai < 2; ++ai)
#pragma unroll
            for (int m = 0; m < 4; ++m) { const unsigned rr_ = (unsigned)(ai * HALF + m * 16); const int t = t0 + (int)rr_;
                f32x4 c01 = {1.f, 0.f, 1.f, 0.f}, c23 = {1.f, 0.f, 1.f, 0.f};
                if (lat) { const int pos = (wc & 1) ? (t & 63) : (t >> 6); const f32x4* rp = (const f32x4*)(rope + pos * 16 + 4 * fq); c01 = rp[0]; c23 = rp[1]; }
#pragma unroll
                for (int bj = 0; bj < 2; ++bj) { const f32x4 a = acc[ai][bj][m][0], b = acc[ai][bj][m][1];
                    float v[8] = {a[0], a[1], a[2], a[3], b[0], b[1], b[2], b[3]};
                    if (u.pn == 2 && bj == 1) {
                        *(u32x4*)(V + (size_t)(row0 + rr_) * 128 + wc * 32 + 8 * fq) = pack8(v); continue; }
                    const float tot = ps[ai][m][bj] + xch[(((pw_ * 2 + ai) * 4 + m) * 2 + bj) * 16 + fr];
                    const float rstd = 1.f / sqrtf(tot * (1.f / 64.f) + EPS);
                    const bool isq = (u.pn < 2); const float sc_ = isq ? C2_GQA : 1.f;
                    float o[8];
#pragma unroll
                    for (int p = 0; p < 4; ++p) { const float x0 = v[2 * p] * rstd * (isq ? gqv[2 * p] : gkv[2 * p]), x1 = v[2 * p + 1] * rstd * (isq ? gqv[2 * p + 1] : gkv[2 * p + 1]);
                        const float cs = (p < 2) ? c01[2 * p] : c23[2 * p - 4], sn = (p < 2) ? c01[2 * p + 1] : c23[2 * p - 3];
                        o[2 * p] = (x0 * cs - x1 * sn) * sc_; o[2 * p + 1] = (x0 * sn + x1 * cs) * sc_; }
                    if (isq) *(u32x4*)(Q + (size_t)(row0 + rr_) * 512 + u.pn * BM + bj * HALF + wc * 32 + 8 * fq) = pack8(o);
                    else *(u32x4*)(K + (size_t)(row0 + rr_) * 128 + wc * 32 + 8 * fq) = pack8(o); }
                EPI_FENCE(); }
    }
};
struct EpiEvenIn {
    static constexpr bool PERM = true, AFTER_DRAIN = false;
    bf16_t *SB, *CX, *QAN, *KVAN, *KR; const float *gq, *gkv; const f32x2* rope  ; LAS float* xch;
    __device__ __forceinline__ void operator()(const f32x4 (&acc)[2][2][4][2], const Unit& u, int wr, int wc, int fr_, int fq_) const {
        int fr = fr_, fq = fq_; asm volatile("" : "+v"(fr), "+v"(fq));
        const unsigned row0 = (unsigned)(u.pm * BM + wr * 64 + fr);
        if (u.pn < 2) {
            const unsigned off0 = row0 * 512u + (unsigned)(u.pn * BM + wc * 32 + 8 * fq);
#pragma unroll
            for (int ai = 0; ai < 2; ++ai)
#pragma unroll
                for (int m = 0; m < 4; ++m) { const unsigned off = off0 + (unsigned)(ai * HALF + m * 16) * 512u;
#pragma unroll
                    for (int bj = 0; bj < 2; ++bj) { const f32x4 v0 = acc[ai][bj][m][0], v1 = acc[ai][bj][m][1]; u32x4 w; w.x = pk2(v0[0], v0[1]); w.y = pk2(v0[2], v0[3]); w.z = pk2(v1[0], v1[1]); w.w = pk2(v1[2], v1[3]);
                        *(u32x4*)(SB + off + bj * HALF) = w; }
                    EPI_FENCE(); }
            return;
        }
        if (u.pn < 6) {
            const unsigned off0 = row0 * 512u + (unsigned)((u.pn - 2) * HALF + wc * 32 + 8 * fq);
#pragma unroll
            for (int ai = 0; ai < 2; ++ai)
#pragma unroll
                for (int m = 0; m < 4; ++m) { const unsigned off = off0 + (unsigned)(ai * HALF + m * 16) * 512u; float r[8];
#pragma unroll
                    for (int n = 0; n < 2; ++n)
#pragma unroll
                        for (int e = 0; e < 4; ++e) r[n * 4 + e] = acc[ai][0][m][n][e] * acc[ai][1][m][n][e];
                    *(u32x4*)(CX + off) = pack8(r); EPI_FENCE(); }
            return;
        }
        const bool isq = (u.pn == 6);
        const int wid = wr * 4 + wc;
        float ps[2][4];
#pragma unroll
        for (int ai = 0; ai < 2; ++ai)
#pragma unroll
            for (int m = 0; m < 4; ++m) { float s_ = 0.f;
#pragma unroll
                for (int bj = 0; bj < 2; ++bj) { if (bj == 1 && !isq) continue; const f32x4 a = acc[ai][bj][m][0], b = acc[ai][bj][m][1];
                    s_ += (a[0] * a[0] + a[1] * a[1]) + (a[2] * a[2] + a[3] * a[3]) + (b[0] * b[0] + b[1] * b[1]) + (b[2] * b[2] + b[3] * b[3]); }
                s_ += swz<0x401F>(s_);
                { auto rr = __builtin_amdgcn_permlane32_swap(__float_as_uint(s_), __float_as_uint(s_), false, false); s_ = __uint_as_float(rr[0]) + __uint_as_float(rr[1]); }
                ps[ai][m] = s_;
                if (fq == 0) xch[((wid * 2 + ai) * 4 + m) * 16 + fr] = s_; }
        asm volatile("s_waitcnt lgkmcnt(0)\n\ts_barrier" ::: "memory");
        const bool lat = (u.pm % 33) != 32; const int t0 = (int)row0 - (u.pm / 33) * SEQT;
        const float invn = isq ? (1.f / 256.f) : (1.f / 128.f);
        const float* gp = (isq ? gq : gkv) + wc * 32 + 8 * fq;
#pragma unroll
        for (int ai = 0; ai < 2; ++ai)
#pragma unroll
            for (int m = 0; m < 4; ++m) { const unsigned rr_ = (unsigned)(ai * HALF + m * 16);
                float tot = 0.f;
#pragma unroll
                for (int w4 = 0; w4 < 4; ++w4) tot += xch[(((wr * 4 + w4) * 2 + ai) * 4 + m) * 16 + fr];
                const float rstd = 1.f / sqrtf(tot * invn + EPS);
#pragma unroll
                for (int bj = 0; bj < 2; ++bj) { const f32x4 a = acc[ai][bj][m][0], b = acc[ai][bj][m][1];
                    if (isq || bj == 0) {
                        const f32x4 g0 = *(const f32x4*)(gp + bj * HALF), g1 = *(const f32x4*)(gp + bj * HALF + 4);
                        float o[8] = {a[0] * rstd * g0[0], a[1] * rstd * g0[1], a[2] * rstd * g0[2], a[3] * rstd * g0[3], b[0] * rstd * g1[0], b[1] * rstd * g1[1], b[2] * rstd * g1[2], b[3] * rstd * g1[3]};
                        if (isq) *(u32x4*)(QAN + (size_t)(row0 + rr_) * 256 + bj * HALF + wc * 32 + 8 * fq) = pack8(o);
                        else *(u32x4*)(KVAN + (size_t)(row0 + rr_) * 128 + wc * 32 + 8 * fq) = pack8(o);
                    } else if (wc == 0) {
                        const int t = t0 + (int)rr_;
                        f32x4 c01 = {1.f, 0.f, 1.f, 0.f}, c23 = {1.f, 0.f, 1.f, 0.f};
                        if (lat) { const int pos = (fq < 2) ? (t >> 6) : (t & 63); const f32x4* rp = (const f32x4*)(rope + pos * 16 + 4 * (fq & 1)); c01 = rp[0]; c23 = rp[1]; }
                        float o[8] = {a[0] * c01[0] - a[1] * c01[1], a[0] * c01[1] + a[1] * c01[0], a[2] * c01[2] - a[3] * c01[3], a[2] * c01[3] + a[3] * c01[2],
                                      b[0] * c23[0] - b[1] * c23[1], b[0] * c23[1] + b[1] * c23[0], b[2] * c23[2] - b[3] * c23[3], b[2] * c23[3] + b[3] * c23[2]};
                        const u32x4 kw = pack8(o); bf16_t* kp = KR + (size_t)(row0 + rr_) * 768 + 64 + 8 * fq;
#pragma unroll
                        for (int h = 0; h < 8; ++h) *(u32x4*)(kp + h * 96) = kw; } }
                EPI_FENCE(); }
    }
};
template <int MODE> struct EpiResidNorm {
    static constexpr bool PERM = true, AFTER_DRAIN = false;
    bf16_t* H; const float* gate; float* xbuf; unsigned* cnt; LAS float* xch; bf16_t* A; const float* ng; const float* modsh; float* out; float coef;
    __device__ __forceinline__ void operator()(f32x4 (&acc)[2][2][4][2], const Unit& u, int wr, int wc, int fr_, int fq_) const {
        int fr = fr_, fq = fq_; asm volatile("" : "+v"(fr), "+v"(fq));
        const unsigned colp = (unsigned)(u.pn * BM + wc * 32 + 8 * fq), rloc = (unsigned)(wr * 64 + fr);
        const int mi = row_mi(u.pm), wid = wr * 4 + wc;
        const float* gp = gate + (unsigned)mi * 9 * DM + colp;
        float ps[2][4];
#pragma unroll
        for (int ai = 0; ai < 2; ++ai)
#pragma unroll
            for (int m = 0; m < 4; ++m) ps[ai][m] = 0.f;
#pragma unroll
        for (int bj = 0; bj < 2; ++bj) { const f32x4 gv0 = *(const f32x4*)(gp + bj * HALF) * coef, gv1 = *(const f32x4*)(gp + bj * HALF + 4) * coef;
#pragma unroll
            for (int ai = 0; ai < 2; ++ai) { u32x4 hb[4];
#pragma unroll
                for (int m = 0; m < 4; ++m) hb[m] = *(const u32x4*)(H + (((unsigned)u.pm * BM + rloc + (unsigned)(ai * HALF + m * 16)) * DM + colp + bj * HALF));
#pragma unroll
                for (int m = 0; m < 4; ++m) { float h[8]; unpack8(hb[m], h);
                    const f32x4 d0 = gv0 * acc[ai][bj][m][0], d1 = gv1 * acc[ai][bj][m][1];
                    const f32x4 h0 = {h[0] + d0[0], h[1] + d0[1], h[2] + d0[2], h[3] + d0[3]}, h1 = {h[4] + d1[0], h[5] + d1[1], h[6] + d1[2], h[7] + d1[3]};
                    acc[ai][bj][m][0] = h0; acc[ai][bj][m][1] = h1;
                    ps[ai][m] += (h0[0] * h0[0] + h0[1] * h0[1]) + (h0[2] * h0[2] + h0[3] * h0[3]) + (h1[0] * h1[0] + h1[1] * h1[1]) + (h1[2] * h1[2] + h1[3] * h1[3]); }
                EPI_FENCE(); }
            EPI_FENCE(); }
#pragma unroll
        for (int ai = 0; ai < 2; ++ai)
#pragma unroll
            for (int m = 0; m < 4; ++m) { float s_ = ps[ai][m]; s_ += swz<0x401F>(s_);
                { auto rr = __builtin_amdgcn_permlane32_swap(__float_as_uint(s_), __float_as_uint(s_), false, false); s_ = __uint_as_float(rr[0]) + __uint_as_float(rr[1]); }
                if (fq == 0) xch[((wid * 2 + ai) * 4 + m) * 16 + fr] = s_; }
        asm volatile("s_waitcnt lgkmcnt(0)\n\ts_barrier" ::: "memory");
        if (wc == 0 && fq == 0) {
#pragma unroll
            for (int ai = 0; ai < 2; ++ai)
#pragma unroll
                for (int m = 0; m < 4; ++m) { float tot = 0.f;
#pragma unroll
                    for (int w4 = 0; w4 < 4; ++w4) tot += xch[(((wr * 4 + w4) * 2 + ai) * 4 + m) * 16 + fr];
                    __hip_atomic_store(xbuf + (((unsigned)u.pm * BM + rloc + (unsigned)(ai * HALF + m * 16)) * 4u + (unsigned)u.pn), tot, __ATOMIC_RELAXED, __HIP_MEMORY_SCOPE_AGENT); } }
        asm volatile("s_waitcnt vmcnt(0) lgkmcnt(0)\n\ts_barrier" ::: "memory");
        if (wid == 0) {
            if (fr == 0 && fq == 0) __hip_atomic_fetch_add(cnt + 64 * u.pm, 1u, __ATOMIC_RELAXED, __HIP_MEMORY_SCOPE_AGENT);
            unsigned it_ = 0;
            while ((unsigned)__builtin_amdgcn_readfirstlane(__hip_atomic_load(cnt + 64 * u.pm, __ATOMIC_RELAXED, __HIP_MEMORY_SCOPE_AGENT)) < 4u) { if (++it_ > (1u << 20)) break; __builtin_amdgcn_s_sleep(2); }
            __builtin_amdgcn_fence(__ATOMIC_ACQUIRE, "agent");
        }
        asm volatile("s_waitcnt vmcnt(0) lgkmcnt(0)\n\ts_barrier" ::: "memory");
        float rstd[2][4];
#pragma unroll
        for (int ai = 0; ai < 2; ++ai)
#pragma unroll
            for (int m = 0; m < 4; ++m) { const float* sl = xbuf + (((unsigned)u.pm * BM + rloc + (unsigned)(ai * HALF + m * 16)) * 4u); float tot = 0.f;
#pragma unroll
                for (int k4 = 0; k4 < 4; ++k4) tot += __hip_atomic_load(sl + k4, __ATOMIC_RELAXED, __HIP_MEMORY_SCOPE_AGENT);
                rstd[ai][m] = 1.f / sqrtf(tot * (1.f / DM) + EPS); EPI_FENCE(); }
        const unsigned orow0 = (unsigned)((u.pm / 33) * SEQ + (u.pm % 33) * BM);
#pragma unroll
        for (int bj = 0; bj < 2; ++bj) {
            float g8[8], sh8[8], sc8[8];
            ldf8(ng + colp + bj * HALF, g8);
            if (MODE == 1) { const float* mp = modsh + (unsigned)mi * 9 * DM + colp + bj * HALF; ldf8(mp, sh8); ldf8(mp + DM, sc8); }
#pragma unroll
            for (int ai = 0; ai < 2; ++ai)
#pragma unroll
                for (int m = 0; m < 4; ++m) { const unsigned rr = rloc + (unsigned)(ai * HALF + m * 16); const f32x4 h0 = acc[ai][bj][m][0], h1 = acc[ai][bj][m][1]; const float r_ = rstd[ai][m];
                    float h[8] = {h0[0], h0[1], h0[2], h0[3], h1[0], h1[1], h1[2], h1[3]};
                    if (MODE == 1) { float o[8];
#pragma unroll
                        for (int i = 0; i < 8; ++i) o[i] = h[i] * r_ * g8[i] * (sc8[i] + 1.f) + sh8[i];
                        *(u32x4*)(H + (((unsigned)u.pm * BM + rr) * DM + colp + bj * HALF)) = pack8(h);
                        *(u32x4*)(A + (((unsigned)u.pm * BM + rr) * DM + colp + bj * HALF)) = pack8(o); }
                    else { float* op = out + ((orow0 + rr) * DM + colp + bj * HALF);
                        *(f32x4*)op = (f32x4){h[0] * r_ * g8[0], h[1] * r_ * g8[1], h[2] * r_ * g8[2], h[3] * r_ * g8[3]};
                        *(f32x4*)(op + 4) = (f32x4){h[4] * r_ * g8[4], h[5] * r_ * g8[5], h[6] * r_ * g8[6], h[7] * r_ * g8[7]}; }
                    EPI_FENCE(); }
            EPI_FENCE(); }
    }
};
struct EpiQb {
    static constexpr bool PERM = false, AFTER_DRAIN = false;
    bf16_t* Q; const f32x2* rope  ;
    __device__ __forceinline__ void operator()(const f32x4 (&acc)[2][2][4][2], const Unit& u, int wr, int wc, int fr_, int fq_) const {
        int fr = fr_, fq = fq_; asm volatile("" : "+v"(fr), "+v"(fq));
        const int row0 = u.pm * BM + wr * 64 + fr, col0 = u.pn * BM + wc * 32 + 4 * fq;
        const bool lat = (u.pm % 33) != 32;
        const int t0 = row0 - (u.pm / 33) * SEQT;
#pragma unroll
        for (int bj = 0; bj < 2; ++bj)
#pragma unroll
            for (int n = 0; n < 2; ++n) { const int col = col0 + bj * HALF + n * 16; const int d = col % 96; const bool rot = (d >= 64) && lat;
                const int i0 = (d - 64) >> 1, f0 = i0 & 7;
#pragma unroll
                for (int ai = 0; ai < 2; ++ai) {
#pragma unroll
                    for (int m = 0; m < 4; ++m) { const int rr = ai * HALF + m * 16; const int t = t0 + rr; f32x4 v = acc[ai][bj][m][n];
                        if (rot) { const int pos = (i0 < 8) ? (t >> 6) : (t & 63);
                            const f32x2 cs0 = rope[pos * 16 + f0], cs1 = rope[pos * 16 + f0 + 1];
                            v = (f32x4){v[0] * cs0.x - v[1] * cs0.y, v[0] * cs0.y + v[1] * cs0.x, v[2] * cs1.x - v[3] * cs1.y, v[2] * cs1.y + v[3] * cs1.x}; }
                        v = v * C2_MLA; u32x2 w; w.x = pk2(v[0], v[1]); w.y = pk2(v[2], v[3]);
                        *(u32x2*)(Q + (unsigned)(row0 + rr) * 768 + col) = w; }
                    EPI_FENCE(); } }
    }
};
struct EpiKVb {
    static constexpr bool PERM = false, AFTER_DRAIN = false;
    bf16_t* K; bf16_t* V;
    __device__ __forceinline__ void operator()(const f32x4 (&acc)[2][2][4][2], const Unit& u, int wr, int wc, int fr_, int fq_) const {
        int fr = fr_, fq = fq_; asm volatile("" : "+v"(fr), "+v"(fq));
        const int row0 = u.pm * BM + wr * 64 + fr, col0 = u.pn * BM + wc * 32 + 4 * fq;
#pragma unroll
        for (int bj = 0; bj < 2; ++bj)
#pragma unroll
            for (int n = 0; n < 2; ++n) { const int col = col0 + bj * HALF + n * 16; const int h = col >> 7, d = col & 127;
                bf16_t* base = (d < 64) ? (K + h * 96 + d) : (V + h * 64 + (d - 64)); const unsigned pitch = (d < 64) ? 768u : 512u;
#pragma unroll
                for (int ai = 0; ai < 2; ++ai) {
#pragma unroll
                    for (int m = 0; m < 4; ++m) { const f32x4 v = acc[ai][bj][m][n]; u32x2 w; w.x = pk2(v[0], v[1]); w.y = pk2(v[2], v[3]);
                        *(u32x2*)(base + (unsigned)(row0 + ai * HALF + m * 16) * pitch) = w; }
                    EPI_FENCE(); } }
    }
};

constexpr int A_NSLOT = 3, A_KSLOT = 12288, A_VSLOT = 8192;
constexpr int A_K = 0, A_V = A_NSLOT * A_KSLOT, A_WS = A_V + A_NSLOT * A_VSLOT, A_OST = A_WS + 2048, A_BYTES = A_OST + 8 * 4096;
static_assert(A_BYTES <= RING_BYTES, "attention LDS");
__device__ __forceinline__ int crow(int r, int hi) { return (r & 3) + 8 * (r >> 2) + 4 * hi; }
__device__ __forceinline__ void glds16(const void* gsrc, unsigned lds_dst) { unsigned keep;
    asm volatile("s_mov_b32 %0, m0\n\ts_mov_b32 m0, %2\n\ts_nop 0\n\tglobal_load_lds_dwordx4 %1, off\n\ts_mov_b32 m0, %0" : "=&s"(keep) : "v"(gsrc), "s"(lds_dst) : "memory"); }
__device__ __forceinline__ void pv(f32x16* o, int vb, bf16x8 pa0, bf16x8 pa1, bf16x8 pa2, bf16x8 pa3) {
#pragma unroll
    for (int d0 = 0; d0 < 2; ++d0) { s16x4 lo[4], hi[4];
#pragma unroll
        for (int ks = 0; ks < 4; ++ks) {
            asm volatile("ds_read_b64_tr_b16 %0,%1 offset:%c2" : "=&v"(lo[ks]) : "v"(vb), "i"(d0 * 4096 + ks * 1024) : "memory");
            asm volatile("ds_read_b64_tr_b16 %0,%1 offset:%c2" : "=&v"(hi[ks]) : "v"(vb), "i"(d0 * 4096 + ks * 1024 + 512) : "memory"); }
        asm volatile("s_waitcnt lgkmcnt(0)" ::: "memory"); __builtin_amdgcn_sched_barrier(0);
#define PK(k) (bf16x8){lo[k][0], lo[k][1], lo[k][2], lo[k][3], hi[k][0], hi[k][1], hi[k][2], hi[k][3]}
        o[d0] = __builtin_amdgcn_mfma_f32_32x32x16_bf16(pa0, PK(0), o[d0], 0, 0, 0);
        o[d0] = __builtin_amdgcn_mfma_f32_32x32x16_bf16(pa1, PK(1), o[d0], 0, 0, 0);
        o[d0] = __builtin_amdgcn_mfma_f32_32x32x16_bf16(pa2, PK(2), o[d0], 0, 0, 0);
        o[d0] = __builtin_amdgcn_mfma_f32_32x32x16_bf16(pa3, PK(3), o[d0], 0, 0, 0);
#undef PK
    }
}
template <int NKD>
__device__ __forceinline__ void attn_unit(const bf16_t* Qu, int qp, const bf16_t* Ku, int kp, const bf16_t* Vu, int vp, bf16_t* Ou, int op, int NT, LAS unsigned char* shm, const int wave_id) {
    const int wid = wave_id, lane = fresh_lane(), r32 = lane & 31, hi = lane >> 5;
    const unsigned lds0 = (unsigned)(uintptr_t)shm;
    LAS float* wsf = (LAS float*)(shm + A_WS) + wid * 64;
    const bf16_t* Qw = Qu + (size_t)(wid * 32) * qp;
    const bf16_t* ksrc = Ku + (size_t)lane * kp + wid * 8;
    const bf16_t* ksrc2 = Ku + (size_t)lane * kp + (8 + (wid & 3)) * 8;
    const bf16_t* vsrc = Vu + (size_t)(16 * (wid & 3) + (lane >> 2)) * vp + (wid >> 2) * 32 + (lane & 3) * 8;
    const unsigned kdst = lds0 + A_K + wid * 1024, kdst2 = lds0 + A_K + (8 + (wid & 3)) * 1024, vdst = lds0 + A_V + wid * 1024;
#define DMA_TILE(t, s) do { glds16(ksrc + (size_t)(t) * 64 * kp, (unsigned)__builtin_amdgcn_readfirstlane(kdst + (s) * A_KSLOT)); \
        if (NKD == 6) glds16(ksrc2 + (size_t)(t) * 64 * kp, (unsigned)__builtin_amdgcn_readfirstlane(kdst2 + (s) * A_KSLOT)); \
        glds16(vsrc + (size_t)(t) * 64 * vp, (unsigned)__builtin_amdgcn_readfirstlane(vdst + (s) * A_VSLOT)); } while (0)
    bf16x8 qr[NKD];
#pragma unroll
    for (int d0 = 0; d0 < NKD; ++d0) qr[d0] = *(const bf16x8*)(Qw + (size_t)r32 * qp + d0 * 16 + hi * 8);
    DMA_TILE(0, 0); if (NT > 1) DMA_TILE(1, 1);
    const int vb0 = (int)(lds0 + A_V) + ((lane >> 4) & 1) * 32 + (lane & 3) * 8 + (4 * hi + ((lane & 15) >> 2)) * 64;
    const LAS unsigned char* kp0 = shm + A_K + hi * 1024 + r32 * 16;
    float mhat = -INFINITY, l_reg = 0.f; f32x16 o[2]; o[0] = f32x16{}; o[1] = f32x16{};
    int sl = 0, sl2 = 2;
    for (int t = 0; t < NT; ++t) {
        if (t + 1 < NT) { if (NKD == 6) asm volatile("s_waitcnt vmcnt(3) lgkmcnt(0)\n\ts_barrier" ::: "memory"); else asm volatile("s_waitcnt vmcnt(2) lgkmcnt(0)\n\ts_barrier" ::: "memory"); }
        else asm volatile("s_waitcnt vmcnt(0) lgkmcnt(0)\n\ts_barrier" ::: "memory");
        if (t + 2 < NT) DMA_TILE(t + 2, sl2);
        f32x16 p0, p1;
        { const LAS unsigned char* kb = kp0 + sl * A_KSLOT;
#pragma unroll
          for (int d0 = 0; d0 < NKD; ++d0) {
              const bf16x8 b0 = *(const LAS bf16x8*)(kb + d0 * 2048), b1 = *(const LAS bf16x8*)(kb + d0 * 2048 + 512);
              if (d0 == 0) { p0 = __builtin_amdgcn_mfma_f32_32x32x16_bf16(b0, qr[0], f32x16{}, 0, 0, 0); p1 = __builtin_amdgcn_mfma_f32_32x32x16_bf16(b1, qr[0], f32x16{}, 0, 0, 0); }
              else { p0 = __builtin_amdgcn_mfma_f32_32x32x16_bf16(b0, qr[d0], p0, 0, 0, 0); p1 = __builtin_amdgcn_mfma_f32_32x32x16_bf16(b1, qr[d0], p1, 0, 0, 0); } } }
        float rm = __builtin_fmaxf(p0[0], p1[0]);
#pragma unroll
        for (int r = 1; r < 16; ++r) rm = __builtin_fmaxf(rm, __builtin_fmaxf(p0[r], p1[r]));
        { auto rr = __builtin_amdgcn_permlane32_swap(__float_as_uint(rm), __float_as_uint(rm), false, false); rm = __builtin_fmaxf(__uint_as_float(rr[0]), __uint_as_float(rr[1])); }
        if (__any(rm > mhat + 8.f)) {
            const float mn = __builtin_fmaxf(mhat, rm); const float f = __builtin_amdgcn_exp2f(mhat - mn); mhat = mn; l_reg *= f;
            if (hi == 0) wsf[r32] = f;
            asm volatile("s_waitcnt lgkmcnt(0)" ::: "memory");
#pragma unroll
            for (int r = 0; r < 16; ++r) { const float fr_ = wsf[crow(r, hi)]; o[0][r] *= fr_; o[1][r] *= fr_; }
        }
        float sacc = 0.f;
#pragma unroll
        for (int r = 0; r < 16; ++r) { p0[r] = __builtin_amdgcn_exp2f(p0[r] - mhat); p1[r] = __builtin_amdgcn_exp2f(p1[r] - mhat); sacc += p0[r] + p1[r]; }
        l_reg += sacc;
        u32x4 pw0, pw1, pw2, pw3;
        pw0 = (u32x4){pk2(p0[0], p0[1]), pk2(p0[2], p0[3]), pk2(p0[4], p0[5]), pk2(p0[6], p0[7])};
        pw1 = (u32x4){pk2(p0[8], p0[9]), pk2(p0[10], p0[11]), pk2(p0[12], p0[13]), pk2(p0[14], p0[15])};
        pw2 = (u32x4){pk2(p1[0], p1[1]), pk2(p1[2], p1[3]), pk2(p1[4], p1[5]), pk2(p1[6], p1[7])};
        pw3 = (u32x4){pk2(p1[8], p1[9]), pk2(p1[10], p1[11]), pk2(p1[12], p1[13]), pk2(p1[14], p1[15])};
        pv(o, vb0 + sl * A_VSLOT, __builtin_bit_cast(bf16x8, pw0), __builtin_bit_cast(bf16x8, pw1), __builtin_bit_cast(bf16x8, pw2), __builtin_bit_cast(bf16x8, pw3));
        sl = (sl == 2) ? 0 : sl + 1; sl2 = (sl2 == 2) ? 0 : sl2 + 1;
    }
    { auto rr = __builtin_amdgcn_permlane32_swap(__float_as_uint(l_reg), __float_as_uint(l_reg), false, false); l_reg = __uint_as_float(rr[0]) + __uint_as_float(rr[1]); }
    if (hi == 0) wsf[32 + r32] = l_reg;
    asm volatile("s_waitcnt lgkmcnt(0)" ::: "memory");
    LAS bf16_t* stg = (LAS bf16_t*)(shm + A_OST) + wid * 2048;
#pragma unroll
    for (int r = 0; r < 16; ++r) { const int orow = crow(r, hi); const float rl = __builtin_amdgcn_rcpf(wsf[32 + orow]);
        stg[orow * 64 + r32] = (bf16_t)f2bf(o[0][r] * rl); stg[orow * 64 + 32 + r32] = (bf16_t)f2bf(o[1][r] * rl); }
    asm volatile("s_waitcnt lgkmcnt(0)" ::: "memory");
    bf16_t* Ow = Ou + (size_t)(wid * 32) * op;
#pragma unroll
    for (int i = 0; i < 4; ++i) { const int row = i * 8 + (lane >> 3), ch = lane & 7; const u32x4 v = *(const LAS u32x4*)(stg + row * 64 + ch * 8); *(u32x4*)(Ow + (size_t)row * op + ch * 8) = v; }
    asm volatile("s_waitcnt vmcnt(0) lgkmcnt(0)\n\ts_barrier" ::: "memory");
#undef DMA_TILE
}


namespace tat {
using bf16 = unsigned short;
using bf16x8 = __attribute__((ext_vector_type(8))) short;
using s16x4 = __attribute__((ext_vector_type(4))) short;
using f32x16 = __attribute__((ext_vector_type(16))) float;
using u32x4 = __attribute__((ext_vector_type(4))) unsigned;
constexpr int D = 64, NW = 8, QBLK = 32, QB = QBLK * NW, KVBLK = 64;
__device__ __forceinline__ int crow(int r, int hi) { return (r & 3) + 8 * (r >> 2) + 4 * hi; }
#define SBAR() __builtin_amdgcn_sched_barrier(0)
constexpr int NSLOT=3, SLOTB=8192;
__device__ __forceinline__ unsigned f2bf_t(float f){unsigned u=__builtin_bit_cast(unsigned,f);return (u+0x7fffu+((u>>16)&1u))>>16;}
constexpr int KSLOTMAX=12288; constexpr int LDS_K=0, LDS_V=NSLOT*KSLOTMAX, LDS_WS=NSLOT*KSLOTMAX+NSLOT*SLOTB, LDS_OST=LDS_WS+NW*64*4, LDS_BYTES=LDS_OST+NW*4096;
constexpr float C2=0.125f*1.4426950408889634f;
__device__ __forceinline__ void glds16(const void*gsrc,unsigned lds_dst){unsigned keep;
  asm volatile("s_mov_b32 %0, m0\n\ts_mov_b32 m0, %2\n\ts_nop 0\n\tglobal_load_lds_dwordx4 %1, off\n\ts_mov_b32 m0, %0":"=&s"(keep):"v"(gsrc),"s"(lds_dst):"memory");}
__device__ __forceinline__ float max3f(float a,float b,float c){float r;asm("v_max3_f32 %0, %1, %2, %3":"=v"(r):"v"(a),"v"(b),"v"(c));return r;}
__device__ __forceinline__ float max2f(float a,float b){float r;asm("v_max_f32_e32 %0, %1, %2":"=v"(r):"v"(a),"v"(b));return r;}
__device__ __forceinline__ float fadd_s(float a,float b){float r;asm("v_add_f32_e32 %0, %1, %2":"=v"(r):"v"(a),"v"(b));return r;}
__device__ __forceinline__ float fsub_s(float a,float b){float r;asm("v_sub_f32_e32 %0, %1, %2":"=v"(r):"v"(a),"v"(b));return r;}
typedef float f32x2_t __attribute__((ext_vector_type(2))); typedef __bf16 bf16x2_t __attribute__((ext_vector_type(2)));
__device__ __forceinline__ unsigned cvtpk_s(float lo,float hi){f32x2_t v={lo,hi};bf16x2_t b=__builtin_convertvector(v,bf16x2_t);return __builtin_bit_cast(unsigned,b);}
#define WAIT_BAR(N) asm volatile("s_waitcnt vmcnt(" #N ") lgkmcnt(0)\n\ts_barrier":::"memory")

template<int NKD> __device__ __forceinline__ void qkt(f32x16&p0,f32x16&p1,const char*Kslot,const bf16x8*qr,const f32x16&negm,int r32,int hi){
  const char*kb=Kslot+hi*1024+r32*16;
  #pragma unroll
  for(int d0=0;d0<NKD;++d0){
    const bf16x8 b0=*reinterpret_cast<const bf16x8*>(kb+d0*2048);
    const bf16x8 b1=*reinterpret_cast<const bf16x8*>(kb+d0*2048+512);
    if(d0==0){p0=__builtin_amdgcn_mfma_f32_32x32x16_bf16(b0,qr[0],negm,0,0,0);p1=__builtin_amdgcn_mfma_f32_32x32x16_bf16(b1,qr[0],negm,0,0,0);}
    else{p0=__builtin_amdgcn_mfma_f32_32x32x16_bf16(b0,qr[d0],p0,0,0,0);p1=__builtin_amdgcn_mfma_f32_32x32x16_bf16(b1,qr[d0],p1,0,0,0);}}
}
typedef __attribute__((address_space(3))) const char* lds_cptr;
typedef short v4i16_t __attribute__((ext_vector_type(4)));
template<int NKD> __device__ __forceinline__ void kload8(bf16x8*kf,lds_cptr kp){
  if(NKD==6){ kf[8]=*(const __attribute__((address_space(3))) bf16x8*)(kp+8192); kf[9]=*(const __attribute__((address_space(3))) bf16x8*)(kp+8704); kf[10]=*(const __attribute__((address_space(3))) bf16x8*)(kp+10240); kf[11]=*(const __attribute__((address_space(3))) bf16x8*)(kp+10752); }
  kf[0]=*(const __attribute__((address_space(3))) bf16x8*)(kp);      kf[1]=*(const __attribute__((address_space(3))) bf16x8*)(kp+512);
  kf[2]=*(const __attribute__((address_space(3))) bf16x8*)(kp+2048); kf[3]=*(const __attribute__((address_space(3))) bf16x8*)(kp+2560);
  kf[4]=*(const __attribute__((address_space(3))) bf16x8*)(kp+4096); kf[5]=*(const __attribute__((address_space(3))) bf16x8*)(kp+4608);
  kf[6]=*(const __attribute__((address_space(3))) bf16x8*)(kp+6144); kf[7]=*(const __attribute__((address_space(3))) bf16x8*)(kp+6656);
}
__device__ __forceinline__ void kload2(bf16x8*kf,lds_cptr kp,int j){ kf[2*j]=*(const __attribute__((address_space(3))) bf16x8*)(kp+j*2048); kf[2*j+1]=*(const __attribute__((address_space(3))) bf16x8*)(kp+j*2048+512); }
__device__ __forceinline__ s16x4 vtr(lds_cptr p){ return __builtin_bit_cast(s16x4,__builtin_amdgcn_ds_read_tr16_b64_v4i16((__attribute__((address_space(3))) v4i16_t*)p)); }
__device__ __forceinline__ float rowmax(const f32x16&p0,const f32x16&p1){
  float a=max3f(p0[0],p0[1],p1[0]),b=max3f(p0[2],p0[3],p1[1]);a=max3f(a,p1[2],p1[3]);
  #pragma unroll
  for(int r=4;r<16;r+=4){a=max3f(a,p0[r],p0[r+1]);b=max3f(b,p0[r+2],p0[r+3]);a=max3f(a,p1[r],p1[r+1]);b=max3f(b,p1[r+2],p1[r+3]);}
  const float m=max2f(a,b);
  auto rr=__builtin_amdgcn_permlane32_swap(__float_as_uint(m),__float_as_uint(m),false,false);
  return max2f(__uint_as_float(rr[0]),__uint_as_float(rr[1]));
}
__device__ __forceinline__ void pv(f32x16*o,int vb,bf16x8 pa0,bf16x8 pa1,bf16x8 pa2,bf16x8 pa3){
  #pragma unroll
  for(int d0=0;d0<2;++d0){s16x4 lo[4],hi[4];
    #pragma unroll
    for(int ks=0;ks<4;++ks){
      asm volatile("ds_read_b64_tr_b16 %0,%1 offset:%c2":"=&v"(lo[ks]):"v"(vb),"i"(d0*4096+ks*1024):"memory");
      asm volatile("ds_read_b64_tr_b16 %0,%1 offset:%c2":"=&v"(hi[ks]):"v"(vb),"i"(d0*4096+ks*1024+512):"memory");}
    asm volatile("s_waitcnt lgkmcnt(0)":::"memory");SBAR();
    #define PK(k) (bf16x8){lo[k][0],lo[k][1],lo[k][2],lo[k][3],hi[k][0],hi[k][1],hi[k][2],hi[k][3]}
    o[d0]=__builtin_amdgcn_mfma_f32_32x32x16_bf16(pa0,PK(0),o[d0],0,0,0);
    o[d0]=__builtin_amdgcn_mfma_f32_32x32x16_bf16(pa1,PK(1),o[d0],0,0,0);
    o[d0]=__builtin_amdgcn_mfma_f32_32x32x16_bf16(pa2,PK(2),o[d0],0,0,0);
    o[d0]=__builtin_amdgcn_mfma_f32_32x32x16_bf16(pa3,PK(3),o[d0],0,0,0);
    #undef PK
  }
}
#ifndef ATTN_STORE16
#define ATTN_STORE16(p,v) (*(u32x4*)(p)=(v))
#endif
template<int THRL,int NKD,int QP,int KP,int VP,int OP> __device__ __forceinline__ void attn_unit(const bf16*Qu,const bf16*__restrict__ Ku,const bf16*__restrict__ Vu,bf16*Ou,const int NT,char*shm,const int wave_id){
  const int lane=fresh_lane(),r32=lane&31,hi=lane>>5; const int wid=wave_id;
  const bf16*Qw=Qu+(long)(wid*QBLK)*QP;
  const bf16*Kh=Ku,*Vh=Vu;
  const unsigned lds0=(unsigned)(uintptr_t)shm;
  float*wsf=(float*)(shm+LDS_WS)+wid*64;
  const bf16*ksrc=Kh+(long)lane*KP+wid*8; const bf16*ksrc2=Kh+(long)lane*KP+(8+(wid&3))*8;
  const bf16*vsrc=Vh+(long)(16*(wid&3)+(lane>>2))*VP+(wid>>2)*32+(lane&3)*8;
  const unsigned kdst=lds0+LDS_K+wid*1024, kdst2=lds0+LDS_K+(8+(wid&3))*1024, vdst=lds0+LDS_V+wid*1024;
  #define KOFF(s_) ((NKD==6)?((s_)+((s_)>>1)):(s_))
  #define DMA_K(t,slot) do{ glds16(ksrc+(long)(t)*KVBLK*KP,(unsigned)__builtin_amdgcn_readfirstlane(kdst+KOFF(slot))); if(NKD==6) glds16(ksrc2+(long)(t)*KVBLK*KP,(unsigned)__builtin_amdgcn_readfirstlane(kdst2+KOFF(slot))); }while(0)
  #define WAIT_KV() do{ if(NKD==6){WAIT_BAR(3);} else {WAIT_BAR(2);} }while(0)
  #define DMA_V(t,slot) glds16(vsrc+(long)(t)*KVBLK*VP,(unsigned)__builtin_amdgcn_readfirstlane(vdst+(slot)))
  const int vb0=(int)(lds0+LDS_V)+((lane>>4)&1)*32+(lane&3)*8+(4*hi+((lane&15)>>2))*64;
  const char*Kbase=shm+LDS_K; bf16x8 kf[2*NKD];
  const lds_cptr shm3=(lds_cptr)shm; const lds_cptr kp0=shm3+LDS_K+hi*1024+r32*16; const lds_cptr vp0=shm3+LDS_V+((lane>>4)&1)*32+(lane&3)*8+(4*hi+((lane&15)>>2))*64;
  DMA_K(0,0);DMA_V(0,0);DMA_K(1,SLOTB);
  bf16x8 qr[NKD];
  #pragma unroll
  for(int d0=0;d0<NKD;++d0)qr[d0]=*reinterpret_cast<const bf16x8*>(&Qw[(long)r32*QP+d0*16+hi*8]);
  float mhat=0.f,l_reg=0.f;f32x16 o[2];o[0]=f32x16{};o[1]=f32x16{};f32x16 negm=f32x16{};asm volatile("":"+v"(negm));
  #define CMASK(P0,P1,t) do{}while(0)
  bool resc=false;
  #define START(P0,P1) do{ const float rm=rowmax(P0,P1); resc=false; \
    { const float dl=rm; mhat=fadd_s(mhat,dl); \
      _Pragma("unroll") for(int r=0;r<16;++r){P0[r]=fsub_s(P0[r],dl);P1[r]=fsub_s(P1[r],dl);} \
      _Pragma("unroll") for(int r=0;r<16;++r)negm[r]=-mhat; asm volatile("":"+v"(negm)); } \
    _Pragma("unroll") for(int r=0;r<16;++r)P0[r]=__builtin_amdgcn_exp2f(P0[r]); }while(0)
  #define RESC() do{ if(resc){ asm volatile("s_waitcnt lgkmcnt(0)":::"memory"); \
      _Pragma("unroll") for(int d_=0;d_<2;++d_) _Pragma("unroll") for(int r=0;r<16;++r)o[d_][r]*=wsf[crow(r,hi)]; } }while(0)
  f32x16 pA0,pA1,pB0,pB1;
  int sl_prev=0,sl_cur=0,sl_next=SLOTB;
  #define ROT() do{sl_prev=sl_cur;sl_cur=sl_next;sl_next=(sl_next==(NSLOT-1)*SLOTB)?0:sl_next+SLOTB;}while(0)
  DMA_K(2,2*SLOTB);
  WAIT_BAR(3);
  qkt<NKD>(pA0,pA1,Kbase,qr,negm,r32,hi);asm volatile("s_nop 15\n\ts_nop 7":"+v"(pA0),"+v"(pA1));CMASK(pA0,pA1,0);
  START(pA0,pA1);
  _Pragma("unroll") for(int r=0;r<16;++r)pA1[r]=__builtin_amdgcn_exp2f(pA1[r]);
  WAIT_BAR(0);
  DMA_K(3,0);DMA_V(1,SLOTB);
  ROT();
  kload8<NKD>(kf,kp0+KOFF(sl_cur));
  WAIT_KV();
  s16x4 vlo[8],vhi[8]; u32x4 pw0,pw1,pw2,pw3;
  #define PKW(P,B) cvtpk_s(P[B],P[B+1])
  #define PAF(k) __builtin_bit_cast(bf16x8,pw##k)
  #define VFR(i) (bf16x8){vlo[i][0],vlo[i][1],vlo[i][2],vlo[i][3],vhi[i][0],vhi[i][1],vhi[i][2],vhi[i][3]}
  #define PIN(x) asm volatile("":"+v"(x))
  #define MX3(a,b,c) __builtin_fmaxf(__builtin_fmaxf((a),(b)),(c))
  #define GAPA(MF,A0,A1,A2,A3,W0,W1,PW) do{ MF; sacc+=A0; sacc+=A1; sacc+=A2; sacc+=A3; PIN(sacc); W0; W1; PIN(PW); SBAR(); }while(0)
  #define EX(v) __builtin_amdgcn_exp2f(v)
  #define GAPB(MF,X,B) do{ MF; X[B]=EX(X[B]); X[B+1]=EX(X[B+1]); X[B+2]=EX(X[B+2]); X[B+3]=EX(X[B+3]); PIN(X); SBAR(); }while(0)
  #define VRD(i) do{ vlo[i]=vtr(vp_+(((i)>>2)*4096+((i)&3)*1024)); vhi[i]=vtr(vp_+(((i)>>2)*4096+((i)&3)*1024+512)); }while(0)
  #define KRD(G,j) do{ if(G){ kload2(kf,kp0+KOFF(sl_next),j); SBAR(); } }while(0)
  #define STEP(C0,C1,P0,P1,t,GK,GV,GL) do{ SBAR(); \
    const lds_cptr vp_=vp0+sl_prev; \
    VRD(0); SBAR(); float sacc=(P0[0]+P0[1]); \
    GAPA(C0=__builtin_amdgcn_mfma_f32_32x32x16_bf16(kf[0],qr[0],negm,0,0,0), P0[2],P0[3],P0[4],P0[5],     pw0[0]=PKW(P0,0), pw0[1]=PKW(P0,2), pw0); \
    VRD(4); SBAR(); GAPA(C1=__builtin_amdgcn_mfma_f32_32x32x16_bf16(kf[1],qr[0],negm,0,0,0), P0[6],P0[7],P0[8],P0[9],     pw0[2]=PKW(P0,4), pw0[3]=PKW(P0,6), pw0); \
    VRD(1); SBAR(); GAPA(C0=__builtin_amdgcn_mfma_f32_32x32x16_bf16(kf[2],qr[1],C0,0,0,0),   P0[10],P0[11],P0[12],P0[13], pw1[0]=PKW(P0,8), pw1[1]=PKW(P0,10), pw1); \
    VRD(5); SBAR(); GAPA(C1=__builtin_amdgcn_mfma_f32_32x32x16_bf16(kf[3],qr[1],C1,0,0,0),   P0[14],P0[15],P1[0],P1[1],   pw1[2]=PKW(P0,12),pw1[3]=PKW(P0,14), pw1); \
    VRD(2); SBAR(); GAPA(C0=__builtin_amdgcn_mfma_f32_32x32x16_bf16(kf[4],qr[2],C0,0,0,0),   P1[2],P1[3],P1[4],P1[5],     pw2[0]=PKW(P1,0), pw2[1]=PKW(P1,2), pw2); \
    VRD(6); SBAR(); GAPA(C1=__builtin_amdgcn_mfma_f32_32x32x16_bf16(kf[5],qr[2],C1,0,0,0),   P1[6],P1[7],P1[8],P1[9],     pw2[2]=PKW(P1,4), pw2[3]=PKW(P1,6), pw2); \
    VRD(3); SBAR(); GAPA(C0=__builtin_amdgcn_mfma_f32_32x32x16_bf16(kf[6],qr[3],C0,0,0,0),   P1[10],P1[11],P1[12],P1[13], pw3[0]=PKW(P1,8), pw3[1]=PKW(P1,10), pw3); \
    VRD(7); SBAR(); GAPA(C1=__builtin_amdgcn_mfma_f32_32x32x16_bf16(kf[7],qr[3],C1,0,0,0),   P1[14],P1[15],0.f,0.f,       pw3[2]=PKW(P1,12),pw3[3]=PKW(P1,14), pw3); \
    if(NKD==6){ C0=__builtin_amdgcn_mfma_f32_32x32x16_bf16(kf[(NKD==6)?8:0],qr[(NKD==6)?4:0],C0,0,0,0); C1=__builtin_amdgcn_mfma_f32_32x32x16_bf16(kf[(NKD==6)?9:0],qr[(NKD==6)?4:0],C1,0,0,0); \
      C0=__builtin_amdgcn_mfma_f32_32x32x16_bf16(kf[(NKD==6)?10:0],qr[(NKD==6)?5:0],C0,0,0,0); C1=__builtin_amdgcn_mfma_f32_32x32x16_bf16(kf[(NKD==6)?11:0],qr[(NKD==6)?5:0],C1,0,0,0); SBAR(); } \
    l_reg+=sacc; \
    if(GK){DMA_K((t)+3,sl_cur);} if(GV){DMA_V((t)+1,sl_next);} \
    CMASK(C0,C1,t); \
    { float a=MX3(C0[0],C0[1],C1[0]),b=MX3(C0[2],C0[3],C1[1]); a=MX3(a,C1[2],C1[3]); \
      _Pragma("unroll") for(int r=4;r<16;r+=4){a=MX3(a,C0[r],C0[r+1]);b=MX3(b,C0[r+2],C0[r+3]);a=MX3(a,C1[r],C1[r+1]);b=MX3(b,C1[r+2],C1[r+3]);} \
      float rm=__builtin_fmaxf(a,b); { auto rr=__builtin_amdgcn_permlane32_swap(__float_as_uint(rm),__float_as_uint(rm),false,false); rm=__builtin_fmaxf(__uint_as_float(rr[0]),__uint_as_float(rr[1])); } \
      resc=false; \
      if(__builtin_expect(__any(rm>(float)THRL),0)){ const float dl=__builtin_fmaxf(rm,0.f); mhat+=dl; \
        _Pragma("unroll") for(int r=0;r<16;++r){C0[r]-=dl;C1[r]-=dl;} \
        _Pragma("unroll") for(int r=0;r<16;++r)negm[r]=-mhat; asm volatile("":"+v"(negm)); \
        const float f=__builtin_amdgcn_exp2f(-dl); l_reg*=f; if(hi==0)wsf[r32]=f; resc=true; } } \
    SBAR(); \
    GAPB(o[0]=__builtin_amdgcn_mfma_f32_32x32x16_bf16(PAF(0),VFR(0),o[0],0,0,0), C0,0); \
    GAPB(o[1]=__builtin_amdgcn_mfma_f32_32x32x16_bf16(PAF(0),VFR(4),o[1],0,0,0), C0,4); \
    KRD(GL,0); GAPB(o[0]=__builtin_amdgcn_mfma_f32_32x32x16_bf16(PAF(1),VFR(1),o[0],0,0,0), C0,8); \
    KRD(GL,1); GAPB(o[1]=__builtin_amdgcn_mfma_f32_32x32x16_bf16(PAF(1),VFR(5),o[1],0,0,0), C0,12); \
    KRD(GL,2); GAPB(o[0]=__builtin_amdgcn_mfma_f32_32x32x16_bf16(PAF(2),VFR(2),o[0],0,0,0), C1,0); \
    KRD(GL,3); GAPB(o[1]=__builtin_amdgcn_mfma_f32_32x32x16_bf16(PAF(2),VFR(6),o[1],0,0,0), C1,4); \
    if(NKD==6){KRD(GL,(NKD==6)?4:0);} GAPB(o[0]=__builtin_amdgcn_mfma_f32_32x32x16_bf16(PAF(3),VFR(3),o[0],0,0,0), C1,8); \
    if(NKD==6){KRD(GL,(NKD==6)?5:0);} GAPB(o[1]=__builtin_amdgcn_mfma_f32_32x32x16_bf16(PAF(3),VFR(7),o[1],0,0,0), C1,12); \
    }while(0)
  int t=1;
  #undef CMASK
  #define CMASK(P0,P1,t) do{}while(0)
  for(;t+5<NT;t+=2){
    STEP(pB0,pB1,pA0,pA1,t,true,true,true);     WAIT_KV(); RESC(); ROT();
    STEP(pA0,pA1,pB0,pB1,t+1,true,true,true);   WAIT_KV(); RESC(); ROT();
  }
  #undef CMASK
  #define CMASK(P0,P1,t) do{}while(0)
  #define ENDW(tt) do{ if((tt)+3<NT){WAIT_KV();} else if((tt)+2<NT){WAIT_BAR(1);} else {WAIT_BAR(0);} }while(0)
  for(;t+1<NT;t+=2){
    STEP(pB0,pB1,pA0,pA1,t,(t+3<NT),(t+1<NT),(t+1<NT));       ENDW(t);   RESC(); ROT();
    STEP(pA0,pA1,pB0,pB1,t+1,(t+4<NT),(t+2<NT),(t+2<NT));     ENDW(t+1); RESC(); ROT();
  }
  STEP(pB0,pB1,pA0,pA1,NT-1,false,false,false); RESC();
  { float sacc=pB0[0]+pB0[1]; _Pragma("unroll") for(int r=2;r<16;++r)sacc+=pB0[r]; _Pragma("unroll") for(int r=0;r<16;++r)sacc+=pB1[r]; l_reg+=sacc;
    pw0=(u32x4){PKW(pB0,0),PKW(pB0,2),PKW(pB0,4),PKW(pB0,6)};pw1=(u32x4){PKW(pB0,8),PKW(pB0,10),PKW(pB0,12),PKW(pB0,14)};pw2=(u32x4){PKW(pB1,0),PKW(pB1,2),PKW(pB1,4),PKW(pB1,6)};pw3=(u32x4){PKW(pB1,8),PKW(pB1,10),PKW(pB1,12),PKW(pB1,14)};
    SBAR(); pv(o,vb0+sl_cur,PAF(0),PAF(1),PAF(2),PAF(3)); }
  #undef PKW
  #undef PAF
  #undef VFR
  #undef PIN
  #undef MX3
  #undef GAPA
  #undef GAPB
  #undef EX
  #undef VRD
  #undef KRD
  #undef STEP
  #undef ENDW
  {auto rr=__builtin_amdgcn_permlane32_swap(__float_as_uint(l_reg),__float_as_uint(l_reg),false,false);l_reg=__uint_as_float(rr[0])+__uint_as_float(rr[1]);}
  if(hi==0)wsf[32+r32]=l_reg;asm volatile("s_waitcnt lgkmcnt(0)":::"memory");
  float rli[16];
  #pragma unroll
  for(int r=0;r<16;++r)rli[r]=__builtin_amdgcn_rcpf(wsf[32+crow(r,hi)]);
  bf16*Ow=Ou+(long)(wid*QBLK)*OP;
  { bf16*stg=(bf16*)(shm+LDS_OST)+wid*2048;
    #pragma unroll
    for(int r=0;r<16;++r){const int orow=crow(r,hi);
      #pragma unroll
      for(int d0=0;d0<2;++d0)stg[orow*64+d0*32+r32]=(bf16)f2bf_t(o[d0][r]*rli[r]);}
    asm volatile("s_waitcnt lgkmcnt(0)":::"memory");
    #pragma unroll
    for(int i=0;i<4;++i){const int row=i*8+(lane>>3),ch=lane&7; const u32x4 v=*(const u32x4*)(stg+row*64+ch*8); ATTN_STORE16(Ow+(long)row*OP+ch*8,v);} }
  asm volatile("s_waitcnt lgkmcnt(0)\n\ts_barrier":::"memory");
  #undef DMA_K
  #undef KOFF
  #undef WAIT_KV
  #undef DMA_V
  #undef CMASK
  #undef START
  #undef RESC
  #undef ROT
}

#undef SBAR
#undef WAIT_BAR
}

struct Fr { int lane, wave, gw, NGW, vcu, G; LAS unsigned char* lds; };

__device__ __forceinline__ void tr_item(const float* W, int K, int N, bf16_t* WT, int drow0, int k0, int n0, LAS float* scr, int lane, const float wsc = 1.0f) {
    { f32x4 w[8];
#pragma unroll
      for (int i = 0; i < 8; ++i) w[i] = *(const f32x4*)(W + (size_t)(k0 + 8 * i + (lane >> 3)) * N + n0 + 4 * (lane & 7));
#pragma unroll
      for (int i = 0; i < 8; ++i) { LAS float* d = scr + (8 * i + (lane >> 3)) * 33 + 4 * (lane & 7); d[0] = w[i].x; d[1] = w[i].y; d[2] = w[i].z; d[3] = w[i].w; } }
    asm volatile("s_waitcnt lgkmcnt(0)" ::: "memory");
    const int c = lane & 7;
#pragma unroll
    for (int j = 0; j < 4; ++j) { const int n = (lane >> 3) + 8 * j; const LAS float* s = scr + (8 * c) * 33 + n;
        u32x4 o; o.x = pk2(s[0 * 33] * wsc, s[1 * 33] * wsc); o.y = pk2(s[2 * 33] * wsc, s[3 * 33] * wsc); o.z = pk2(s[4 * 33] * wsc, s[5 * 33] * wsc); o.w = pk2(s[6 * 33] * wsc, s[7 * 33] * wsc);
        *(u32x4*)(WT + (size_t)(drow0 + n) * K + k0 + 8 * c) = o; }
    asm volatile("s_waitcnt lgkmcnt(0)" ::: "memory");
}

constexpr int I_FI = 16 * 176, I_FO = 44 * 32, I_EIN = 16 * 61, I_EQB = 4 * 24, I_EKVB = 2 * 32, I_SQ = 16 * 32, I_OIN = 16 * 56;
constexpr int I_E4 = I_EIN + I_EQB + I_EKVB + I_SQ, I_O2 = I_OIN + I_SQ;
constexpr int N_TR0 = 2 * I_FI + 2 * I_FO + I_E4, N_TR1 = 2 * I_FI + 2 * I_FO + I_O2;
__device__ __forceinline__ void tr_decode(const Params& P, const Fr& F, int it, LAS float* scr) {
    unsigned char* ws = P.ws;
        int r = it;
        if (r < 4 * I_FI) { const int mat = r / I_FI; r -= mat * I_FI; const int kb = r / 176, nb = r % 176, n0 = nb * 32, g = n0 / DFF, j = n0 - g * DFF;
            tr_item(P.w_ffn_in + (size_t)mat * DM * NFI, DM, NFI, (bf16_t*)(ws + WS_WFI) + (size_t)mat * NFI * DM, (j / 128) * 256 + g * 128 + (j % 128), kb * 64, n0, scr, F.lane, g ? -0.6931471805599453f : -1.4426950408889634f); return; }
        r -= 4 * I_FI;
        if (r < 4 * I_FO) { const int mat = r / I_FO; r -= mat * I_FO; const int kb = r / 32, nb = r % 32;
            tr_item(P.w_ffn_out + (size_t)mat * DFF * DM, DFF, DM, (bf16_t*)(ws + WS_WFO) + (size_t)mat * DM * DFF, nb * 32, kb * 64, nb * 32, scr, F.lane); return; }
        r -= 4 * I_FO;
        if (r < I_EIN) { const int kb = r / 61, nb = r % 61, n0 = nb * 32; int dr = n0;
            if (n0 >= 512 && n0 < 1024) { const int j = n0 - 512; dr = 512 + (j / 128) * 256 + (j % 128); } else if (n0 >= 1024 && n0 < 1536) { const int j = n0 - 1024; dr = 512 + (j / 128) * 256 + 128 + (j % 128); }
            tr_item(P.e_w_in, DM, E_IN, (bf16_t*)(ws + WS_EWIN), dr, kb * 64, n0, scr, F.lane); return; }
        r -= I_EIN;
        if (r < I_EQB) { const int kb = r / 24, nb = r % 24; tr_item(P.e_w_q_b, 256, 768, (bf16_t*)(ws + WS_EWQB), nb * 32, kb * 64, nb * 32, scr, F.lane); return; }
        r -= I_EQB;
        if (r < I_EKVB) { const int kb = r / 32, nb = r % 32; tr_item(P.e_w_kv_b, 128, 1024, (bf16_t*)(ws + WS_EWKVB), nb * 32, kb * 64, nb * 32, scr, F.lane); return; }
        r -= I_EKVB;
        if (r < I_SQ) { const int kb = r / 32, nb = r % 32; tr_item(P.e_w_out, DM, DM, (bf16_t*)(ws + WS_EWOUT), nb * 32, kb * 64, nb * 32, scr, F.lane); return; }
        r -= I_SQ;
        if (r < I_OIN) { const int kb = r / 56, nb = r % 56, n0 = nb * 32; int dr = n0;
            if (n0 >= 1280) { const int j = n0 - 1280; dr = 768 + (j / 128) * 256 + 128 + (j % 128); } else if (n0 >= 768) { const int j = n0 - 768; dr = 768 + (j / 128) * 256 + (j % 128); }
            tr_item(P.o_w_in, DM, O_IN, (bf16_t*)(ws + WS_OWIN), dr, kb * 64, n0, scr, F.lane); return; }
        r -= I_OIN;
        { const int kb = r / 32, nb = r % 32; tr_item(P.o_w_out, DM, DM, (bf16_t*)(ws + WS_OWOUT), nb * 32, kb * 64, nb * 32, scr, F.lane); }
}
__device__ __forceinline__ void tr_items(const Params& P, const Fr& F, int which, int worker, int nworkers) {
    LAS float* scr = (LAS float*)(F.lds + F.wave * 16384);
    const int n = which ? N_TR1 : N_TR0;
    for (int v = worker; v < n; v += nworkers) { int it;
        if (v < 2 * I_FI) it = which * 2 * I_FI + v;
        else if (v < 2 * I_FI + 2 * I_FO) it = 4 * I_FI + which * 2 * I_FO + (v - 2 * I_FI);
        else it = 4 * I_FI + 4 * I_FO + which * I_E4 + (v - 2 * I_FI - 2 * I_FO);
        tr_decode(P, F, it, scr); }
}
__device__ __forceinline__ void p0_prologue(const Params& P, const Fr& F0, const bool do_mod) {
    Fr F = F0; F.lane = fresh_lane();
    unsigned char* ws = P.ws;
    tr_items(P, F, 0, F.gw, F.NGW);
    { u32x4* z = (u32x4*)((bf16_t*)(ws + WS_EWIN) + (size_t)E_IN * DM); const int n16 = 96 * DM * 2 / 16;
      for (int i = F.gw * 64 + F.lane; i < n16; i += F.NGW * 64) z[i] = (u32x4){0u, 0u, 0u, 0u}; }
    if (do_mod) { float* MOD = (float*)(ws + WS_MOD);
      for (int it = F.gw; it < 2 * 36 * 16; it += F.NGW) {
          const int l = it / (36 * 16), r = it % (36 * 16), jb = r / 16, kc = r % 16, k0 = kc * 64;
          const float s0 = silu_f(P.c[k0 + F.lane]), s1 = silu_f(P.c[DM + k0 + F.lane]), s2 = silu_f(P.c_ctx[k0 + F.lane]);
          const float* wp = P.w_mod + ((size_t)l * DM + k0) * 9216 + jb * 256 + F.lane * 4;
          f32x4 a0 = {0.f, 0.f, 0.f, 0.f}, a1 = a0, a2 = a0;
#pragma unroll 8
          for (int k = 0; k < 64; ++k) { const f32x4 w = *(const f32x4*)(wp + (size_t)k * 9216); a0 += w * rdlane(s0, k); a1 += w * rdlane(s1, k); a2 += w * rdlane(s2, k); }
          if (kc == 0) { const f32x4 bv = *(const f32x4*)(P.b_mod + (size_t)l * 9216 + jb * 256 + F.lane * 4); a0 += bv; a1 += bv; a2 += bv; }
          float* mp = MOD + (size_t)l * 3 * 9216 + jb * 256 + F.lane * 4;
#pragma unroll
          for (int e = 0; e < 4; ++e) { atomicAdd(mp + e, a0[e]); atomicAdd(mp + 9216 + e, a1[e]); atomicAdd(mp + 2 * 9216 + e, a2[e]); }
      } }
    { f32x2* rt = (f32x2*)(ws + WS_ROPE);
      for (int i = F.gw * 64 + F.lane; i < 2 * 128 * 16; i += F.NGW * 64) {
          const int kind = i >> 11, pos = (i >> 4) & 127, f = i & 15; const float nf = kind ? 16.f : 8.f;
          const float inv = exp2f(-((float)f / nf) * 13.287712379549449f);
          const float ang = (float)pos * inv;
          const double rev = (double)ang * 0.15915494309189535; const float fr_ = (float)(rev - __builtin_rint(rev));
          rt[i] = (f32x2){__builtin_amdgcn_cosf(fr_), __builtin_amdgcn_sinf(fr_)}; } }
}

__device__ __forceinline__ void ld8(const bf16_t* p, float (&f)[8]) { unpack8(*(const u32x4*)p, f); }
__device__ __forceinline__ void ldf8(const float* p, float (&f)[8]) { const f32x4 a = *(const f32x4*)p, b = *(const f32x4*)(p + 4); f[0] = a.x; f[1] = a.y; f[2] = a.z; f[3] = a.w; f[4] = b.x; f[5] = b.y; f[6] = b.z; f[7] = b.w; }
__device__ __forceinline__ void norm_finish(float (&v0)[8], float (&v1)[8], const float (&g0)[8], const float (&g1)[8], const float* shp, bf16_t* arow) {
    float s = 0.f;
#pragma unroll
    for (int i = 0; i < 8; ++i) s += v0[i] * v0[i] + v1[i] * v1[i];
    const float rstd = 1.f / sqrtf(wave_sum(s) * (1.f / DM) + EPS);
    float sh0[8], sh1[8], sc0[8], sc1[8]; ldf8(shp, sh0); ldf8(shp + 512, sh1); ldf8(shp + DM, sc0); ldf8(shp + DM + 512, sc1);
    float o0[8], o1[8];
#pragma unroll
    for (int i = 0; i < 8; ++i) { o0[i] = v0[i] * rstd * g0[i] * (sc0[i] + 1.f) + sh0[i]; o1[i] = v1[i] * rstd * g1[i] * (sc1[i] + 1.f) + sh1[i]; }
    *(u32x4*)arow = pack8(o0); *(u32x4*)(arow + 512) = pack8(o1);
}
__device__ __forceinline__ void norm_phase(const Params& P, const Fr& F0, int l, int j, int nslab) {
    Fr F = F0; F.lane = fresh_lane();
    bf16_t* Hb = (bf16_t*)(P.ws + WS_H); bf16_t* A = (bf16_t*)(P.ws + WS_A); const float* MOD = (const float*)(P.ws + WS_MOD);
    const int c0 = F.lane * 8;
    float g0[8], g1[8]; ldf8(P.norm_g + (size_t)(l * 3 + j) * DM + c0, g0); ldf8(P.norm_g + (size_t)(l * 3 + j) * DM + 512 + c0, g1);
    const bool from_input = (l == 0 && j == 0), ctx_from_input = (l == 0 && j <= 1);
    const bool uneven = (nslab > 0) && (F.NGW == 2048);
    const int rbase = uneven ? (F.gw < 512 ? F.gw : 1024 + (F.gw - 512)) : F.gw, rstride = uneven ? (F.gw < 512 ? 512 : 1536) : F.NGW, rend = uneven ? (F.gw < 512 ? 1024 : NB * SEQ) : NB * SEQ;
    for (int r = rbase; r < rend; r += 2 * rstride) { const int ra = r, rb = (r + rstride < rend) ? r + rstride : r;
        const int ba = ra / SEQ, bb = rb / SEQ; const size_t rowa = (size_t)ba * SEQT + (ra - ba * SEQ), rowb = (size_t)bb * SEQT + (rb - bb * SEQ);
        float va0[8], va1[8], vb0[8], vb1[8];
        if (from_input) { const float* pa = P.x + (size_t)ra * DM + c0; const float* pb = P.x + (size_t)rb * DM + c0;
            const f32x4 a0 = *(const f32x4*)pa, a1 = *(const f32x4*)(pa + 4), a2 = *(const f32x4*)(pa + 512), a3 = *(const f32x4*)(pa + 516), b0 = *(const f32x4*)pb, b1 = *(const f32x4*)(pb + 4), b2 = *(const f32x4*)(pb + 512), b3 = *(const f32x4*)(pb + 516);
#pragma unroll
            for (int i = 0; i < 4; ++i) { va0[i] = a0[i]; va0[4 + i] = a1[i]; va1[i] = a2[i]; va1[4 + i] = a3[i]; vb0[i] = b0[i]; vb0[4 + i] = b1[i]; vb1[i] = b2[i]; vb1[4 + i] = b3[i]; } }
        else { const u32x4 a0 = *(const u32x4*)(Hb + rowa * DM + c0), a1 = *(const u32x4*)(Hb + rowa * DM + 512 + c0), b0 = *(const u32x4*)(Hb + rowb * DM + c0), b1 = *(const u32x4*)(Hb + rowb * DM + 512 + c0);
            unpack8(a0, va0); unpack8(a1, va1); unpack8(b0, vb0); unpack8(b1, vb1); }
        norm_finish(va0, va1, g0, g1, MOD + ((size_t)(l * 3 + ba) * 9 + 3 * j) * DM + c0, A + rowa * DM + c0);
        if (rb != ra) norm_finish(vb0, vb1, g0, g1, MOD + ((size_t)(l * 3 + bb) * 9 + 3 * j) * DM + c0, A + rowb * DM + c0); }
    for (int r = F.gw; r < NB * CTXL; r += F.NGW) { const int b = r / CTXL, tc = r - b * CTXL; const size_t row = (size_t)b * SEQT + SEQ + tc;
        float v0[8], v1[8];
        if (ctx_from_input) { const float* inrow = P.ctx + (size_t)r * DM; ldf8(inrow + c0, v0); ldf8(inrow + 512 + c0, v1); }
        else { ld8(Hb + row * DM + c0, v0); ld8(Hb + row * DM + 512 + c0, v1); }
        if (nslab > 0) {
            const float* prb = (const float*)(P.ws + WS_PART); const unsigned po = (unsigned)r * DM + (unsigned)c0;
            for (int sl = 0; sl < nslab; sl += 6) {
                f32x4 w[6][4]; float mk[6];
#pragma unroll
                for (int q = 0; q < 6; ++q) { const bool ok = (sl + q < nslab); const float* p = prb + (po + (unsigned)(ok ? sl + q : sl) * (512u * DM)); mk[q] = ok ? 1.f : 0.f;
                    w[q][0] = *(const f32x4*)p; w[q][1] = *(const f32x4*)(p + 4); w[q][2] = *(const f32x4*)(p + 512); w[q][3] = *(const f32x4*)(p + 516); }
#pragma unroll
                for (int q = 0; q < 6; ++q) {
#pragma unroll
                    for (int i = 0; i < 4; ++i) { v0[i] += mk[q] * w[q][0][i]; v0[4 + i] += mk[q] * w[q][1][i]; v1[i] += mk[q] * w[q][2][i]; v1[4 + i] += mk[q] * w[q][3][i]; } } }
            *(u32x4*)(Hb + row * DM + c0) = pack8(v0); *(u32x4*)(Hb + row * DM + 512 + c0) = pack8(v1); }
        norm_finish(v0, v1, g0, g1, MOD + ((size_t)(l * 3 + 2) * 9 + 3 * j) * DM + c0, A + row * DM + c0); }
}
__device__ __forceinline__ void final_norm(const Params& P, const Fr& F0) {
    Fr F = F0; F.lane = fresh_lane();
    const bf16_t* Hb = (const bf16_t*)(P.ws + WS_H); const int c0 = F.lane * 8;
    float g0[8], g1[8]; ldf8(P.final_g + c0, g0); ldf8(P.final_g + 512 + c0, g1);
    for (int r0 = F.gw; r0 < NB * SEQ; r0 += 2 * F.NGW) { const int ra = r0, rb = (r0 + F.NGW < NB * SEQ) ? r0 + F.NGW : r0;
        const int ba = ra / SEQ, bb = rb / SEQ; const size_t rowa = (size_t)ba * SEQT + (ra - ba * SEQ), rowb = (size_t)bb * SEQT + (rb - bb * SEQ);
        const u32x4 ra0 = *(const u32x4*)(Hb + rowa * DM + c0), ra1 = *(const u32x4*)(Hb + rowa * DM + 512 + c0), rb0 = *(const u32x4*)(Hb + rowb * DM + c0), rb1 = *(const u32x4*)(Hb + rowb * DM + 512 + c0);
#pragma unroll
        for (int h = 0; h < 2; ++h) { float v0[8], v1[8]; unpack8(h ? rb0 : ra0, v0); unpack8(h ? rb1 : ra1, v1); const int r = h ? rb : ra; if (h && rb == ra) break;
        float s = 0.f;
#pragma unroll
        for (int i = 0; i < 8; ++i) s += v0[i] * v0[i] + v1[i] * v1[i];
        const float rstd = 1.f / sqrtf(wave_sum(s) * (1.f / DM) + EPS);
        float* op = P.out + (size_t)r * DM + c0;
        *(f32x4*)op = (f32x4){v0[0] * rstd * g0[0], v0[1] * rstd * g0[1], v0[2] * rstd * g0[2], v0[3] * rstd * g0[3]};
        *(f32x4*)(op + 4) = (f32x4){v0[4] * rstd * g0[4], v0[5] * rstd * g0[5], v0[6] * rstd * g0[6], v0[7] * rstd * g0[7]};
        *(f32x4*)(op + 512) = (f32x4){v1[0] * rstd * g1[0], v1[1] * rstd * g1[1], v1[2] * rstd * g1[2], v1[3] * rstd * g1[3]};
        *(f32x4*)(op + 516) = (f32x4){v1[4] * rstd * g1[4], v1[5] * rstd * g1[5], v1[6] * rstd * g1[6], v1[7] * rstd * g1[7]}; } }
}


__device__ __forceinline__ void elem_even(const Params& P, const Fr& F0) {
    Fr F = F0; F.lane = fresh_lane();
    const bf16_t* PP = (const bf16_t*)(P.ws + WS_P); bf16_t* Y = (bf16_t*)(P.ws + WS_Y); bf16_t* QAN = (bf16_t*)(P.ws + WS_QAN); bf16_t* KVAN = (bf16_t*)(P.ws + WS_KVAN); bf16_t* KR = (bf16_t*)(P.ws + WS_KR);
    const f32x2* rope = (const f32x2*)(P.ws + WS_ROPE);
    const int lane = F.lane, ch0 = lane * 8;
    float w0[8], w1[8], w2[8]; ldf8(P.e_conv_w + ch0, w0); ldf8(P.e_conv_w + 512 + ch0, w1); ldf8(P.e_conv_w + 1024 + ch0, w2);
    const int seg = lane < 32 ? 0 : lane < 48 ? 1 : lane < 52 ? 2 : 3;
    const int scol = lane < 32 ? 1536 + lane * 8 : lane < 48 ? 1792 + (lane - 32) * 8 : lane < 52 ? 1920 + (lane - 48) * 8 : 0;
    float gn[8];
    if (seg == 0) ldf8(P.e_q_norm + lane * 8, gn); else if (seg == 1) ldf8(P.e_kv_norm + (lane - 32) * 8, gn); else { for (int i = 0; i < 8; ++i) gn[i] = 1.f; }
    u32x4 rsb, rc0, rx0, rsv, rcm, rxm, rcp, rxp; float mmk, mpk;
#define EV_LOAD(rw) do { const int b_ = (rw) / SEQT, t_ = (rw) - b_ * SEQT; const bool lat_ = t_ < SEQ; const int s0_ = lat_ ? 0 : SEQ, s1_ = lat_ ? SEQ : SEQT; \
        const bool hm_ = (t_ - 1 >= s0_), hp_ = (t_ + 1 < s1_); const bf16_t* Pr_ = PP + (size_t)(rw) * E_INP; const bf16_t* Pm_ = hm_ ? Pr_ - E_INP : Pr_; const bf16_t* Pp_ = hp_ ? Pr_ + E_INP : Pr_; \
        rsb = *(const u32x4*)(Pr_ + ch0); rc0 = *(const u32x4*)(Pr_ + 512 + ch0); rx0 = *(const u32x4*)(Pr_ + 1024 + ch0); rsv = *(const u32x4*)(Pr_ + scol); \
        rcm = *(const u32x4*)(Pm_ + 512 + ch0); rxm = *(const u32x4*)(Pm_ + 1024 + ch0); rcp = *(const u32x4*)(Pp_ + 512 + ch0); rxp = *(const u32x4*)(Pp_ + 1024 + ch0); mmk = hm_ ? 1.f : 0.f; mpk = hp_ ? 1.f : 0.f; } while (0)
    if (F.gw < T) EV_LOAD(F.gw);
    for (int row = F.gw; row < T; row += F.NGW) { const int b = row / SEQT, t = row - b * SEQT; const bool lat = t < SEQ;
        float sb[8], c0[8], x0[8], cm[8], xm[8], cp[8], xp[8], sv[8];
        unpack8(rsb, sb); unpack8(rc0, c0); unpack8(rx0, x0); unpack8(rsv, sv); unpack8(rcm, cm); unpack8(rxm, xm); unpack8(rcp, cp); unpack8(rxp, xp);
        const float mm = mmk, mp = mpk;
        { const int nrow = (row + F.NGW < T) ? row + F.NGW : row; EV_LOAD(nrow); }
#pragma unroll
        for (int i = 0; i < 8; ++i) { cm[i] *= mm; cp[i] *= mp; }
        float ya[8];
#pragma unroll
        for (int i = 0; i < 8; ++i) ya[i] = sb[i] * (w0[i] * (cm[i] * xm[i]) + w1[i] * (c0[i] * x0[i]) + w2[i] * (cp[i] * xp[i]));
        *(u32x4*)(Y + (size_t)row * DM + ch0) = pack8(ya);
        float ss = 0.f;
#pragma unroll
        for (int i = 0; i < 8; ++i) ss += sv[i] * sv[i];
        const float sq = wave_sum(seg == 0 ? ss : 0.f), skv = wave_sum(seg == 1 ? ss : 0.f);
        if (seg == 0) { const float rstd = 1.f / sqrtf(sq * (1.f / 256.f) + EPS); float o[8];
#pragma unroll
            for (int i = 0; i < 8; ++i) o[i] = sv[i] * rstd * gn[i];
            *(u32x4*)(QAN + (size_t)row * 256 + lane * 8) = pack8(o); }
        else if (seg == 1) { const float rstd = 1.f / sqrtf(skv * (1.f / 128.f) + EPS); float o[8];
#pragma unroll
            for (int i = 0; i < 8; ++i) o[i] = sv[i] * rstd * gn[i];
            *(u32x4*)(KVAN + (size_t)row * 128 + (lane - 32) * 8) = pack8(o); }
        else if (seg == 2) { const int j = lane - 48; float o[8];
#pragma unroll
            for (int p = 0; p < 4; ++p) { const int i = 4 * j + p; float cs = 1.f, sn = 0.f;
                if (lat) { const int pos = (i < 8) ? (t >> 6) : (t & 63); const f32x2 r2 = rope[pos * 16 + (i & 7)]; cs = r2.x; sn = r2.y; }
                o[2 * p] = sv[2 * p] * cs - sv[2 * p + 1] * sn; o[2 * p + 1] = sv[2 * p] * sn + sv[2 * p + 1] * cs; }
            *(u32x4*)(KR + (size_t)row * 32 + j * 8) = pack8(o); } }
#undef EV_LOAD
}
__device__ __forceinline__ void conv_even(const Params& P, const Fr& F0, const int row0_, const int row1_, const int worker, const int nworkers) {
    Fr F = F0; F.lane = fresh_lane();
    const bf16_t* SB = (const bf16_t*)(P.ws + WS_SB); const bf16_t* CX = (const bf16_t*)(P.ws + WS_CX); bf16_t* Y = (bf16_t*)(P.ws + WS_Y);
    const int ch0 = F.lane * 8;
    float w0[8], w1[8], w2[8]; ldf8(P.e_conv_w + ch0, w0); ldf8(P.e_conv_w + 512 + ch0, w1); ldf8(P.e_conv_w + 1024 + ch0, w2);
    u32x4 rsb, rc0, rcm, rcp; float mmk, mpk;
#define CE_LOAD(rw) do { const int b_ = (rw) / SEQT, t_ = (rw) - b_ * SEQT; const bool lat_ = t_ < SEQ; const int s0_ = lat_ ? 0 : SEQ, s1_ = lat_ ? SEQ : SEQT; \
        const bool hm_ = (t_ - 1 >= s0_), hp_ = (t_ + 1 < s1_); const bf16_t* C_ = CX + (size_t)(rw) * 512 + ch0; \
        rsb = *(const u32x4*)(SB + (size_t)(rw) * 512 + ch0); rc0 = *(const u32x4*)C_; rcm = *(const u32x4*)(hm_ ? C_ - 512 : C_); rcp = *(const u32x4*)(hp_ ? C_ + 512 : C_); mmk = hm_ ? 1.f : 0.f; mpk = hp_ ? 1.f : 0.f; } while (0)
    if (row0_ + worker < row1_) CE_LOAD(row0_ + worker);
    for (int row = row0_ + worker; row < row1_; row += nworkers) {
        float sb[8], c0[8], cm[8], cp[8]; unpack8(rsb, sb); unpack8(rc0, c0); unpack8(rcm, cm); unpack8(rcp, cp);
        const float mm = mmk, mp = mpk;
        { const int nrow = (row + nworkers < row1_) ? row + nworkers : row; CE_LOAD(nrow); }
        float ya[8];
#pragma unroll
        for (int i = 0; i < 8; ++i) ya[i] = sb[i] * (w0[i] * (cm[i] * mm) + w1[i] * c0[i] + w2[i] * (cp[i] * mp));
        *(u32x4*)(Y + (size_t)row * DM + ch0) = pack8(ya); }
#undef CE_LOAD
}
__device__ __forceinline__ void kr_copy(const Params& P, const Fr& F0) {
    Fr F = F0; F.lane = fresh_lane();
    const bf16_t* KR = (const bf16_t*)(P.ws + WS_KR); bf16_t* K = (bf16_t*)(P.ws + WS_EK);
    for (int row = F.gw; row < T; row += F.NGW) { const int h = F.lane >> 3, q = F.lane & 7;
        const u32x2 v = *(const u32x2*)(KR + (size_t)row * 32 + q * 4); *(u32x2*)(K + (size_t)row * 768 + h * 96 + 64 + q * 4) = v; }
}
__device__ __forceinline__ void elem_odd(const Params& P, const Fr& F0) {
    Fr F = F0; F.lane = fresh_lane();
    const bf16_t* PP = (const bf16_t*)(P.ws + WS_P); bf16_t* Q = (bf16_t*)(P.ws + WS_OQ); bf16_t* K = (bf16_t*)(P.ws + WS_OK);
    const f32x2* rope = (const f32x2*)(P.ws + WS_ROPE) + 2048;
    const int lane = F.lane, l8 = lane & 7;
    float gq[8], gk[8]; ldf8(P.o_q_norm + l8 * 8, gq); ldf8(P.o_k_norm + l8 * 8, gk);
    u32x4 rq_, rk_; f32x2 rr_[4];
#define OD_LOAD(rw) do { const int b_ = (rw) / SEQT, t_ = (rw) - b_ * SEQT; const bool lat_ = t_ < SEQ; const bf16_t* Pr_ = PP + (size_t)(rw) * 768; \
        rq_ = *(const u32x4*)(Pr_ + lane * 8); rk_ = *(const u32x4*)(Pr_ + 512 + (lane & 15) * 8); \
        _Pragma("unroll") for (int p_ = 0; p_ < 4; ++p_) { const int i_ = 4 * l8 + p_; const int pos_ = lat_ ? ((i_ < 16) ? (t_ >> 6) : (t_ & 63)) : 0; const f32x2 r2_ = rope[pos_ * 16 + (i_ & 15)]; rr_[p_] = lat_ ? r2_ : (f32x2){1.f, 0.f}; } } while (0)
    if (F.gw < T) OD_LOAD(F.gw);
    for (int row = F.gw; row < T; row += F.NGW) {
        float q[8], k[8]; unpack8(rq_, q); unpack8(rk_, k);
        float cs[4], sn[4];
#pragma unroll
        for (int p = 0; p < 4; ++p) { cs[p] = rr_[p].x; sn[p] = rr_[p].y; }
        { const int nrow = (row + F.NGW < T) ? row + F.NGW : row; OD_LOAD(nrow); }
        float sq = 0.f, sk = 0.f;
#pragma unroll
        for (int i = 0; i < 8; ++i) { sq += q[i] * q[i]; sk += k[i] * k[i]; }
        sq += swz<0x041F>(sq); sq += swz<0x081F>(sq); sq += swz<0x101F>(sq);
        sk += swz<0x041F>(sk); sk += swz<0x081F>(sk); sk += swz<0x101F>(sk);
        const float rq = 1.f / sqrtf(sq * (1.f / 64.f) + EPS), rk = 1.f / sqrtf(sk * (1.f / 64.f) + EPS);
        float qo[8], ko[8];
#pragma unroll
        for (int p = 0; p < 4; ++p) { const float q0 = q[2 * p] * rq * gq[2 * p], q1 = q[2 * p + 1] * rq * gq[2 * p + 1]; qo[2 * p] = (q0 * cs[p] - q1 * sn[p]) * C2_GQA; qo[2 * p + 1] = (q0 * sn[p] + q1 * cs[p]) * C2_GQA;
            const float k0 = k[2 * p] * rk * gk[2 * p], k1 = k[2 * p + 1] * rk * gk[2 * p + 1]; ko[2 * p] = k0 * cs[p] - k1 * sn[p]; ko[2 * p + 1] = k0 * sn[p] + k1 * cs[p]; }
        *(u32x4*)(Q + (size_t)row * 512 + lane * 8) = pack8(qo);
        if (lane < 16) *(u32x4*)(K + (size_t)row * 128 + lane * 8) = pack8(ko); }
#undef OD_LOAD
}
__device__ __forceinline__ void conv_odd(const Params& P, const Fr& F0) {
    Fr F = F0; F.lane = fresh_lane();
    const bf16_t* G = (const bf16_t*)(P.ws + WS_G); bf16_t* Y = (bf16_t*)(P.ws + WS_Y);
    const int lane = F.lane, ch0 = lane * 8;
    constexpr int TK = 8;
    float bias[8], lg[8], lb[8]; ldf8(P.o_conv_b + ch0, bias); ldf8(P.o_ln_g + ch0, lg); ldf8(P.o_ln_b + ch0, lb);
    for (int it = F.gw; it < NB * SEQ / TK; it += F.NGW) { const int b = it / (SEQ / TK), t0 = (it - b * (SEQ / TK)) * TK;
        const bf16_t* Gb = G + (size_t)b * SEQT * 512 + ch0;
        float acc[TK][8];
#pragma unroll
        for (int q = 0; q < TK; ++q)
#pragma unroll
            for (int i = 0; i < 8; ++i) acc[q][i] = bias[i];
        u32x4 gcur[TK + 3];
#pragma unroll
        for (int r = 0; r < TK + 3; ++r) { const int tt = t0 - 15 + r; gcur[r] = (tt >= 0 && tt < SEQ) ? *(const u32x4*)(Gb + (size_t)tt * 512) : (u32x4){0u, 0u, 0u, 0u}; }
#pragma unroll 1
        for (int jc = 0; jc < 32; jc += 4) {
            u32x4 gnxt[TK + 3]; float w[4][8];
#pragma unroll
            for (int jj = 0; jj < 4; ++jj) { if (jc + jj < 31) ldf8(P.o_conv_w + (jc + jj) * 512 + ch0, w[jj]); else { for (int i = 0; i < 8; ++i) w[jj][i] = 0.f; } }
#pragma unroll
            for (int r = 0; r < TK + 3; ++r) { const int tt = t0 + jc + 4 - 15 + r; gnxt[r] = (jc + 4 < 32 && tt >= 0 && tt < SEQ) ? *(const u32x4*)(Gb + (size_t)tt * 512) : (u32x4){0u, 0u, 0u, 0u}; }
#pragma unroll
            for (int r = 0; r < TK + 3; ++r) { float gv[8]; unpack8(gcur[r], gv);
#pragma unroll
                for (int q = 0; q < TK; ++q) { const int jj = r - q; if (jj >= 0 && jj < 4) {
#pragma unroll
                    for (int i = 0; i < 8; ++i) acc[q][i] += w[jj][i] * gv[i]; } } }
#pragma unroll
            for (int r = 0; r < TK + 3; ++r) gcur[r] = gnxt[r]; }
#pragma unroll
        for (int q = 0; q < TK; ++q) { float s = 0.f;
#pragma unroll
            for (int i = 0; i < 8; ++i) s += acc[q][i];
            const float mu = wave_sum(s) * (1.f / 512.f); float s2 = 0.f;
#pragma unroll
            for (int i = 0; i < 8; ++i) { acc[q][i] -= mu; s2 += acc[q][i] * acc[q][i]; }
            const float rstd = 1.f / sqrtf(wave_sum(s2) * (1.f / 512.f) + EPS); float o[8];
#pragma unroll
            for (int i = 0; i < 8; ++i) o[i] = silu_f(acc[q][i] * rstd * lg[i] + lb[i]);
            *(u32x4*)(Y + ((size_t)b * SEQT + t0 + q) * DM + 512 + ch0) = pack8(o); } }
}

#define XB_TMO      128
#define XB_XCNT(j)  (256  + 64 * (j))
#define XB_XSUB(j)  (1280 + 64 * (j))
#define XB_XGEN(j)  (2304 + 64 * (j))
#define XB_TOP      3328
#define XB_TOPGEN   3392
#define XCD_BAR_WORDS 3456
#define XB_SPIN_CAP (1u << 18)

__device__ __forceinline__ unsigned xb_ld(unsigned* p)              { return __hip_atomic_load(p, __ATOMIC_RELAXED, __HIP_MEMORY_SCOPE_AGENT); }
__device__ __forceinline__ unsigned xb_add(unsigned* p, unsigned v) { return __hip_atomic_fetch_add(p, v, __ATOMIC_RELAXED, __HIP_MEMORY_SCOPE_AGENT); }
__device__ __forceinline__ unsigned xb_xcc_id() { return (unsigned)__builtin_amdgcn_s_getreg((3 << 11) | 20) & 0xFu; }
#define XB_SPIN(cond, bar) do { unsigned _sp = 0; while (cond) { __builtin_amdgcn_s_sleep(1); \
    if ((++_sp & 255u) == 0u) { if (xb_ld(&(bar)[XB_TMO])) break; if (_sp > XB_SPIN_CAP) { atomicAdd(&(bar)[XB_TMO], 1u); break; } } } } while (0)

struct XcdBarrier {
    unsigned* bar; unsigned x;
    volatile __attribute__((address_space(3))) unsigned* st;
};

__device__ __forceinline__ XcdBarrier xcd_barrier_post(unsigned* bar, volatile __attribute__((address_space(3))) unsigned* st) {
    XcdBarrier b; b.bar = bar; b.x = xb_xcc_id(); b.st = st;
    if (threadIdx.x == 0) (void)xb_add(&bar[XB_XCNT(b.x)], 1u);
    return b;
}
__device__ __forceinline__ void xcd_barrier_complete(unsigned* bar, unsigned x, unsigned& nloc, unsigned& nx) {
    const unsigned G = gridDim.x * gridDim.y * gridDim.z;
    unsigned sum, cnt, mine, sp = 0u;
    for (;;) {
        sum = 0u; cnt = 0u; mine = 0u;
#pragma unroll
        for (unsigned j = 0; j < 16; ++j) { const unsigned c = xb_ld(&bar[XB_XCNT(j)]); sum += c; cnt += (c > 0u) ? 1u : 0u; mine = (j == x) ? c : mine; }
        if (sum == G) break;
        __builtin_amdgcn_s_sleep(1);
        if ((++sp & 255u) == 0u) { if (xb_ld(&bar[XB_TMO])) break; if (sp > XB_SPIN_CAP) { atomicAdd(&bar[XB_TMO], 1u); break; } }
    }
    nloc = mine > 0u ? mine : 1u; nx = cnt > 0u ? cnt : 1u;
}

__device__ __forceinline__ void xcd_barrier(const XcdBarrier& b) {
    asm volatile("s_waitcnt vmcnt(0)" ::: "memory");
    __syncthreads();
    if (threadIdx.x == 0) {
        unsigned* bar = b.bar;
        __builtin_amdgcn_s_waitcnt(0);
        unsigned nloc = b.st[0], nx = b.st[1];
        if (nloc == 0u) { xcd_barrier_complete(bar, b.x, nloc, nx); b.st[0] = nloc; b.st[1] = nx; }
        const unsigned old = xb_add(&bar[XB_XSUB(b.x)], 1u);
        const unsigned gen = old / nloc;
        if (old + 1u == (gen + 1u) * nloc) {
            __builtin_amdgcn_fence(__ATOMIC_RELEASE, "agent");
            asm volatile("s_waitcnt vmcnt(0)" ::: "memory");
            const unsigned og = xb_add(&bar[XB_TOP], 1u);
            const unsigned tg = og / nx;
            if (og + 1u == (tg + 1u) * nx) xb_add(&bar[XB_TOPGEN], 1u);
            else XB_SPIN(xb_ld(&bar[XB_TOPGEN]) == tg, bar);
            __builtin_amdgcn_fence(__ATOMIC_ACQUIRE, "agent");
            xb_add(&bar[XB_XGEN(b.x)], 1u);
            asm volatile("s_waitcnt vmcnt(0)" ::: "memory");
        } else {
            XB_SPIN(xb_ld(&bar[XB_XGEN(b.x)]) == gen, bar);
            __builtin_amdgcn_fence(__ATOMIC_ACQUIRE, "agent");
            asm volatile("s_waitcnt vmcnt(0)" ::: "memory");
        }
    }
    __syncthreads();
}

#ifdef NO_ATTN
#define ATTN6(...) do{}while(0)
#define ATTN4(...) do{}while(0)
#else
#define ATTN6 attn_unit<6>
#define ATTN4 attn_unit<4>
#endif
#ifdef NO_GEMM
#define GEMM(...) do{}while(0)
#define GEMM_ROT(...) do{}while(0)
#else
template <class E> struct EpiOn { static constexpr bool v = true; };
#ifdef ONLY_EPI
template <class E> struct EpiSel { static constexpr bool v = false; }; template <> struct EpiSel<ONLY_EPI> { static constexpr bool v = true; };
#else
template <class E> struct EpiSel { static constexpr bool v = true; };
#endif
#define GEMM(EpiT, Aptr, Bptr, Kdim, nMl, nNt, skipc, SPL, ...) do { if constexpr (EpiSel<EpiT>::v) { pg8::Gemm g_{(const bf16_t*)(Aptr), (const bf16_t*)(Bptr), T, 0, (Kdim)}; pg8::Order S_; S_.init((nMl), (nNt), F.G, (int)blockIdx.x, (skipc), (Kdim) / 64, (SPL)); \
        EpiT E_{__VA_ARGS__}; pg8::gemm_phase<EpiT, pg8::Order, true, true>(F.lds, g_, S_, E_, F.wave); } } while (0)
#define GEMM_ROT(ROT, EpiT, Aptr, Bptr, Kdim, nMl, nNt, skipc, SPL, ...) do { if constexpr (EpiSel<EpiT>::v) { pg8::Gemm g_{(const bf16_t*)(Aptr), (const bf16_t*)(Bptr), T, 0, (Kdim)}; pg8::Order S_; S_.init((nMl), (nNt), F.G, (int)((blockIdx.x + (ROT)) % gridDim.x), (skipc), (Kdim) / 64, (SPL)); \
        EpiT E_{__VA_ARGS__}; pg8::gemm_phase<EpiT, pg8::Order, true, true>(F.lds, g_, S_, E_, F.wave); } } while (0)
#endif

__global__ void __launch_bounds__(NWAVES * 64, 2) hybrid_fwd(Params P) {
    extern __shared__ __attribute__((aligned(16))) unsigned char lds_raw[];
    cg::grid_group grid = cg::this_grid();
    Fr F; F.lds = (LAS unsigned char*)lds_raw; F.lane = 0; F.wave = __builtin_amdgcn_readfirstlane(threadIdx.x >> 6);
    F.G = gridDim.x; { const int bx = blockIdx.x; F.vcu = (F.G % 8 == 0) ? (bx % 8) * (F.G / 8) + bx / 8 : bx; }
    F.gw = F.vcu * NWAVES + F.wave; F.NGW = F.G * NWAVES;
    unsigned char* ws = P.ws;
    bf16_t* Hb = (bf16_t*)(ws + WS_H); const float* MOD = (const float*)(ws + WS_MOD);
    volatile LAS unsigned* MISC = (volatile LAS unsigned*)(F.lds + RING_BYTES + 320);
    if (threadIdx.x < 32) MISC[threadIdx.x] = 0u;
    __syncthreads();
    XcdBarrier xbar = xcd_barrier_post((unsigned*)(ws + WS_CTL) + 4096, MISC + 8);
#define SYNC() xcd_barrier(xbar)
#ifndef PROBE
#define PROBE 0
#endif
#ifndef NO_P0
    if (PROBE & 16) { p0_prologue(P, F, false); SYNC(); }
    p0_prologue(P, F, true);
#endif
    if (P.ws == nullptr) grid.sync();
    SYNC();
    { constexpr int l = 0;
        const float* modl = MOD + (size_t)l * 3 * 9 * DM;
        if (PROBE & 4) { norm_phase(P, F, l, 0, 0); SYNC(); }
        norm_phase(P, F, l, 0, (l == 1) ? 22 : 0); SYNC();
        if (PROBE & 2) { GEMM(EpiSwiglu, ws + WS_A, ws + WS_WFI + (size_t)(l * 2 + 0) * NFI * DM * 2, DM, 66, 22, 0, 0, (bf16_t*)(ws + WS_ACT)); SYNC(); }
        GEMM(EpiSwiglu, ws + WS_A, ws + WS_WFI + (size_t)(l * 2 + 0) * NFI * DM * 2, DM, 66, 22, 0, 0, (bf16_t*)(ws + WS_ACT)); SYNC();
        if (PROBE & 8) { GEMM(EpiResidT<(l == 0)>, ws + WS_ACT, ws + WS_WFO + (size_t)(l * 2 + 0) * DM * DFF * 2, DFF, 64, 4, 1, 22, Hb, modl + 2 * DM, (float*)(ws + WS_PART), P.x, 0.0f); SYNC(); }
        GEMM(EpiResidT<(l == 0)>, ws + WS_ACT, ws + WS_WFO + (size_t)(l * 2 + 0) * DM * DFF * 2, DFF, 64, 4, 1, 22, Hb, modl + 2 * DM, (float*)(ws + WS_PART), P.x, 0.5f); SYNC();
        if (PROBE & 4) { norm_phase(P, F, l, 1, 0); SYNC(); }
        norm_phase(P, F, l, 1, 22); SYNC();
        if (l == 0) {
            GEMM(EpiEvenIn, ws + WS_A, ws + WS_EWIN, DM, 66, 8, 0, 0, (bf16_t*)(ws + WS_SB), (bf16_t*)(ws + WS_CX), (bf16_t*)(ws + WS_QAN), (bf16_t*)(ws + WS_KVAN), (bf16_t*)(ws + WS_EK), P.e_q_norm, P.e_kv_norm, (const f32x2*)(ws + WS_ROPE), (LAS float*)(F.lds + RING_BYTES + 1024));
            if (blockIdx.x >= 16) { Fr F2 = F; F2.lane = fresh_lane(); tr_items(P, F2, 1, ((int)blockIdx.x - 16) * NWAVES + F.wave, (F.G - 16) * NWAVES); }
            SYNC();
            if (F.G == 256) { if (blockIdx.x < 206) conv_even(P, F, 0, 11536, (int)blockIdx.x * NWAVES + F.wave, 206 * NWAVES); else conv_even(P, F, 11536, T, ((int)blockIdx.x - 206) * NWAVES + F.wave, 50 * NWAVES); }
            else conv_even(P, F, 0, T, F.gw, F.NGW);
            GEMM(EpiQb, ws + WS_QAN, ws + WS_EWQB, 256, 66, 3, 0, 0, (bf16_t*)(ws + WS_EQ), (const f32x2*)(ws + WS_ROPE));
            GEMM_ROT(58, EpiKVb, ws + WS_KVAN, ws + WS_EWKVB, 128, 66, 4, 0, 0, (bf16_t*)(ws + WS_EK), (bf16_t*)(ws + WS_EV));
            SYNC();
            for (int rep_ = 0; rep_ < ((PROBE & 1) ? 2 : 1); ++rep_) {
            { const bf16_t* Q = (const bf16_t*)(ws + WS_EQ); const bf16_t* K = (const bf16_t*)(ws + WS_EK); const bf16_t* V = (const bf16_t*)(ws + WS_EV); bf16_t* Y = (bf16_t*)(ws + WS_Y);
              for (int i = 0; i < 2; ++i) { const int u = 2 * F.vcu + i; if (u >= 512) break; const int bh = u >> 5, qb = u & 31, b = bh >> 3, h = bh & 7; const size_t r0 = (size_t)b * SEQT;
                  tat::attn_unit<8, 6, 768, 768, 512, DM>(Q + (r0 + qb * 256) * 768 + h * 96, K + r0 * 768 + h * 96, V + r0 * 512 + h * 64, Y + (r0 + qb * 256) * DM + 512 + h * 64, SEQT / 64, (char*)lds_raw, F.wave); }
              if ((F.vcu & 15) == 0 && F.vcu < 256) { const int bh = F.vcu >> 4, b = bh >> 3, h = bh & 7; const size_t r0 = (size_t)b * SEQT + SEQ;
                  tat::attn_unit<8, 6, 768, 768, 512, DM>(Q + r0 * 768 + h * 96, K + r0 * 768 + h * 96, V + r0 * 512 + h * 64, Y + r0 * DM + 512 + h * 64, CTXL / 64, (char*)lds_raw, F.wave); } }
            SYNC(); }
        if (PROBE & 8) { GEMM(EpiResidT<false>, ws + WS_Y, ws + WS_EWOUT, DM, 64, 4, 1, 8, Hb, modl + 5 * DM, (float*)(ws + WS_PART), P.x, 0.0f); SYNC(); }
            GEMM(EpiResidT<false>, ws + WS_Y, ws + WS_EWOUT, DM, 64, 4, 1, 8, Hb, modl + 5 * DM, (float*)(ws + WS_PART), P.x, 1.0f); SYNC();
        } else {
            GEMM(EpiOddQKV, ws + WS_A, ws + WS_OWIN, DM, 66, 7, 0, 0, (bf16_t*)(ws + WS_OQ), (bf16_t*)(ws + WS_OK), (bf16_t*)(ws + WS_OV), (bf16_t*)(ws + WS_G), P.o_q_norm, P.o_k_norm, (const f32x2*)(ws + WS_ROPE) + 2048, (LAS float*)(F.lds + RING_BYTES + 1024)); SYNC();
#ifndef NO_CONV
            conv_odd(P, F);
#endif
            for (int rep_ = 0; rep_ < ((PROBE & 1) ? 2 : 1); ++rep_) {
            { const bf16_t* Q = (const bf16_t*)(ws + WS_OQ); const bf16_t* K = (const bf16_t*)(ws + WS_OK); const bf16_t* V = (const bf16_t*)(ws + WS_OV); bf16_t* Y = (bf16_t*)(ws + WS_Y);
              for (int i = 0; i < 2; ++i) { const int u = 2 * F.vcu + i; if (u >= 512) break; const int bh = u >> 5, qb = u & 31, b = bh >> 3, h = bh & 7; const size_t r0 = (size_t)b * SEQT;
                  tat::attn_unit<8, 4, 512, 128, 128, DM>(Q + (r0 + qb * 256) * 512 + h * 64, K + r0 * 128 + (h >> 2) * 64, V + r0 * 128 + (h >> 2) * 64, Y + (r0 + qb * 256) * DM + h * 64, SEQT / 64, (char*)lds_raw, F.wave); } }
            SYNC(); }
        if (PROBE & 8) { GEMM(EpiResidT<false>, ws + WS_Y, ws + WS_OWOUT, DM, 64, 4, 1, 0, Hb, modl + 5 * DM, (float*)(ws + WS_PART), P.x, 0.0f); SYNC(); }
            GEMM(EpiResidT<false>, ws + WS_Y, ws + WS_OWOUT, DM, 64, 4, 1, 0, Hb, modl + 5 * DM, (float*)(ws + WS_PART), P.x, 1.0f); SYNC();
        }
        const int nml = (l == 1) ? 64 : 66, skipc = (l == 1) ? 1 : 0;
        if (PROBE & 4) { norm_phase(P, F, l, 2, 0); SYNC(); }
        norm_phase(P, F, l, 2, (l == 0) ? 8 : 0); SYNC();
        if (PROBE & 2) { GEMM(EpiSwiglu, ws + WS_A, ws + WS_WFI + (size_t)(l * 2 + 1) * NFI * DM * 2, DM, nml, 22, skipc, 0, (bf16_t*)(ws + WS_ACT)); SYNC(); }
        GEMM(EpiSwiglu, ws + WS_A, ws + WS_WFI + (size_t)(l * 2 + 1) * NFI * DM * 2, DM, nml, 22, skipc, 0, (bf16_t*)(ws + WS_ACT)); SYNC();
        if (PROBE & 8) { GEMM(EpiResidT<false>, ws + WS_ACT, ws + WS_WFO + (size_t)(l * 2 + 1) * DM * DFF * 2, DFF, 64, 4, 1, (l == 0 ? 22 : 0), Hb, modl + 8 * DM, (float*)(ws + WS_PART), P.x, 0.0f); SYNC(); }
        if (l == 0) { GEMM(EpiResidT<false>, ws + WS_ACT, ws + WS_WFO + (size_t)(l * 2 + 1) * DM * DFF * 2, DFF, 64, 4, 1, 22, Hb, modl + 8 * DM, (float*)(ws + WS_PART), P.x, 0.5f); SYNC(); }
        else { GEMM(EpiResidNorm<2>, ws + WS_ACT, ws + WS_WFO + (size_t)(l * 2 + 1) * DM * DFF * 2, DFF, 64, 4, 1, 0, Hb, modl + 8 * DM, (float*)(ws + WS_XBUF) + (size_t)T * 4, (unsigned*)(ws + WS_CTL) + 16384 + 8192, (LAS float*)(F.lds + RING_BYTES + 1024), (bf16_t*)(ws + WS_A), P.final_g, modl, P.out, 0.5f); }
        }
    { constexpr int l = 1;
        const float* modl = MOD + (size_t)l * 3 * 9 * DM;
        if (PROBE & 4) { norm_phase(P, F, l, 0, 0); SYNC(); }
        norm_phase(P, F, l, 0, (l == 1) ? 22 : 0); SYNC();
        if (PROBE & 2) { GEMM(EpiSwiglu, ws + WS_A, ws + WS_WFI + (size_t)(l * 2 + 0) * NFI * DM * 2, DM, 66, 22, 0, 0, (bf16_t*)(ws + WS_ACT)); SYNC(); }
        GEMM(EpiSwiglu, ws + WS_A, ws + WS_WFI + (size_t)(l * 2 + 0) * NFI * DM * 2, DM, 66, 22, 0, 0, (bf16_t*)(ws + WS_ACT)); SYNC();
        if (PROBE & 8) { GEMM(EpiResidT<(l == 0)>, ws + WS_ACT, ws + WS_WFO + (size_t)(l * 2 + 0) * DM * DFF * 2, DFF, 64, 4, 1, 22, Hb, modl + 2 * DM, (float*)(ws + WS_PART), P.x, 0.0f); SYNC(); }
        GEMM(EpiResidT<(l == 0)>, ws + WS_ACT, ws + WS_WFO + (size_t)(l * 2 + 0) * DM * DFF * 2, DFF, 64, 4, 1, 22, Hb, modl + 2 * DM, (float*)(ws + WS_PART), P.x, 0.5f); SYNC();
        if (PROBE & 4) { norm_phase(P, F, l, 1, 0); SYNC(); }
        norm_phase(P, F, l, 1, 22); SYNC();
        if (l == 0) {
            GEMM(EpiEvenIn, ws + WS_A, ws + WS_EWIN, DM, 66, 8, 0, 0, (bf16_t*)(ws + WS_SB), (bf16_t*)(ws + WS_CX), (bf16_t*)(ws + WS_QAN), (bf16_t*)(ws + WS_KVAN), (bf16_t*)(ws + WS_EK), P.e_q_norm, P.e_kv_norm, (const f32x2*)(ws + WS_ROPE), (LAS float*)(F.lds + RING_BYTES + 1024));
            if (blockIdx.x >= 16) { Fr F2 = F; F2.lane = fresh_lane(); tr_items(P, F2, 1, ((int)blockIdx.x - 16) * NWAVES + F.wave, (F.G - 16) * NWAVES); }
            SYNC();
            if (F.G == 256) { if (blockIdx.x < 206) conv_even(P, F, 0, 11536, (int)blockIdx.x * NWAVES + F.wave, 206 * NWAVES); else conv_even(P, F, 11536, T, ((int)blockIdx.x - 206) * NWAVES + F.wave, 50 * NWAVES); }
            else conv_even(P, F, 0, T, F.gw, F.NGW);
            GEMM(EpiQb, ws + WS_QAN, ws + WS_EWQB, 256, 66, 3, 0, 0, (bf16_t*)(ws + WS_EQ), (const f32x2*)(ws + WS_ROPE));
            GEMM_ROT(58, EpiKVb, ws + WS_KVAN, ws + WS_EWKVB, 128, 66, 4, 0, 0, (bf16_t*)(ws + WS_EK), (bf16_t*)(ws + WS_EV));
            SYNC();
            for (int rep_ = 0; rep_ < ((PROBE & 1) ? 2 : 1); ++rep_) {
            { const bf16_t* Q = (const bf16_t*)(ws + WS_EQ); const bf16_t* K = (const bf16_t*)(ws + WS_EK); const bf16_t* V = (const bf16_t*)(ws + WS_EV); bf16_t* Y = (bf16_t*)(ws + WS_Y);
              for (int i = 0; i < 2; ++i) { const int u = 2 * F.vcu + i; if (u >= 512) break; const int bh = u >> 5, qb = u & 31, b = bh >> 3, h = bh & 7; const size_t r0 = (size_t)b * SEQT;
                  tat::attn_unit<8, 6, 768, 768, 512, DM>(Q + (r0 + qb * 256) * 768 + h * 96, K + r0 * 768 + h * 96, V + r0 * 512 + h * 64, Y + (r0 + qb * 256) * DM + 512 + h * 64, SEQT / 64, (char*)lds_raw, F.wave); }
              if ((F.vcu & 15) == 0 && F.vcu < 256) { const int bh = F.vcu >> 4, b = bh >> 3, h = bh & 7; const size_t r0 = (size_t)b * SEQT + SEQ;
                  tat::attn_unit<8, 6, 768, 768, 512, DM>(Q + r0 * 768 + h * 96, K + r0 * 768 + h * 96, V + r0 * 512 + h * 64, Y + r0 * DM + 512 + h * 64, CTXL / 64, (char*)lds_raw, F.wave); } }
            SYNC(); }
        if (PROBE & 8) { GEMM(EpiResidT<false>, ws + WS_Y, ws + WS_EWOUT, DM, 64, 4, 1, 8, Hb, modl + 5 * DM, (float*)(ws + WS_PART), P.x, 0.0f); SYNC(); }
            GEMM(EpiResidT<false>, ws + WS_Y, ws + WS_EWOUT, DM, 64, 4, 1, 8, Hb, modl + 5 * DM, (float*)(ws + WS_PART), P.x, 1.0f); SYNC();
        } else {
            GEMM(EpiOddQKV, ws + WS_A, ws + WS_OWIN, DM, 66, 7, 0, 0, (bf16_t*)(ws + WS_OQ), (bf16_t*)(ws + WS_OK), (bf16_t*)(ws + WS_OV), (bf16_t*)(ws + WS_G), P.o_q_norm, P.o_k_norm, (const f32x2*)(ws + WS_ROPE) + 2048, (LAS float*)(F.lds + RING_BYTES + 1024)); SYNC();
#ifndef NO_CONV
            conv_odd(P, F);
#endif
            for (int rep_ = 0; rep_ < ((PROBE & 1) ? 2 : 1); ++rep_) {
            { const bf16_t* Q = (const bf16_t*)(ws + WS_OQ); const bf16_t* K = (const bf16_t*)(ws + WS_OK); const bf16_t* V = (const bf16_t*)(ws + WS_OV); bf16_t* Y = (bf16_t*)(ws + WS_Y);
              for (int i = 0; i < 2; ++i) { const int u = 2 * F.vcu + i; if (u >= 512) break; const int bh = u >> 5, qb = u & 31, b = bh >> 3, h = bh & 7; const size_t r0 = (size_t)b * SEQT;
                  tat::attn_unit<8, 4, 512, 128, 128, DM>(Q + (r0 + qb * 256) * 512 + h * 64, K + r0 * 128 + (h >> 2) * 64, V + r0 * 128 + (h >> 2) * 64, Y + (r0 + qb * 256) * DM + h * 64, SEQT / 64, (char*)lds_raw, F.wave); } }
            SYNC(); }
        if (PROBE & 8) { GEMM(EpiResidT<false>, ws + WS_Y, ws + WS_OWOUT, DM, 64, 4, 1, 0, Hb, modl + 5 * DM, (float*)(ws + WS_PART), P.x, 0.0f); SYNC(); }
            GEMM(EpiResidT<false>, ws + WS_Y, ws + WS_OWOUT, DM, 64, 4, 1, 0, Hb, modl + 5 * DM, (float*)(ws + WS_PART), P.x, 1.0f); SYNC();
        }
        const int nml = (l == 1) ? 64 : 66, skipc = (l == 1) ? 1 : 0;
        if (PROBE & 4) { norm_phase(P, F, l, 2, 0); SYNC(); }
        norm_phase(P, F, l, 2, (l == 0) ? 8 : 0); SYNC();
        if (PROBE & 2) { GEMM(EpiSwiglu, ws + WS_A, ws + WS_WFI + (size_t)(l * 2 + 1) * NFI * DM * 2, DM, nml, 22, skipc, 0, (bf16_t*)(ws + WS_ACT)); SYNC(); }
        GEMM(EpiSwiglu, ws + WS_A, ws + WS_WFI + (size_t)(l * 2 + 1) * NFI * DM * 2, DM, nml, 22, skipc, 0, (bf16_t*)(ws + WS_ACT)); SYNC();
        if (PROBE & 8) { GEMM(EpiResidT<false>, ws + WS_ACT, ws + WS_WFO + (size_t)(l * 2 + 1) * DM * DFF * 2, DFF, 64, 4, 1, (l == 0 ? 22 : 0), Hb, modl + 8 * DM, (float*)(ws + WS_PART), P.x, 0.0f); SYNC(); }
        if (l == 0) { GEMM(EpiResidT<false>, ws + WS_ACT, ws + WS_WFO + (size_t)(l * 2 + 1) * DM * DFF * 2, DFF, 64, 4, 1, 22, Hb, modl + 8 * DM, (float*)(ws + WS_PART), P.x, 0.5f); SYNC(); }
        else { GEMM(EpiResidNorm<2>, ws + WS_ACT, ws + WS_WFO + (size_t)(l * 2 + 1) * DM * DFF * 2, DFF, 64, 4, 1, 0, Hb, modl + 8 * DM, (float*)(ws + WS_XBUF) + (size_t)T * 4, (unsigned*)(ws + WS_CTL) + 16384 + 8192, (LAS float*)(F.lds + RING_BYTES + 1024), (bf16_t*)(ws + WS_A), P.final_g, modl, P.out, 0.5f); }
        }
}

extern "C" void kernel_launch(void* const* d_in, const int* in_sizes, int n_in, void* d_out, int out_size, void* d_ws, size_t ws_size, hipStream_t stream) {
    static int grid = 0;
    if (grid == 0) {
        if (n_in != 25 || out_size != NB * SEQ * DM || ws_size < WS_END) { fprintf(stderr, "kernel_launch: unexpected shapes (n_in %d out %d ws %zu)\n", n_in, out_size, ws_size); grid = -1; return; }
        int dev = 0, cus = 0, per_cu = 0;
        hipGetDevice(&dev); hipDeviceGetAttribute(&cus, hipDeviceAttributeMultiprocessorCount, dev);
        if (hipFuncSetAttribute((const void*)hybrid_fwd, hipFuncAttributeMaxDynamicSharedMemorySize, LDS_BYTES) != hipSuccess) { fprintf(stderr, "kernel_launch: hipFuncSetAttribute failed\n"); grid = -1; return; }
        if (hipOccupancyMaxActiveBlocksPerMultiprocessor(&per_cu, (const void*)hybrid_fwd, NWAVES * 64, LDS_BYTES) != hipSuccess || per_cu < 1) { fprintf(stderr, "kernel_launch: occupancy query gives %d\n", per_cu); per_cu = 1; }
        (void)hipGetLastError();
        grid = cus * 1;
        fprintf(stderr, "kernel_launch: grid %d (per_cu %d)\n", grid, per_cu);
    }
    if (grid < 0) return;
    hipMemsetAsync((char*)d_ws + WS_CTL, 0, ZERO_BYTES, stream);
    Params p{};
    const float** pp = (const float**)&p;
    for (int i = 0; i < 25; ++i) pp[i] = (const float*)d_in[i];
    p.out = (float*)d_out; p.ws = (unsigned char*)d_ws;
    void* args[] = {&p};
    hipError_t e = hipLaunchCooperativeKernel((const void*)hybrid_fwd, dim3(grid), dim3(NWAVES * 64), args, LDS_BYTES, stream);
    if (e != hipSuccess) fprintf(stderr, "cooperative launch failed: %s (grid %d)\n", hipGetErrorString(e), grid);
}
```
